# Optimizing an MI355X kernel written in HIP

```python
import math
import jax, jax.numpy as jnp
from jax import lax
import numpy as np

D_MODEL = 1024
BATCH = 2
SEQ = 8192
DEPTH = 1

N_META = 16
RWKV_HEADS = 8
RWKV_HEAD_DIM = 64
RWKV_DIM = RWKV_HEADS * RWKV_HEAD_DIM
DECAY_LORA = 64
AAA_LORA = 64
GATE_LORA = 128
RWKV_GN_EPS = RWKV_HEAD_DIM * 1e-5
ATTN_Q_HEADS = 8
ATTN_KV_HEADS = 2
ATTN_HEAD_DIM = 64
ATTN_GROUP = ATTN_Q_HEADS // ATTN_KV_HEADS
ATTN_DIM = ATTN_Q_HEADS * ATTN_HEAD_DIM
KV_DIM = ATTN_KV_HEADS * ATTN_HEAD_DIM
WINDOW = 128
BLOCK = 128
REL_BUCKETS = 32
REL_MAX_EXACT = 16
REL_MAX_DIST = 128
D_FF = 2816
CONV_WIDTH = 3
NORM_EPS = 1e-6
MASK_VALUE = -1e30

RWKV_IN = 3 * RWKV_DIM + DECAY_LORA + AAA_LORA + GATE_LORA
ATTN_IN = ATTN_DIM + 2 * KV_DIM
IN_DIM = RWKV_IN + ATTN_IN
MIX_DIM = RWKV_DIM + ATTN_DIM

kernel_name = "hymba_rwkv7_swa_convffn_layer"


def rms_norm(x, w, eps=NORM_EPS):
    xf = x.astype(jnp.float32)
    y = xf * lax.rsqrt(jnp.mean(xf * xf, axis=-1, keepdims=True) + eps)
    return (y * w.astype(jnp.float32)).astype(x.dtype)


def shift_right(x, n):
    return jnp.pad(x, ((0, 0), (n, 0), (0, 0)))[:, : x.shape[1]]


def t5_bucket(d):
    d = jnp.maximum(d, 0)
    df = jnp.maximum(d, REL_MAX_EXACT).astype(jnp.float32)
    large = REL_MAX_EXACT + (jnp.log(df / REL_MAX_EXACT) / math.log(REL_MAX_DIST / REL_MAX_EXACT)
                             * (REL_BUCKETS - REL_MAX_EXACT)).astype(jnp.int32)
    large = jnp.minimum(large, REL_BUCKETS - 1)
    return jnp.where(d < REL_MAX_EXACT, d, large)


def rwkv7_step(S, inp):
    r, w, k, v, a, b = inp
    sa = jnp.einsum('bhij,bhj->bhi', S, a)
    S = S * w[:, :, None, :] + sa[..., None] * b[:, :, None, :] + v[..., None] * k[:, :, None, :]
    y = jnp.einsum('bhij,bhj->bhi', S, r)
    return S, y


def rwkv7_mixer(p, mu, w0, w_dec_up, a0, a_up, g_up, k_k, k_a, r_k, lnx_w, lnx_b):
    B, L, _ = p.shape
    H, N = RWKV_HEADS, RWKV_HEAD_DIM
    p = p + (shift_right(p, 1) - p) * mu
    r, k, v, wd, ad, gd = jnp.split(
        p, [RWKV_DIM, 2 * RWKV_DIM, 3 * RWKV_DIM, 3 * RWKV_DIM + DECAY_LORA,
            3 * RWKV_DIM + DECAY_LORA + AAA_LORA], axis=-1)
    w_log = -jax.nn.softplus(-(w0 + jnp.tanh(wd) @ w_dec_up)) - 0.5
    decay = jnp.exp(-jnp.exp(w_log.astype(jnp.float32)))
    a = jax.nn.sigmoid(a0 + ad @ a_up)
    g = jax.nn.sigmoid(gd) @ g_up
    heads = lambda t: t.reshape(B, L, H, N).astype(jnp.float32)
    kk = heads(k * k_k)
    kk = kk / jnp.maximum(jnp.sqrt(jnp.sum(kk * kk, axis=-1, keepdims=True)), 1e-12)
    k = k * (1.0 + (a - 1.0) * k_a)
    r_h, k_h, v_h, a_h, w_h = heads(r), heads(k), heads(v), heads(a), heads(decay)
    xs = tuple(jnp.moveaxis(t, 1, 0) for t in (r_h, w_h, k_h, v_h, -kk, kk * a_h))
    S0 = jnp.zeros((B, H, N, N), jnp.float32)
    _, y = lax.scan(rwkv7_step, S0, xs)
    y = jnp.moveaxis(y, 0, 1)
    mean = jnp.mean(y, axis=-1, keepdims=True)
    var = jnp.mean(jnp.square(y - mean), axis=-1, keepdims=True)
    y = ((y - mean) * lax.rsqrt(var + RWKV_GN_EPS)).reshape(B, L, RWKV_DIM)
    y = y * lnx_w.astype(jnp.float32) + lnx_b.astype(jnp.float32)
    bonus = jnp.sum(r_h * k_h * r_k.astype(jnp.float32), axis=-1, keepdims=True) * v_h
    y = (y + bonus.reshape(B, L, RWKV_DIM)) * g.astype(jnp.float32)
    return y.astype(p.dtype)


def swa_mixer(p, q_norm_w, k_norm_w, rel_bias, sinks):
    B, L, _ = p.shape
    q, k, v = jnp.split(p, [ATTN_DIM, ATTN_DIM + KV_DIM], axis=-1)
    q = rms_norm(q.reshape(B, L, ATTN_Q_HEADS, ATTN_HEAD_DIM), q_norm_w)
    k = rms_norm(k.reshape(B, L, ATTN_KV_HEADS, ATTN_HEAD_DIM), k_norm_w)
    v = v.reshape(B, L, ATTN_KV_HEADS, ATTN_HEAD_DIM)
    meta_k, meta_v = k[:, :N_META], v[:, :N_META]
    pad = BLOCK - N_META
    padf = lambda t: jnp.pad(t, ((0, 0), (pad, 0), (0, 0), (0, 0)))
    q, k, v = padf(q), padf(k), padf(v)
    nb = (L + pad) // BLOCK
    qb = q.reshape(B, nb, BLOCK, ATTN_KV_HEADS, ATTN_GROUP, ATTN_HEAD_DIM)

    def band(t):
        t = t.reshape(B, nb, BLOCK, ATTN_KV_HEADS, ATTN_HEAD_DIM)
        prev = jnp.pad(t, ((0, 0), (1, 0), (0, 0), (0, 0), (0, 0)))[:, :nb]
        return jnp.concatenate([prev, t], axis=2)

    kband, vband = band(k), band(v)
    scale = ATTN_HEAD_DIM ** -0.5
    s_meta = jnp.einsum('bnqhgd,bmhd->bhgnqm', qb, meta_k)
    s_band = jnp.einsum('bnqhgd,bnkhd->bhgnqk', qb, kband)
    qpos = jnp.arange(nb)[:, None] * BLOCK + jnp.arange(BLOCK)[None, :] - pad
    kpos = (jnp.arange(nb)[:, None] - 1) * BLOCK + jnp.arange(2 * BLOCK)[None, :] - pad
    d_band = qpos[:, :, None] - kpos[:, None, :]
    mask_band = (kpos[:, None, :] >= N_META) & (d_band >= 0) & (d_band < WINDOW)
    d_meta = qpos[:, :, None] - jnp.arange(N_META)[None, None, :]
    mask_meta = d_meta >= 0
    d_all = jnp.concatenate([d_meta, d_band], axis=-1)
    mask_all = jnp.concatenate([mask_meta, mask_band], axis=-1)
    bias = rel_bias[t5_bucket(d_all)]
    bias = jnp.moveaxis(bias, -1, 0).reshape(ATTN_KV_HEADS, ATTN_GROUP, nb, BLOCK, -1)
    s = jnp.concatenate([s_meta, s_band], axis=-1).astype(jnp.float32) * scale + bias.astype(jnp.float32)
    s = jnp.where(mask_all, s, MASK_VALUE)
    sink = sinks.astype(jnp.float32).reshape(ATTN_KV_HEADS, ATTN_GROUP, 1, 1, 1)
    m = jnp.maximum(jnp.max(s, axis=-1, keepdims=True), sink)
    e = jnp.exp(s - m)
    prob = (e / (jnp.sum(e, axis=-1, keepdims=True) + jnp.exp(sink - m))).astype(v.dtype)
    o = (jnp.einsum('bhgnqm,bmhd->bnqhgd', prob[..., :N_META], meta_v)
         + jnp.einsum('bhgnqk,bnkhd->bnqhgd', prob[..., N_META:], vband))
    return o.reshape(B, nb * BLOCK, ATTN_DIM)[:, pad:]


def conv_ffn(u, w_up, conv_w, conv_b, w_down):
    hid = u @ w_up
    hid = (hid * conv_w[0] + shift_right(hid, 1) * conv_w[1]
           + shift_right(hid, 2) * conv_w[2] + conv_b)
    gate, val = jnp.split(hid, 2, axis=-1)
    return (jax.nn.silu(gate) * val) @ w_down


def setup_inputs(seed: int = 0) -> dict:
    key = jax.random.key(seed)
    ks = jax.random.split(key, 32)
    nrm = lambda k, shape, s: jax.random.normal(k, shape, jnp.float32) * s
    near_one = lambda k, shape: 1.0 + 0.02 * jax.random.normal(k, shape, jnp.float32)
    return {
        "x": nrm(ks[0], (BATCH, SEQ, D_MODEL), 1.0),
        "meta_tokens": nrm(ks[1], (N_META, D_MODEL), 1.0),
        "rel_bias": nrm(ks[2], (REL_BUCKETS, ATTN_Q_HEADS), 0.5),
        "norm1_w": near_one(ks[3], (DEPTH, D_MODEL)),
        "w_in": nrm(ks[4], (DEPTH, D_MODEL, IN_DIM), D_MODEL ** -0.5),
        "shift_mu": jax.random.uniform(ks[5], (DEPTH, RWKV_IN), jnp.float32, 0.0, 1.0),
        "decay_w0": jax.random.uniform(ks[6], (DEPTH, RWKV_DIM), jnp.float32, -5.0, -1.0),
        "decay_up": nrm(ks[7], (DEPTH, DECAY_LORA, RWKV_DIM), 0.1 * DECAY_LORA ** -0.5),
        "aaa_a0": nrm(ks[8], (DEPTH, RWKV_DIM), 0.1),
        "aaa_up": nrm(ks[9], (DEPTH, AAA_LORA, RWKV_DIM), 0.5 * AAA_LORA ** -0.5),
        "gate_up": nrm(ks[10], (DEPTH, GATE_LORA, RWKV_DIM), GATE_LORA ** -0.5),
        "k_k": 0.85 + nrm(ks[11], (DEPTH, RWKV_DIM), 0.02),
        "k_a": near_one(ks[12], (DEPTH, RWKV_DIM)),
        "r_k": nrm(ks[13], (DEPTH, RWKV_HEADS, RWKV_HEAD_DIM), 0.1),
        "lnx_w": near_one(ks[14], (DEPTH, RWKV_DIM)),
        "lnx_b": nrm(ks[15], (DEPTH, RWKV_DIM), 0.02),
        "q_norm_w": near_one(ks[16], (DEPTH, ATTN_HEAD_DIM)),
        "k_norm_w": near_one(ks[17], (DEPTH, ATTN_HEAD_DIM)),
        "sinks": nrm(ks[18], (DEPTH, ATTN_Q_HEADS), 1.0),
        "w_out": nrm(ks[19], (DEPTH, MIX_DIM, D_MODEL), MIX_DIM ** -0.5),
        "norm2_w": near_one(ks[20], (DEPTH, D_MODEL)),
        "w_up": nrm(ks[21], (DEPTH, D_MODEL, 2 * D_FF), D_MODEL ** -0.5),
        "conv_w": nrm(ks[22], (DEPTH, CONV_WIDTH, 2 * D_FF), CONV_WIDTH ** -0.5),
        "conv_b": nrm(ks[23], (DEPTH, 2 * D_FF), 0.02),
        "w_down": nrm(ks[24], (DEPTH, D_FF, D_MODEL), D_FF ** -0.5),
    }


def reference(x, meta_tokens, rel_bias, norm1_w, w_in, shift_mu, decay_w0, decay_up, aaa_a0,
              aaa_up, gate_up, k_k, k_a, r_k, lnx_w, lnx_b, q_norm_w, k_norm_w, sinks, w_out,
              norm2_w, w_up, conv_w, conv_b, w_down):
    B = x.shape[0]
    meta = jnp.broadcast_to(meta_tokens[None].astype(x.dtype), (B, N_META, D_MODEL))
    h = jnp.concatenate([meta, x], axis=1)
    for layer in range(DEPTH):
        u = rms_norm(h, norm1_w[layer])
        p = u @ w_in[layer]
        y_rwkv = rwkv7_mixer(p[..., :RWKV_IN], shift_mu[layer], decay_w0[layer], decay_up[layer],
                             aaa_a0[layer], aaa_up[layer], gate_up[layer], k_k[layer], k_a[layer],
                             r_k[layer], lnx_w[layer], lnx_b[layer])
        y_attn = swa_mixer(p[..., RWKV_IN:], q_norm_w[layer], k_norm_w[layer], rel_bias, sinks[layer])
        h = h + jnp.concatenate([y_rwkv, y_attn], axis=-1) @ w_out[layer]
        u = rms_norm(h, norm2_w[layer])
        h = h + conv_ffn(u, w_up[layer], conv_w[layer], conv_b[layer], w_down[layer])
    return h[:, N_META:]
```

```cpp
#include <hip/hip_runtime.h>
#include <cstdio>
#include <cstdint>
namespace pg8 {
#define PG8_LAS __attribute__((address_space(3)))
typedef unsigned short bf16_t;
typedef short bf16x8 __attribute__((ext_vector_type(8)));
typedef float f32x4 __attribute__((ext_vector_type(4)));
typedef unsigned u32x4 __attribute__((ext_vector_type(4)));
constexpr int BM = 256, BK = 64, HALF = 128, HTB = HALF * BK * 2  , STAGE_BYTES = 8 * HTB, NXCD = 8, WGM = 8;

__host__ __device__ __forceinline__ int lds_byte(int r, int c) { const int st = (r >> 4) * 2 + (c >> 5), rr = r & 15, cc = c & 31, ob = rr * 64 + cc * 2; return st * 1024 + (ob ^ (((ob >> 9) & 1) << 5)); }
__host__ __device__ __forceinline__ void stage_rc(int b, int& R, int& C) { const int st = b / 1024, sb = b % 1024, swz = sb ^ (((sb >> 9) & 1) << 5); R = (st >> 1) * 16 + swz / 64; C = (st & 1) * 32 + (swz % 64) / 2; }
__host__ __device__ __forceinline__ int perm32(int rho) { const int n = rho >> 4, i = rho & 15; return 8 * (i >> 2) + 4 * n + (i & 3); }

struct Unit { int pm, pn; };
struct Gemm { const bf16_t* A; const bf16_t* Bt; int M, N, K; };

template <int AMODE> struct StaticOrderT {
    int nM, nN, nwg, G, c;
    __host__ __device__ void init(int M, int N, int G_, int c_) { nM = M / BM; nN = N / BM; nwg = nM * nN; G = G_; c = c_; }
    __host__ __device__ bool next(int i, Unit& u) const {
        const long L = (long)i * G + c; if (L >= nwg) return false;
        int wgid = (int)L; { const int q = nwg / NXCD, r = nwg % NXCD, xcd = wgid % NXCD, off = wgid / NXCD; wgid = (xcd < r ? xcd * (q + 1) : r * (q + 1) + (xcd - r) * q) + off; }
        const int nig = WGM * nN, gid = wgid / nig, fm = gid * WGM, gsz = (nM - fm) < WGM ? (nM - fm) : WGM;
        u.pm = fm + ((wgid % nig) % gsz); u.pn = (wgid % nig) / gsz; return true;
    }
    __host__ __device__ __forceinline__ int a_row0(const Unit& u) const { return AMODE == 0 ? u.pm * BM : (AMODE == 1 ? (u.pm >> 5) * 8208 + 16 + (u.pm & 31) * 256 : (u.pm / 33) * 8208 + 14 + 254 * (u.pm % 33)); }
    __device__ __forceinline__ void a_ready(const Unit&) const {}
    __device__ __forceinline__ void done(const Unit&) const {}
};

__device__ __forceinline__ unsigned cvt_pk_bf16(float lo, float hi) { unsigned r; asm volatile("v_cvt_pk_bf16_f32 %0, %1, %2" : "=v"(r) : "v"(lo), "v"(hi)); return r; }
typedef float f32x2 __attribute__((ext_vector_type(2)));
typedef unsigned u32x2 __attribute__((ext_vector_type(2)));
struct EpiBf16 {
    static constexpr bool PERM = true, AFTER_DRAIN = false;
    bf16_t* O; int ldc;
    __device__ __forceinline__ void operator()(f32x4 (&acc)[2][2][4][2], const Unit& u, int wr, int wc, int fr, int fq) const {
        const int row0 = u.pm * BM + wr * 64 + fr, col0 = u.pn * BM + wc * 32 + 8 * fq;
#pragma unroll
        for (int ai = 0; ai < 2; ++ai)
#pragma unroll
            for (int m = 0; m < 4; ++m) { bf16_t* rowp = O + (size_t)(row0 + ai * HALF + m * 16) * ldc + col0;
#pragma unroll
                for (int bj = 0; bj < 2; ++bj) { const f32x4 v0 = acc[ai][bj][m][0], v1 = acc[ai][bj][m][1];
                    u32x4 w; w.x = cvt_pk_bf16(v0[0], v0[1]); w.y = cvt_pk_bf16(v0[2], v0[3]); w.z = cvt_pk_bf16(v1[0], v1[1]); w.w = cvt_pk_bf16(v1[2], v1[3]);
                    *(u32x4*)(rowp + bj * HALF) = w; } }
    }
};
struct EpiH1 {
    static constexpr bool PERM = false, AFTER_DRAIN = false;
    const float* x; float* out; bf16_t* h1b; float* ssqp; int ssq_stride;
    __device__ __forceinline__ void operator()(f32x4 (&acc)[2][2][4][2], const Unit& u, int wr, int wc, int fr, int fq) const {
        const int col0 = u.pn * BM + wc * 32 + 4 * fq;
#pragma unroll
        for (int ai = 0; ai < 2; ++ai)
#pragma unroll
            for (int m = 0; m < 4; ++m) { const int rr = u.pm * BM + ai * HALF + wr * 64 + m * 16 + fr; const int U = (rr >> 13) * 8208 + 16 + (rr & 8191); float s = 0.f;
#pragma unroll
                for (int bj = 0; bj < 2; ++bj)
#pragma unroll
                    for (int n = 0; n < 2; ++n) { const size_t off = (size_t)rr * 1024 + col0 + bj * HALF + n * 16;
                        const f32x4 h = *(const f32x4*)(x + off) + acc[ai][bj][m][n]; *(f32x4*)(out + off) = h;
                        s += (h[0] * h[0] + h[1] * h[1]) + (h[2] * h[2] + h[3] * h[3]);
                        u32x2 w; w.x = cvt_pk_bf16(h[0], h[1]); w.y = cvt_pk_bf16(h[2], h[3]); *(u32x2*)(h1b + (size_t)U * 1024 + col0 + bj * HALF + n * 16) = w; }
                s += __shfl_xor(s, 16); s += __shfl_xor(s, 32);
                if (fq == 0) ssqp[(size_t)(u.pn * 4 + wc) * ssq_stride + U] = s; }
    }
};
struct EpiOut {
    static constexpr bool PERM = false, AFTER_DRAIN = false;
    float* out;
    __device__ __forceinline__ void operator()(f32x4 (&acc)[2][2][4][2], const Unit& u, int wr, int wc, int fr, int fq) const {
        const int col0 = u.pn * BM + wc * 32 + 4 * fq;
#pragma unroll
        for (int ai = 0; ai < 2; ++ai)
#pragma unroll
            for (int m = 0; m < 4; ++m) { const int rr = u.pm * BM + ai * HALF + wr * 64 + m * 16 + fr;
#pragma unroll
                for (int bj = 0; bj < 2; ++bj)
#pragma unroll
                    for (int n = 0; n < 2; ++n) { const size_t off = (size_t)rr * 1024 + col0 + bj * HALF + n * 16; *(f32x4*)(out + off) = *(const f32x4*)(out + off) + acc[ai][bj][m][n]; } }
    }
};
struct EpiAct {
    static constexpr bool PERM = true, AFTER_DRAIN = false;
    bf16_t* act; const float* ssqp; int ssq_stride; const float* conv_w; const float* conv_b; PG8_LAS float* halo;
    __device__ __forceinline__ void operator()(f32x4 (&acc)[2][2][4][2], const Unit& u, int wr, int wc, int fr, int fq) const {
        const int b = u.pm / 33, ti = u.pm % 33, lane = fq * 16 + fr;
#pragma unroll
        for (int ai = 0; ai < 2; ++ai)
#pragma unroll
            for (int m = 0; m < 4; ++m) { const int pos = 14 + 254 * ti + ai * HALF + wr * 64 + m * 16 + fr; float rs = 0.f;
                if (pos <= 8207) { const int U = b * 8208 + pos; float s = 0.f;
#pragma unroll
                    for (int p = 0; p < 16; ++p) s += ssqp[(size_t)p * ssq_stride + U];
                    rs = 1.0f / sqrtf(s * (1.0f / 1024.0f) + 1e-6f); }
#pragma unroll
                for (int bj = 0; bj < 2; ++bj)
#pragma unroll
                    for (int n = 0; n < 2; ++n) acc[ai][bj][m][n] = acc[ai][bj][m][n] * rs; }
        if (fr >= 14) {
#pragma unroll
            for (int ai = 0; ai < 2; ++ai)
#pragma unroll
                for (int bj = 0; bj < 2; ++bj)
#pragma unroll
                    for (int n = 0; n < 2; ++n) *(PG8_LAS f32x4*)(halo + ((2 * ai + wr) * 2 + (fr - 14)) * 256 + bj * 128 + wc * 32 + 8 * fq + 4 * n) = acc[ai][bj][3][n];
        }
        asm volatile("s_waitcnt lgkmcnt(0)" ::: "memory"); __builtin_amdgcn_s_barrier(); asm volatile("" ::: "memory");
        const int src1 = (lane & 48) | ((fr + 15) & 15), src2 = (lane & 48) | ((fr + 14) & 15);
        u32x2 res[2][4][2];
#pragma unroll
        for (int n = 0; n < 2; ++n) {
            const int jg = u.pn * 128 + wc * 32 + 8 * fq + 4 * n;
            const f32x4 g0 = *(const f32x4*)(conv_w + jg), g1 = *(const f32x4*)(conv_w + 5632 + jg), g2 = *(const f32x4*)(conv_w + 2 * 5632 + jg), gb = *(const f32x4*)(conv_b + jg);
            const f32x4 v0 = *(const f32x4*)(conv_w + 2816 + jg), v1 = *(const f32x4*)(conv_w + 5632 + 2816 + jg), v2 = *(const f32x4*)(conv_w + 2 * 5632 + 2816 + jg), vb = *(const f32x4*)(conv_b + 2816 + jg);
#pragma unroll
            for (int ai = 0; ai < 2; ++ai) { const int seg = 2 * ai + wr;
                f32x4 pg = (f32x4){0.f, 0.f, 0.f, 0.f}, pv = (f32x4){0.f, 0.f, 0.f, 0.f};
                if (seg > 0 && fr >= 14) { const PG8_LAS float* hp = halo + ((seg - 1) * 2 + (fr - 14)) * 256 + wc * 32 + 8 * fq + 4 * n; pg = *(const PG8_LAS f32x4*)hp; pv = *(const PG8_LAS f32x4*)(hp + 128); }
#pragma unroll
                for (int m = 0; m < 4; ++m) { const f32x4 xg = acc[ai][0][m][n], xv = acc[ai][1][m][n]; float o[4];
#pragma unroll
                    for (int c = 0; c < 4; ++c) {
                        const float zg1 = fr == 15 ? pg[c] : xg[c], zg2 = fr >= 14 ? pg[c] : xg[c], zv1 = fr == 15 ? pv[c] : xv[c], zv2 = fr >= 14 ? pv[c] : xv[c];
                        const float xg1 = __shfl(zg1, src1), xg2 = __shfl(zg2, src2), xv1 = __shfl(zv1, src1), xv2 = __shfl(zv2, src2);
                        const float gate = g0[c] * xg[c] + g1[c] * xg1 + g2[c] * xg2 + gb[c];
                        const float val = v0[c] * xv[c] + v1[c] * xv1 + v2[c] * xv2 + vb[c];
                        o[c] = gate * __builtin_amdgcn_rcpf(1.0f + __expf(-gate)) * val; }
                    res[ai][m][n].x = cvt_pk_bf16(o[0], o[1]); res[ai][m][n].y = cvt_pk_bf16(o[2], o[3]);
                    pg = xg; pv = xv; } }
        }
#pragma unroll
        for (int ai = 0; ai < 2; ++ai)
#pragma unroll
            for (int m = 0; m < 4; ++m) { const int r = ai * HALF + wr * 64 + m * 16 + fr, t = 254 * ti + r - 2;
                if (r >= 2 && t < 8192) { u32x4 w; w.x = res[ai][m][0].x; w.y = res[ai][m][0].y; w.z = res[ai][m][1].x; w.w = res[ai][m][1].y;
                    *(u32x4*)(act + (size_t)(b * 8192 + t) * 2816 + u.pn * 128 + wc * 32 + 8 * fq) = w; } }
    }
};

template <class Epi, class Sched, bool ALIGN_EPI = false, bool SP2 = false>
__device__ __forceinline__ void gemm_phase(PG8_LAS unsigned char* lds, const Gemm g, const Sched& S, const Epi& E) {
    const int tid = threadIdx.x, wid = __builtin_amdgcn_readfirstlane(tid >> 6), lane = tid & 63, wr = wid >> 2, wc = wid & 3, fr = lane & 15, fq = lane >> 4;
    const int K = g.K, nt = K / BK;
    unsigned voffA[2], voffB[2];
#pragma unroll
    for (int i = 0; i < 2; ++i) { int R, C; stage_rc(tid * 16 + i * 8192, R, C); const int Rb = Epi::PERM ? ((R & ~31) + perm32(R & 31)) : R;
        voffA[i] = (unsigned)(R * K + C) * 2u; voffB[i] = (unsigned)(Rb * K + C) * 2u; }
    const size_t kstep = (size_t)(BK * 2);
    const size_t hstep = (size_t)HALF * K * 2;
    const size_t tstep = 2 * hstep;
    const unsigned ldsw = (unsigned)wid * 1024u;
    const int aoff = lds_byte(wr * 64 + fr, fq * 8), boff = lds_byte(wc * 32 + fr, fq * 8);
#define PG8_SA(b, h) (((b) * 2 + (h)) * HTB)
#define PG8_SB(b, h) ((4 + (b) * 2 + (h)) * HTB)
#define PG8_STAGE(bufoff, gbase, voff) do { _Pragma("unroll") for (int _i = 0; _i < 2; ++_i) \
        __builtin_amdgcn_global_load_lds((const unsigned*)((const char*)(gbase) + (voff)[_i]), (PG8_LAS unsigned*)(lds + (bufoff) + ldsw + _i * 8192), 16, 0, 0); } while (0)
#define PG8_LDA(dst, b, h) do { _Pragma("unroll") for (int m = 0; m < 4; ++m) _Pragma("unroll") for (int k = 0; k < 2; ++k) dst[m][k] = *(const PG8_LAS bf16x8*)(lds + PG8_SA(b, h) + aoff + m * 2048 + k * 1024); } while (0)
#define PG8_LDB(dst, b, h) do { _Pragma("unroll") for (int n = 0; n < 2; ++n) _Pragma("unroll") for (int k = 0; k < 2; ++k) dst[n][k] = *(const PG8_LAS bf16x8*)(lds + PG8_SB(b, h) + boff + n * 2048 + k * 1024); } while (0)
#define PG8_MMA(ai, bj, At, Bt) do { __builtin_amdgcn_s_setprio(1); _Pragma("unroll") for (int m = 0; m < 4; ++m) _Pragma("unroll") for (int n = 0; n < 2; ++n) _Pragma("unroll") for (int k = 0; k < 2; ++k) \
        acc[ai][bj][m][n] = __builtin_amdgcn_mfma_f32_16x16x32_bf16(Bt[n][k], At[m][k], acc[ai][bj][m][n], 0, 0, 0); __builtin_amdgcn_s_setprio(0); } while (0)
#define PG8_WAIT_V(n) asm volatile("s_waitcnt vmcnt(" #n ")" ::: "memory")
#define PG8_WAIT_L(n) asm volatile("s_waitcnt lgkmcnt(" #n ")" ::: "memory")
#define PG8_BAR __builtin_amdgcn_s_barrier()
#define PG8_SCHED __builtin_amdgcn_sched_barrier(0)
    Unit cur, nxt; int ui = 0;
    if (!S.next(0, cur)) return;
    f32x4 acc[2][2][4][2];
#pragma unroll
    for (int a = 0; a < 2; ++a)
#pragma unroll
        for (int b = 0; b < 2; ++b)
#pragma unroll
            for (int m = 0; m < 4; ++m)
#pragma unroll
                for (int n = 0; n < 2; ++n) acc[a][b][m][n] = (f32x4){0.f, 0.f, 0.f, 0.f};
    bf16x8 At[4][2], B0[2][2], B1[2][2];
    const size_t rowb = (size_t)K * 2; const char* cA = (const char*)g.A + (size_t)S.a_row0(cur) * rowb; const char* cB = (const char*)g.Bt + (size_t)cur.pn * tstep;
    S.a_ready(cur);
    if constexpr (SP2) {
        PG8_STAGE(PG8_SB(0, 0), cB, voffB); PG8_STAGE(PG8_SB(0, 1), cB + hstep, voffB); PG8_STAGE(PG8_SA(0, 0), cA, voffA); PG8_STAGE(PG8_SA(0, 1), cA + hstep, voffA);
        if (wr == 1) PG8_BAR;
        PG8_WAIT_V(2); PG8_BAR;
        PG8_STAGE(PG8_SB(1, 0), cB + kstep, voffB); PG8_STAGE(PG8_SA(1, 0), cA + kstep, voffA); PG8_STAGE(PG8_SB(1, 1), cB + hstep + kstep, voffB);
        PG8_WAIT_V(6); PG8_BAR;
    } else {
        PG8_STAGE(PG8_SB(0, 0), cB, voffB); PG8_STAGE(PG8_SA(0, 0), cA, voffA); PG8_STAGE(PG8_SB(0, 1), cB + hstep, voffB); PG8_STAGE(PG8_SA(0, 1), cA + hstep, voffA);
        if (wr == 1) PG8_BAR;
        PG8_WAIT_V(4); PG8_BAR;
        PG8_STAGE(PG8_SB(1, 0), cB + kstep, voffB); PG8_STAGE(PG8_SA(1, 0), cA + kstep, voffA); PG8_STAGE(PG8_SB(1, 1), cB + hstep + kstep, voffB);
        PG8_WAIT_V(6); PG8_BAR;
    }
    for (;;) {
        const bool has_next = S.next(ui + 1, nxt);
        const char* nA = has_next ? (const char*)g.A + (size_t)S.a_row0(nxt) * rowb : cA; const char* nB = has_next ? (const char*)g.Bt + (size_t)nxt.pn * tstep : cB;
        for (int t = 0; t < nt; t += 2) {
            const bool last = (t == nt - 2);
            const char* a1 = cA + (size_t)(t + 1) * kstep;
            const char* a2 = last ? nA : cA + (size_t)(t + 2) * kstep; const char* b2 = last ? nB : cB + (size_t)(t + 2) * kstep;
            const char* a3 = a2 + kstep; const char* b3 = b2 + kstep;
            if (last && has_next) S.a_ready(nxt);
            if constexpr (SP2) {
            PG8_LDB(B0, 0, 0); PG8_LDB(B1, 0, 1); PG8_SCHED; PG8_LDA(At, 0, 0); PG8_STAGE(PG8_SA(1, 1), a1 + hstep, voffA);
            PG8_WAIT_V(8); PG8_WAIT_L(0); PG8_BAR; PG8_MMA(0, 0, At, B0); PG8_MMA(0, 1, At, B1); PG8_BAR; PG8_SCHED;
            PG8_LDA(At, 0, 1); PG8_STAGE(PG8_SB(0, 0), b2, voffB); PG8_STAGE(PG8_SB(0, 1), b2 + hstep, voffB); PG8_STAGE(PG8_SA(0, 0), a2, voffA);
            PG8_WAIT_V(8); PG8_WAIT_L(0); PG8_BAR; PG8_MMA(1, 0, At, B0); PG8_MMA(1, 1, At, B1); PG8_BAR; PG8_SCHED;
            PG8_LDB(B0, 1, 0); PG8_LDB(B1, 1, 1); PG8_SCHED; PG8_LDA(At, 1, 0); PG8_STAGE(PG8_SA(0, 1), a2 + hstep, voffA);
            PG8_WAIT_V(8); PG8_WAIT_L(0); PG8_BAR; PG8_MMA(0, 0, At, B0); PG8_MMA(0, 1, At, B1); PG8_BAR; PG8_SCHED;
            PG8_LDA(At, 1, 1); PG8_STAGE(PG8_SB(1, 0), b3, voffB); PG8_STAGE(PG8_SB(1, 1), b3 + hstep, voffB); PG8_STAGE(PG8_SA(1, 0), a3, voffA);
            PG8_WAIT_V(8); PG8_WAIT_L(0); PG8_BAR; PG8_MMA(1, 0, At, B0); PG8_MMA(1, 1, At, B1); PG8_BAR; PG8_SCHED;
            } else {
            PG8_LDB(B0, 0, 0); PG8_SCHED; PG8_LDA(At, 0, 0); PG8_STAGE(PG8_SA(1, 1), a1 + hstep, voffA);
            PG8_WAIT_L(8); PG8_BAR; PG8_WAIT_L(0); PG8_MMA(0, 0, At, B0); PG8_BAR; PG8_SCHED;
            PG8_LDB(B1, 0, 1); PG8_STAGE(PG8_SB(0, 0), b2, voffB);
            PG8_BAR; PG8_WAIT_L(0); PG8_MMA(0, 1, At, B1); PG8_BAR;
            PG8_LDA(At, 0, 1); PG8_STAGE(PG8_SA(0, 0), a2, voffA);
            PG8_BAR; PG8_WAIT_L(0); PG8_MMA(1, 0, At, B0); PG8_BAR; PG8_SCHED;
            PG8_STAGE(PG8_SB(0, 1), b2 + hstep, voffB);
            PG8_WAIT_V(6); PG8_BAR; PG8_MMA(1, 1, At, B1); PG8_BAR;
            PG8_LDB(B0, 1, 0); PG8_SCHED; PG8_LDA(At, 1, 0); PG8_STAGE(PG8_SA(0, 1), a2 + hstep, voffA);
            PG8_WAIT_L(8); PG8_BAR; PG8_WAIT_L(0); PG8_MMA(0, 0, At, B0); PG8_BAR; PG8_SCHED;
            PG8_LDB(B1, 1, 1); PG8_STAGE(PG8_SB(1, 0), b3, voffB);
            PG8_BAR; PG8_WAIT_L(0); PG8_MMA(0, 1, At, B1); PG8_BAR;
            PG8_LDA(At, 1, 1); PG8_STAGE(PG8_SA(1, 0), a3, voffA);
            PG8_BAR; PG8_WAIT_L(0); PG8_MMA(1, 0, At, B0); PG8_BAR; PG8_SCHED;
            PG8_STAGE(PG8_SB(1, 1), b3 + hstep, voffB);
            PG8_WAIT_V(6); PG8_BAR; PG8_MMA(1, 1, At, B1); PG8_BAR;
            }
        }
        if constexpr (ALIGN_EPI) { if (wr == 0) PG8_BAR; }
        if constexpr (!Epi::AFTER_DRAIN) { E(acc, cur, wr, wc, fr, fq); S.done(cur); }
        if (!has_next) break;
#pragma unroll
        for (int a = 0; a < 2; ++a)
#pragma unroll
            for (int b = 0; b < 2; ++b)
#pragma unroll
                for (int m = 0; m < 4; ++m)
#pragma unroll
                    for (int n = 0; n < 2; ++n) acc[a][b][m][n] = (f32x4){0.f, 0.f, 0.f, 0.f};
        cur = nxt; cA = nA; cB = nB; ++ui;
        if constexpr (ALIGN_EPI) { if (wr == 1) PG8_BAR; }
    }
    PG8_WAIT_V(0);
    if constexpr (!ALIGN_EPI) { if (wr == 0) PG8_BAR; }
    PG8_BAR;
    if constexpr (Epi::AFTER_DRAIN) { E.fused(acc, cur, wr, wc, fr, fq, lds, wid, lane); S.done(cur); }
#undef PG8_SA
#undef PG8_SB
#undef PG8_STAGE
#undef PG8_LDA
#undef PG8_LDB
#undef PG8_MMA
#undef PG8_WAIT_V
#undef PG8_WAIT_L
#undef PG8_BAR
#undef PG8_SCHED
}
}
#define GAS __attribute__((address_space(1)))
#define LAS __attribute__((address_space(3)))
typedef unsigned short bf16;
typedef unsigned v4u __attribute__((ext_vector_type(4)));
typedef float f32x4 __attribute__((ext_vector_type(4)));
typedef short bf16x8 __attribute__((ext_vector_type(8)));
typedef GAS unsigned gu32;
typedef GAS unsigned long long gu64;
#define RLX_AGENT __ATOMIC_RELAXED, __HIP_MEMORY_SCOPE_AGENT
#define LDS_WAIT() asm volatile("s_waitcnt lgkmcnt(0)" ::: "memory")
#define VM_WAIT() asm volatile("s_waitcnt vmcnt(0)" ::: "memory")
__device__ __forceinline__ unsigned long long rt() { return __builtin_amdgcn_s_memrealtime(); }
__device__ __forceinline__ unsigned f2bf(float f) { unsigned u = __builtin_bit_cast(unsigned, f); return (u + 0x7fffu + ((u >> 16) & 1u)) >> 16; }
__device__ __forceinline__ unsigned pk2(float lo, float hi) { return f2bf(lo) | (f2bf(hi) << 16); }

#define XB_TMO      128
#define XB_XCNT(j)  (256  + 64 * (j))
#define XB_XSUB(j)  (1280 + 64 * (j))
#define XB_XGEN(j)  (2304 + 64 * (j))
#define XB_TOP      3328
#define XB_TOPGEN   3392
#define XCD_BAR_WORDS 3456
#define XB_SPIN_CAP (1u << 18)

__device__ __forceinline__ unsigned xb_ld(unsigned* p)              { return __hip_atomic_load(p, __ATOMIC_RELAXED, __HIP_MEMORY_SCOPE_AGENT); }
__device__ __forceinline__ unsigned xb_add(unsigned* p, unsigned v) { return __hip_atomic_fetch_add(p, v, __ATOMIC_RELAXED, __HIP_MEMORY_SCOPE_AGENT); }
__device__ __forceinline__ unsigned xb_xcc_id() { return (unsigned)__builtin_amdgcn_s_getreg((3 << 11) | 20) & 0xFu; }
#define XB_SPIN(cond, bar) do { unsigned _sp = 0; while (cond) { __builtin_amdgcn_s_sleep(1); \
    if ((++_sp & 255u) == 0u) { if (xb_ld(&(bar)[XB_TMO])) break; if (_sp > XB_SPIN_CAP) { atomicAdd(&(bar)[XB_TMO], 1u); break; } } } } while (0)

struct XcdBarrier {
    unsigned* bar; unsigned x;
    volatile LAS unsigned* st;
};

__device__ __forceinline__ XcdBarrier xcd_barrier_post(unsigned* bar, volatile LAS unsigned* st) {
    XcdBarrier b; b.bar = bar; b.x = xb_xcc_id(); b.st = st;
    if (threadIdx.x == 0) (void)xb_add(&bar[XB_XCNT(b.x)], 1u);
    return b;
}
__device__ __forceinline__ void xcd_barrier_complete(unsigned* bar, unsigned x, unsigned& nloc, unsigned& nx) {
    const unsigned G = gridDim.x * gridDim.y * gridDim.z;
    unsigned sum, cnt, mine, sp = 0u;
    for (;;) {
        sum = 0u; cnt = 0u; mine = 0u;
#pragma unroll
        for (unsigned j = 0; j < 16; ++j) { const unsigned c = xb_ld(&bar[XB_XCNT(j)]); sum += c; cnt += (c > 0u) ? 1u : 0u; mine = (j == x) ? c : mine; }
        if (sum == G) break;
        __builtin_amdgcn_s_sleep(1);
        if ((++sp & 255u) == 0u) { if (xb_ld(&bar[XB_TMO])) break; if (sp > XB_SPIN_CAP) { atomicAdd(&bar[XB_TMO], 1u); break; } }
    }
    nloc = mine > 0u ? mine : 1u; nx = cnt > 0u ? cnt : 1u;
}

__device__ __forceinline__ void xcd_barrier(const XcdBarrier& b) {
    asm volatile("s_waitcnt vmcnt(0)" ::: "memory");
    __syncthreads();
    if (threadIdx.x == 0) {
        unsigned* bar = b.bar;
        __builtin_amdgcn_s_waitcnt(0);
        unsigned nloc = b.st[0], nx = b.st[1];
        if (nloc == 0u) { xcd_barrier_complete(bar, b.x, nloc, nx); b.st[0] = nloc; b.st[1] = nx; }
        const unsigned old = xb_add(&bar[XB_XSUB(b.x)], 1u);
        const unsigned gen = old / nloc;
        if (old + 1u == (gen + 1u) * nloc) {
            __builtin_amdgcn_fence(__ATOMIC_RELEASE, "agent");
            asm volatile("s_waitcnt vmcnt(0)" ::: "memory");
            const unsigned og = xb_add(&bar[XB_TOP], 1u);
            const unsigned tg = og / nx;
            if (og + 1u == (tg + 1u) * nx) xb_add(&bar[XB_TOPGEN], 1u);
            else XB_SPIN(xb_ld(&bar[XB_TOPGEN]) == tg, bar);
            __builtin_amdgcn_fence(__ATOMIC_ACQUIRE, "agent");
            xb_add(&bar[XB_XGEN(b.x)], 1u);
            asm volatile("s_waitcnt vmcnt(0)" ::: "memory");
        } else {
            XB_SPIN(xb_ld(&bar[XB_XGEN(b.x)]) == gen, bar);
            __builtin_amdgcn_fence(__ATOMIC_ACQUIRE, "agent");
            asm volatile("s_waitcnt vmcnt(0)" ::: "memory");
        }
    }
    __syncthreads();
}
constexpr int NWAVES = 8;
constexpr int BATCH = 2, SEQ = 8192, NMETA = 16, LTOK = SEQ + NMETA  , DM = 1024, INDIM = 2560, RWKV_IN = 1792, RDIM = 512, DFF = 2816;
constexpr int MROWS = BATCH * LTOK  , MPAD = 16640  , MREAL = BATCH * SEQ;
constexpr int QOFF = RWKV_IN, KOFF = RWKV_IN + 512, VOFF = RWKV_IN + 512 + 128;
constexpr size_t MiB = 1u << 20;
constexpr size_t WS_CTL = 0, CTL_ZERO_BYTES = 64 * 1024;
constexpr size_t WS_WIN = 1 * MiB, WS_WOUT = 6 * MiB, WS_WUP = 8 * MiB, WS_WDN = 19 * MiB;
constexpr size_t WS_SSQP = 24 * MiB + 512 * 1024;
constexpr size_t WS_KN = 26 * MiB;
constexpr size_t WS_XN = 30 * MiB + 512 * 1024;
constexpr size_t WS_P = 63 * MiB;
constexpr size_t WS_YMIX = 144 * MiB + 512 * 1024;
constexpr size_t WS_H1B = 177 * MiB;
constexpr size_t WS_TAIL = 209 * MiB + 512 * 1024;
constexpr size_t WS_ACT = WS_XN;
constexpr size_t WS_END = 256 * MiB;
constexpr size_t PREPB = (size_t)MROWS * RDIM * 2;
static_assert(WS_WDN + (size_t)DM * DFF * 2 <= WS_SSQP && WS_SSQP + 16ull * MPAD * 4 <= WS_KN && WS_KN + (size_t)MROWS * 128 * 2 <= WS_XN, "ws map 1");
static_assert(WS_XN + (size_t)MPAD * DM * 2 <= WS_P && WS_XN + (size_t)MROWS * RDIM * 4 <= WS_P && WS_P + (size_t)MPAD * INDIM * 2 <= WS_YMIX && WS_YMIX + (size_t)MPAD * DM * 2 <= WS_H1B, "ws map 2");
static_assert(WS_H1B + (size_t)MPAD * DM * 2 <= WS_TAIL && WS_H1B + PREPB <= WS_TAIL && WS_TAIL + 2 * PREPB <= WS_END && WS_ACT + (size_t)MREAL * DFF * 2 <= WS_YMIX, "ws map 3");
static_assert(3 * PREPB <= (size_t)MREAL * DM * 4, "d_out holds RB, K2B, VB");
constexpr int CW_BAR = 4096;
constexpr int RING_OFF = 0, RING_BYTES = 131072, HALO_OFF = RING_BYTES  , LDSCTL_OFF = RING_BYTES + 8192, MISC_OFF = LDSCTL_OFF + 320, LDS_BYTES = 147456;

__constant__ unsigned char c_bucket[128] = {0, 1, 2, 3, 4, 5, 6, 7, 8, 9, 10, 11, 12, 13, 14, 15, 16, 16, 16, 17, 17, 18, 18, 18, 19, 19, 19, 20, 20, 20, 20, 21, 21, 21, 21, 22, 22, 22, 22, 22, 23, 23, 23, 23, 23, 23, 24, 24, 24, 24, 24, 24, 25, 25, 25, 25, 25, 25, 25, 26, 26, 26, 26, 26, 26, 26, 26, 27, 27, 27, 27, 27, 27, 27, 27, 27, 27, 28, 28, 28, 28, 28, 28, 28, 28, 28, 28, 29, 29, 29, 29, 29, 29, 29, 29, 29, 29, 29, 29, 30, 30, 30, 30, 30, 30, 30, 30, 30, 30, 30, 30, 30, 30, 31, 31, 31, 31, 31, 31, 31, 31, 31, 31, 31, 31, 31, 31, 31};

struct Frame {
    LAS unsigned char* lds;
    volatile LAS unsigned* MISC;
    gu32* ctl;
    int tid, lane, wave, vcu, G;
    const float* in[25]; float* out; unsigned char* ws;
};
__device__ __forceinline__ float wave_sum(float v) {
#pragma unroll
    for (int o = 1; o < 64; o <<= 1) v += __shfl_xor(v, o);
    return v;
}
__device__ __forceinline__ float bf2f(bf16 u) { return __uint_as_float((unsigned)u << 16); }
__device__ __forceinline__ float bflo(unsigned u) { return __uint_as_float(u << 16); }
__device__ __forceinline__ float bfhi(unsigned u) { return __uint_as_float(u & 0xffff0000u); }
__device__ __forceinline__ float sigmoidf_(float x) { return 1.0f / (1.0f + __expf(-x)); }

enum { I_X = 0, I_META, I_RELB, I_N1W, I_WIN, I_MU, I_W0, I_WDEC, I_A0, I_AUP, I_GUP, I_KK, I_KA, I_RK, I_LNW, I_LNB, I_QNW, I_KNW, I_SINK, I_WOUT, I_N2W, I_WUP, I_CONVW, I_CONVB, I_WDN };

__device__ __forceinline__ void p0_transpose_item(const float* W, int K, int N, bf16* WT, const float* ksc, int mode, LAS float* scr, int item, int lane) {
    const int nblk = N / 32, kb = item / nblk, nb = item % nblk, k0 = 64 * kb, n0 = 32 * nb;
#pragma unroll 8
    for (int i = 0; i < 32; ++i) { const int kk = 2 * i + (lane >> 5); float w = W[(size_t)(k0 + kk) * N + n0 + (lane & 31)]; if (ksc) w *= ksc[k0 + kk]; scr[kk * 33 + (lane & 31)] = w; }
    LDS_WAIT(); asm volatile("" ::: "memory");
    int d0 = n0;
    if (mode == 1) d0 = n0 < DFF ? (n0 / 128) * 256 + (n0 % 128) : ((n0 - DFF) / 128) * 256 + 128 + ((n0 - DFF) % 128);
    const int c = lane & 7;
#pragma unroll
    for (int j = 0; j < 4; ++j) { const int n = (lane >> 3) + 8 * j; const LAS float* s = scr + (8 * c) * 33 + n;
        v4u o; o.x = pk2(s[0 * 33], s[1 * 33]); o.y = pk2(s[2 * 33], s[3 * 33]); o.z = pk2(s[4 * 33], s[5 * 33]); o.w = pk2(s[6 * 33], s[7 * 33]);
        *(GAS v4u*)(WT + (size_t)(d0 + n) * K + k0 + 8 * c) = o; }
    LDS_WAIT(); asm volatile("" ::: "memory");
}
__device__ __forceinline__ void p0_prologue(Frame& F) {
    LAS float* scr = (LAS float*)(F.lds + RING_OFF + F.wave * 16384);
    const int gw = F.vcu * NWAVES + F.wave, NGW = F.G * NWAVES;
    constexpr int I_1 = (DM / 64) * (INDIM / 32), I_2 = (DM / 64) * (DM / 32), I_3 = (DM / 64) * (2 * DFF / 32), I_4 = (DFF / 64) * (DM / 32);
    constexpr int NITEMS = I_1 + I_2 + I_3 + I_4;
    for (int it = gw; it < NITEMS; it += NGW) {
        int r = it;
        if (r < I_1) { p0_transpose_item(F.in[I_WIN], DM, INDIM, (bf16*)(F.ws + WS_WIN), F.in[I_N1W], 0, scr, r, F.lane); continue; } r -= I_1;
        if (r < I_2) { p0_transpose_item(F.in[I_WOUT], DM, DM, (bf16*)(F.ws + WS_WOUT), nullptr, 0, scr, r, F.lane); continue; } r -= I_2;
        if (r < I_3) { p0_transpose_item(F.in[I_WUP], DM, 2 * DFF, (bf16*)(F.ws + WS_WUP), F.in[I_N2W], 1, scr, r, F.lane); continue; } r -= I_3;
        p0_transpose_item(F.in[I_WDN], DFF, DM, (bf16*)(F.ws + WS_WDN), nullptr, 0, scr, r, F.lane);
    }
    bf16* XN = (bf16*)(F.ws + WS_XN);
    for (int R = gw; R < MPAD; R += NGW) {
        GAS unsigned long long* o8 = (GAS unsigned long long*)(XN + (size_t)R * DM) + F.lane;
        if (R >= MROWS) {
#pragma unroll
            for (int j = 0; j < 4; ++j) o8[64 * j] = 0ull;
            continue; }
        const int b = R / LTOK, pos = R % LTOK;
        const float* src = pos < NMETA ? F.in[I_META] + (size_t)pos * DM : F.in[I_X] + ((size_t)b * SEQ + pos - NMETA) * DM;
        const GAS f32x4* xr = (const GAS f32x4*)src + F.lane;
        f32x4 v[4]; float s = 0.f;
#pragma unroll
        for (int j = 0; j < 4; ++j) { v[j] = xr[64 * j]; s += (v[j].x * v[j].x + v[j].y * v[j].y) + (v[j].z * v[j].z + v[j].w * v[j].w); }
        const float rs = 1.0f / sqrtf(wave_sum(s) * (1.0f / DM) + 1e-6f);
#pragma unroll
        for (int j = 0; j < 4; ++j) o8[64 * j] = (unsigned long long)pk2(v[j].x * rs, v[j].y * rs) | ((unsigned long long)pk2(v[j].z * rs, v[j].w * rs) << 32);
    }
}

__device__ __forceinline__ void p2_prep(Frame& F) {
    LAS float* inb = (LAS float*)(F.lds + RING_OFF + F.wave * 16384);
    const int lane = F.lane, gw = F.vcu * NWAVES + F.wave, NGW = F.G * NWAVES;
    const bf16* P = (const bf16*)(F.ws + WS_P);
    bf16* RB = (bf16*)F.out; bf16* K2B = (bf16*)((unsigned char*)F.out + PREPB); bf16* VB = (bf16*)((unsigned char*)F.out + 2 * PREPB);
    bf16* KKB = (bf16*)(F.ws + WS_H1B); bf16* BB = (bf16*)(F.ws + WS_TAIL); bf16* GB = (bf16*)(F.ws + WS_TAIL + PREPB);
    float* EB = (float*)(F.ws + WS_XN); bf16* KN = (bf16*)(F.ws + WS_KN);
    const float* mu = F.in[I_MU];
    for (int job = gw; job < MROWS / 8; job += NGW) {
        const int R0 = job * 8, pos0 = R0 % LTOK;
#pragma unroll 1
        for (int t = 0; t < 8; ++t) { const bf16* pr = P + (size_t)(R0 + t) * INDIM; const bool hp = (pos0 + t) > 0;
#pragma unroll
            for (int i2 = 0; i2 < 4; ++i2) { const int c = 1536 + 64 * i2 + lane; const float cur = bf2f(pr[c]); const float prv = hp ? bf2f(pr[c - INDIM]) : 0.f;
                const float xs = cur + (prv - cur) * mu[c];
                const float val = i2 == 0 ? tanhf(xs) : (i2 == 1 ? xs : sigmoidf_(xs));
                inb[(64 * i2 + lane) * 8 + t] = val; } }
        LDS_WAIT(); asm volatile("" ::: "memory");
        float acc[8][8], av[8][8];
#pragma unroll
        for (int i = 0; i < 8; ++i)
#pragma unroll
            for (int t = 0; t < 8; ++t) acc[i][t] = 0.f;
#pragma unroll 2
        for (int j = 0; j < 64; ++j) { const f32x4 a0 = *(const LAS f32x4*)(inb + j * 8), a1 = *(const LAS f32x4*)(inb + j * 8 + 4);
#pragma unroll
            for (int i = 0; i < 8; ++i) { const float w = F.in[I_WDEC][j * RDIM + 64 * i + lane];
                acc[i][0] += w * a0.x; acc[i][1] += w * a0.y; acc[i][2] += w * a0.z; acc[i][3] += w * a0.w; acc[i][4] += w * a1.x; acc[i][5] += w * a1.y; acc[i][6] += w * a1.z; acc[i][7] += w * a1.w; } }
#pragma unroll
        for (int i = 0; i < 8; ++i) { const float w0 = F.in[I_W0][64 * i + lane];
#pragma unroll
            for (int t = 0; t < 8; ++t) EB[(size_t)(R0 + t) * RDIM + 64 * i + lane] = 0.60653065971f * sigmoidf_(w0 + acc[i][t]); }
#pragma unroll
        for (int i = 0; i < 8; ++i)
#pragma unroll
            for (int t = 0; t < 8; ++t) acc[i][t] = 0.f;
#pragma unroll 2
        for (int j = 0; j < 64; ++j) { const f32x4 a0 = *(const LAS f32x4*)(inb + (64 + j) * 8), a1 = *(const LAS f32x4*)(inb + (64 + j) * 8 + 4);
#pragma unroll
            for (int i = 0; i < 8; ++i) { const float w = F.in[I_AUP][j * RDIM + 64 * i + lane];
                acc[i][0] += w * a0.x; acc[i][1] += w * a0.y; acc[i][2] += w * a0.z; acc[i][3] += w * a0.w; acc[i][4] += w * a1.x; acc[i][5] += w * a1.y; acc[i][6] += w * a1.z; acc[i][7] += w * a1.w; } }
#pragma unroll
        for (int i = 0; i < 8; ++i) { const float a0 = F.in[I_A0][64 * i + lane];
#pragma unroll
            for (int t = 0; t < 8; ++t) av[i][t] = sigmoidf_(a0 + acc[i][t]); }
#pragma unroll
        for (int i = 0; i < 8; ++i) { const int c = 64 * i + lane; const float kkw = F.in[I_KK][c], kaw = F.in[I_KA][c], mur = mu[c], muk = mu[512 + c], muv = mu[1024 + c];
#pragma unroll
            for (int t = 0; t < 8; ++t) { const bf16* pr = P + (size_t)(R0 + t) * INDIM; const bool hp = (pos0 + t) > 0;
                const float rc = bf2f(pr[c]), kc = bf2f(pr[512 + c]), vc = bf2f(pr[1024 + c]);
                const float rp = hp ? bf2f(pr[c - INDIM]) : 0.f, kp = hp ? bf2f(pr[512 + c - INDIM]) : 0.f, vp = hp ? bf2f(pr[1024 + c - INDIM]) : 0.f;
                const float r = rc + (rp - rc) * mur, k = kc + (kp - kc) * muk, v = vc + (vp - vc) * muv;
                const float kkv = k * kkw; const float ss = wave_sum(kkv * kkv); const float kk = kkv / fmaxf(sqrtf(ss), 1e-12f);
                const float a = av[i][t]; const float k2 = k * (1.0f + (a - 1.0f) * kaw);
                const size_t o = (size_t)(R0 + t) * RDIM + c;
                RB[o] = (bf16)f2bf(r); K2B[o] = (bf16)f2bf(k2); VB[o] = (bf16)f2bf(v); KKB[o] = (bf16)f2bf(kk); BB[o] = (bf16)f2bf(kk * a); } }
#pragma unroll
        for (int i = 0; i < 8; ++i)
#pragma unroll
            for (int t = 0; t < 8; ++t) acc[i][t] = 0.f;
#pragma unroll 2
        for (int j = 0; j < 128; ++j) { const f32x4 a0 = *(const LAS f32x4*)(inb + (128 + j) * 8), a1 = *(const LAS f32x4*)(inb + (128 + j) * 8 + 4);
#pragma unroll
            for (int i = 0; i < 8; ++i) { const float w = F.in[I_GUP][j * RDIM + 64 * i + lane];
                acc[i][0] += w * a0.x; acc[i][1] += w * a0.y; acc[i][2] += w * a0.z; acc[i][3] += w * a0.w; acc[i][4] += w * a1.x; acc[i][5] += w * a1.y; acc[i][6] += w * a1.z; acc[i][7] += w * a1.w; } }
#pragma unroll
        for (int i = 0; i < 8; ++i)
#pragma unroll
            for (int t = 0; t < 8; ++t) GB[(size_t)(R0 + t) * RDIM + 64 * i + lane] = (bf16)f2bf(acc[i][t]);
#pragma unroll 1
        for (int t = 0; t < 8; ++t)
#pragma unroll
            for (int hk = 0; hk < 2; ++hk) { const float k = bf2f(P[(size_t)(R0 + t) * INDIM + KOFF + 64 * hk + lane]); const float ss = wave_sum(k * k);
                KN[(size_t)(R0 + t) * 128 + 64 * hk + lane] = (bf16)f2bf(k * (1.0f / sqrtf(ss * (1.0f / 64.0f) + 1e-6f)) * F.in[I_KNW][lane]); }
        LDS_WAIT(); asm volatile("" ::: "memory");
    }
}

__device__ __forceinline__ void p3_scan(Frame& F, int bh) {
    const int b = bh >> 3, h = bh & 7, tid = F.tid;
    LAS float* sw = (LAS float*)(F.lds + RING_OFF); LAS float* sa = sw + 2048; LAS float* sb = sa + 2048; LAS float* sk = sb + 2048; LAS float* sr = sk + 2048; LAS float* sv = sr + 2048; LAS float* sy = sv + 2048;
    const bf16* RB = (const bf16*)F.out; const bf16* K2B = (const bf16*)((unsigned char*)F.out + PREPB); const bf16* VB = (const bf16*)((unsigned char*)F.out + 2 * PREPB);
    const bf16* KKB = (const bf16*)(F.ws + WS_H1B); const bf16* BB = (const bf16*)(F.ws + WS_TAIL);
    float* EB = (float*)(F.ws + WS_XN);
    const int i = tid >> 2, q = tid & 3;
    float S[16];
#pragma unroll
    for (int j = 0; j < 16; ++j) S[j] = 0.f;
#pragma unroll 1
    for (int c0 = 0; c0 < LTOK; c0 += 32) {
        const int nst = (LTOK - c0) < 32 ? (LTOK - c0) : 32;
        for (int e = tid; e < 2048; e += 512) { const int s = e >> 6, j = e & 63;
            if (s < nst) { const size_t idx = (size_t)(b * LTOK + c0 + s) * RDIM + 64 * h + j; const float kk = bf2f(KKB[idx]);
                sw[e] = __expf(-EB[idx]); sa[e] = -kk; sb[e] = bf2f(BB[idx]); sk[e] = bf2f(K2B[idx]); sr[e] = bf2f(RB[idx]); sv[e] = bf2f(VB[idx]); } }
        __syncthreads();
        if (tid < 256) {
#pragma unroll 1
            for (int s = 0; s < nst; ++s) {
                const int o = s * 64 + 16 * q; float wv[16], avv[16], bv[16], kv[16], rv[16];
#pragma unroll
                for (int j4 = 0; j4 < 4; ++j4) { const f32x4 t0 = *(const LAS f32x4*)(sw + o + 4 * j4), t1 = *(const LAS f32x4*)(sa + o + 4 * j4), t2 = *(const LAS f32x4*)(sb + o + 4 * j4), t3 = *(const LAS f32x4*)(sk + o + 4 * j4), t4 = *(const LAS f32x4*)(sr + o + 4 * j4);
#pragma unroll
                    for (int c = 0; c < 4; ++c) { wv[4 * j4 + c] = t0[c]; avv[4 * j4 + c] = t1[c]; bv[4 * j4 + c] = t2[c]; kv[4 * j4 + c] = t3[c]; rv[4 * j4 + c] = t4[c]; } }
                const float v = sv[s * 64 + i];
                float sacc = 0.f;
#pragma unroll
                for (int j = 0; j < 16; ++j) sacc += S[j] * avv[j];
                sacc += __shfl_xor(sacc, 1); sacc += __shfl_xor(sacc, 2);
                float y = 0.f;
#pragma unroll
                for (int j = 0; j < 16; ++j) { S[j] = S[j] * wv[j] + sacc * bv[j] + v * kv[j]; y += S[j] * rv[j]; }
                y += __shfl_xor(y, 1); y += __shfl_xor(y, 2);
                if (q == 0) sy[s * 64 + i] = y;
            }
        }
        __syncthreads();
        for (int e = tid; e < 2048; e += 512) { const int s = e >> 6, j = e & 63; if (s < nst) EB[(size_t)(b * LTOK + c0 + s) * RDIM + 64 * h + j] = sy[e]; }
    }
}

__device__ __forceinline__ void p3b_finalize(Frame& F) {
    const int lane = F.lane, gw = F.vcu * NWAVES + F.wave, NGW = F.G * NWAVES;
    const bf16* RB = (const bf16*)F.out; const bf16* K2B = (const bf16*)((unsigned char*)F.out + PREPB); const bf16* VB = (const bf16*)((unsigned char*)F.out + 2 * PREPB);
    const bf16* GB = (const bf16*)(F.ws + WS_TAIL + PREPB); const float* YR = (const float*)(F.ws + WS_XN); bf16* YMIX = (bf16*)(F.ws + WS_YMIX);
    for (int R = gw; R < MROWS; R += NGW) {
#pragma unroll
        for (int i = 0; i < 8; ++i) { const int c = 64 * i + lane; const size_t o = (size_t)R * RDIM + c;
            const float y = YR[o]; const float mean = wave_sum(y) * (1.0f / 64.0f); const float d = y - mean; const float var = wave_sum(d * d) * (1.0f / 64.0f);
            const float yn = d * (1.0f / sqrtf(var + 64e-5f)) * F.in[I_LNW][c] + F.in[I_LNB][c];
            const float r = bf2f(RB[o]), k2 = bf2f(K2B[o]), v = bf2f(VB[o]);
            const float bs = wave_sum(r * k2 * F.in[I_RK][c]);
            YMIX[(size_t)R * DM + c] = (bf16)f2bf((yn + bs * v) * bf2f(GB[o])); }
    }
}

__device__ __forceinline__ void p4_attention(Frame& F, int w0, int nw) {
    const int lane = F.lane;
    const bf16* P = (const bf16*)(F.ws + WS_P); const bf16* KN = (const bf16*)(F.ws + WS_KN); bf16* YMIX = (bf16*)(F.ws + WS_YMIX);
    const float* relb = F.in[I_RELB];
    constexpr int NPB = (LTOK + 63) / 64;
    for (int job = w0; job < BATCH * NPB * 8; job += nw) {
        const int hq = job & 7, pb = (job >> 3) % NPB, b = (job >> 3) / NPB, hkv = hq >> 2;
        const int qpos_raw = 64 * pb + lane; const bool live = qpos_raw < LTOK; const int qpos = live ? qpos_raw : LTOK - 1;
        const size_t R = (size_t)b * LTOK + qpos;
        float q[64], o[64];
        { const v4u* qp = (const v4u*)(P + R * INDIM + QOFF + 64 * hq); float ss = 0.f;
#pragma unroll
            for (int c8 = 0; c8 < 8; ++c8) { const v4u u = qp[c8]; q[8 * c8 + 0] = bflo(u.x); q[8 * c8 + 1] = bfhi(u.x); q[8 * c8 + 2] = bflo(u.y); q[8 * c8 + 3] = bfhi(u.y); q[8 * c8 + 4] = bflo(u.z); q[8 * c8 + 5] = bfhi(u.z); q[8 * c8 + 6] = bflo(u.w); q[8 * c8 + 7] = bfhi(u.w); }
#pragma unroll
            for (int d = 0; d < 64; ++d) ss += q[d] * q[d];
            const float rs = 0.125f / sqrtf(ss * (1.0f / 64.0f) + 1e-6f);
#pragma unroll
            for (int d = 0; d < 64; ++d) { q[d] = q[d] * rs * F.in[I_QNW][d]; o[d] = 0.f; } }
        float m = F.in[I_SINK][hq], l = 1.0f;
#pragma unroll 1
        for (int it = 0; it < NMETA + 128; ++it) {
            int kpos; bool valid; float bias;
            if (it < NMETA) { kpos = it; valid = kpos <= qpos; const int dist = qpos - kpos; const int bk = (dist >= 0 && dist < 128) ? c_bucket[dist] : 31; bias = relb[bk * 8 + hq]; }
            else { const int dd = it - NMETA; kpos = qpos - dd; valid = kpos >= NMETA; bias = relb[c_bucket[dd] * 8 + hq]; }
            if (kpos < 0) kpos = 0;
            const size_t KR = (size_t)b * LTOK + kpos;
            const v4u* kp = (const v4u*)(KN + KR * 128 + 64 * hkv);
            float s = 0.f;
#pragma unroll
            for (int c8 = 0; c8 < 8; ++c8) { const v4u u = kp[c8];
                s += q[8 * c8 + 0] * bflo(u.x) + q[8 * c8 + 1] * bfhi(u.x) + q[8 * c8 + 2] * bflo(u.y) + q[8 * c8 + 3] * bfhi(u.y) + q[8 * c8 + 4] * bflo(u.z) + q[8 * c8 + 5] * bfhi(u.z) + q[8 * c8 + 6] * bflo(u.w) + q[8 * c8 + 7] * bfhi(u.w); }
            s += bias;
            if (valid) {
                const float mn = fmaxf(m, s), alpha = __expf(m - mn), p = __expf(s - mn); l = l * alpha + p; m = mn;
                const v4u* vp = (const v4u*)(P + KR * INDIM + VOFF + 64 * hkv);
#pragma unroll
                for (int c8 = 0; c8 < 8; ++c8) { const v4u u = vp[c8];
                    o[8 * c8 + 0] = o[8 * c8 + 0] * alpha + p * bflo(u.x); o[8 * c8 + 1] = o[8 * c8 + 1] * alpha + p * bfhi(u.x); o[8 * c8 + 2] = o[8 * c8 + 2] * alpha + p * bflo(u.y); o[8 * c8 + 3] = o[8 * c8 + 3] * alpha + p * bfhi(u.y);
                    o[8 * c8 + 4] = o[8 * c8 + 4] * alpha + p * bflo(u.z); o[8 * c8 + 5] = o[8 * c8 + 5] * alpha + p * bfhi(u.z); o[8 * c8 + 6] = o[8 * c8 + 6] * alpha + p * bflo(u.w); o[8 * c8 + 7] = o[8 * c8 + 7] * alpha + p * bfhi(u.w); }
            }
        }
        if (live) { const float il = 1.0f / l; v4u* op = (v4u*)(YMIX + R * DM + 512 + 64 * hq);
#pragma unroll
            for (int c8 = 0; c8 < 8; ++c8) { v4u w; w.x = pk2(o[8 * c8 + 0] * il, o[8 * c8 + 1] * il); w.y = pk2(o[8 * c8 + 2] * il, o[8 * c8 + 3] * il); w.z = pk2(o[8 * c8 + 4] * il, o[8 * c8 + 5] * il); w.w = pk2(o[8 * c8 + 6] * il, o[8 * c8 + 7] * il); op[c8] = w; } }
    }
}

__device__ __forceinline__ void p5_meta_rows(Frame& F, int blk) {
    const int b = blk >> 1, row = 14 + (blk & 1), U = b * LTOK + row, tid = F.tid;
    LAS float* ys = (LAS float*)(F.lds + RING_OFF); LAS float* red = ys + 1024;
    const bf16* YMIX = (const bf16*)(F.ws + WS_YMIX); const bf16* WT = (const bf16*)(F.ws + WS_WOUT); bf16* H1B = (bf16*)(F.ws + WS_H1B); float* SSQP = (float*)(F.ws + WS_SSQP);
    for (int k = tid; k < DM; k += 512) ys[k] = bf2f(YMIX[(size_t)U * DM + k]);
    __syncthreads();
    float ssq = 0.f;
#pragma unroll 1
    for (int cc = 0; cc < 2; ++cc) { const int col = tid + 512 * cc; const v4u* wp = (const v4u*)(WT + (size_t)col * DM); float acc = 0.f;
#pragma unroll 4
        for (int k8 = 0; k8 < DM / 8; ++k8) { const v4u u = wp[k8]; const f32x4 y0 = *(const LAS f32x4*)(ys + 8 * k8), y1 = *(const LAS f32x4*)(ys + 8 * k8 + 4);
            acc += bflo(u.x) * y0.x + bfhi(u.x) * y0.y + bflo(u.y) * y0.z + bfhi(u.y) * y0.w + bflo(u.z) * y1.x + bfhi(u.z) * y1.y + bflo(u.w) * y1.z + bfhi(u.w) * y1.w; }
        const float h = F.in[I_META][(size_t)row * DM + col] + acc; ssq += h * h; H1B[(size_t)U * DM + col] = (bf16)f2bf(h); }
    ssq = wave_sum(ssq);
    if (F.lane == 0) red[F.wave] = ssq;
    __syncthreads();
    if (tid < 16) { float t = 0.f; if (tid == 0) { for (int w = 0; w < NWAVES; ++w) t += red[w]; } SSQP[(size_t)tid * MPAD + U] = t; }
    __syncthreads();
}

#ifndef MK_N_LAUNCHES
#define MK_N_LAUNCHES 8
#endif
constexpr int N_LAUNCHES = MK_N_LAUNCHES;
constexpr int PER_PHASE = 8;
struct Args { const float* in[25]; float* out; unsigned char* ws; int ph_lo, ph_hi; };
__global__ void __launch_bounds__(NWAVES * 64, 2) hymba_fwd(Args args) {
    extern __shared__ __attribute__((aligned(16))) unsigned char lds[];
    Frame F;
    F.lds = (LAS unsigned char*)lds;
    F.MISC = (volatile LAS unsigned*)(F.lds + MISC_OFF);
    F.tid = threadIdx.x; F.lane = F.tid & 63; F.wave = __builtin_amdgcn_readfirstlane(F.tid >> 6);
    F.G = gridDim.x; { const int bx = blockIdx.x; F.vcu = (F.G % 8 == 0) ? (bx % 8) * (F.G / 8) + bx / 8 : bx; }
    F.ws = args.ws; F.out = args.out; F.ctl = (gu32*)(args.ws + WS_CTL);
#pragma unroll
    for (int i = 0; i < 25; ++i) F.in[i] = args.in[i];
    for (int u = F.tid; u < (LDS_BYTES - LDSCTL_OFF) / 4; u += NWAVES * 64) ((LAS unsigned*)(F.lds + LDSCTL_OFF))[u] = 0u;
    __syncthreads();
    XcdBarrier bar; bar.bar = (unsigned*)(F.ctl + CW_BAR); bar.x = 0; bar.st = nullptr;
    if (N_LAUNCHES == 1) bar = xcd_barrier_post((unsigned*)(F.ctl + CW_BAR), F.MISC + 8);
    const int lo = args.ph_lo, hi = args.ph_hi;
#define IN(k) (lo <= (k) && (k) < hi)
#define SEAM(k) do { if (IN(k) && IN((k) + 1)) xcd_barrier(bar); } while (0)
    bf16* XN = (bf16*)(F.ws + WS_XN); bf16* PB = (bf16*)(F.ws + WS_P); bf16* YMIX = (bf16*)(F.ws + WS_YMIX); bf16* H1B = (bf16*)(F.ws + WS_H1B); bf16* ACT = (bf16*)(F.ws + WS_ACT);
    float* SSQP = (float*)(F.ws + WS_SSQP);

    if (IN(0)) { p0_prologue(F); SEAM(0); }
    if (IN(1)) {
        pg8::Gemm g{XN, (const bf16*)(F.ws + WS_WIN), MPAD, INDIM, DM}; pg8::StaticOrderT<0> S; S.init(MPAD, INDIM, F.G, (int)blockIdx.x);
        pg8::EpiBf16 E{PB, INDIM};
        pg8::gemm_phase<pg8::EpiBf16, pg8::StaticOrderT<0>, true, true>(F.lds + RING_OFF, g, S, E);
        SEAM(1);
    }
    if (IN(2)) { p2_prep(F); SEAM(2); }
    if (IN(3)) {
        if (blockIdx.x < 16) p3_scan(F, (int)blockIdx.x);
        else p4_attention(F, ((int)blockIdx.x - 16) * NWAVES + F.wave, (F.G - 16) * NWAVES);
        SEAM(3);
    }
    if (IN(4)) { p3b_finalize(F); SEAM(4); }
    if (IN(5)) {
        if (blockIdx.x < 4) p5_meta_rows(F, (int)blockIdx.x);
        pg8::Gemm g{YMIX, (const bf16*)(F.ws + WS_WOUT), MREAL, DM, DM}; pg8::StaticOrderT<1> S; S.init(MREAL, DM, F.G, (int)blockIdx.x);
        pg8::EpiH1 E{F.in[I_X], F.out, H1B, SSQP, MPAD};
        pg8::gemm_phase<pg8::EpiH1, pg8::StaticOrderT<1>, true, true>(F.lds + RING_OFF, g, S, E);
        SEAM(5);
    }
    if (IN(6)) {
        pg8::Gemm g{H1B, (const bf16*)(F.ws + WS_WUP), 66 * 256, 2 * DFF, DM}; pg8::StaticOrderT<2> S; S.init(66 * 256, 2 * DFF, F.G, (int)blockIdx.x);
        pg8::EpiAct E{ACT, SSQP, MPAD, F.in[I_CONVW], F.in[I_CONVB], (LAS float*)(F.lds + HALO_OFF)};
        pg8::gemm_phase<pg8::EpiAct, pg8::StaticOrderT<2>, true, true>(F.lds + RING_OFF, g, S, E);
        SEAM(6);
    }
    if (IN(7)) {
        pg8::Gemm g{ACT, (const bf16*)(F.ws + WS_WDN), MREAL, DM, DFF}; pg8::StaticOrderT<0> S; S.init(MREAL, DM, F.G, (int)blockIdx.x);
        pg8::EpiOut E{F.out};
        pg8::gemm_phase<pg8::EpiOut, pg8::StaticOrderT<0>, true, true>(F.lds + RING_OFF, g, S, E);
    }
#undef IN
#undef SEAM
}

extern "C" void kernel_launch(void* const* d_in, const int* in_sizes, int n_in, void* d_out, int out_size, void* d_ws, size_t ws_size, hipStream_t stream) {
    static int grid = 0;
    if (grid == 0) {
        if (n_in != 25 || out_size != MREAL * DM || ws_size < WS_END) { fprintf(stderr, "kernel_launch: unexpected shapes n_in %d out %d ws %zu\n", n_in, out_size, ws_size); grid = -1; return; }
        int dev = 0, cus = 0;
        if (hipGetDevice(&dev) != hipSuccess || hipDeviceGetAttribute(&cus, hipDeviceAttributeMultiprocessorCount, dev) != hipSuccess) { grid = -1; return; }
        if (hipFuncSetAttribute((const void*)hymba_fwd, hipFuncAttributeMaxDynamicSharedMemorySize, LDS_BYTES) != hipSuccess) { fprintf(stderr, "kernel_launch: hipFuncSetAttribute failed\n"); grid = -1; return; }
        (void)hipGetLastError();
        grid = cus;
    }
    if (grid < 0) return;
    (void)hipMemsetAsync((char*)d_ws + WS_CTL, 0, CTL_ZERO_BYTES, stream);
    Args a{};
    for (int i = 0; i < 25; ++i) a.in[i] = (const float*)d_in[i];
    a.out = (float*)d_out; a.ws = (unsigned char*)d_ws;
    for (int li = 0; li < N_LAUNCHES; ++li) {
        a.ph_lo = (N_LAUNCHES == 1) ? 0 : li; a.ph_hi = (N_LAUNCHES == 1) ? PER_PHASE : li + 1;
        hipLaunchKernelGGL(hymba_fwd, dim3(grid), dim3(NWAVES * 64), LDS_BYTES, stream, a);
    }
}
```

```cpp
#include <hip/hip_runtime.h>
#include <cstdio>
#include <cstdint>
namespace pg8 {
#define PG8_LAS __attribute__((address_space(3)))
typedef unsigned short bf16_t;
typedef short bf16x8 __attribute__((ext_vector_type(8)));
typedef float f32x4 __attribute__((ext_vector_type(4)));
typedef unsigned u32x4 __attribute__((ext_vector_type(4)));
constexpr int BM = 256, BK = 64, HALF = 128, HTB = HALF * BK * 2  , STAGE_BYTES = 8 * HTB, NXCD = 8, WGM = 8;

__host__ __device__ __forceinline__ int lds_byte(int r, int c) { const int st = (r >> 4) * 2 + (c >> 5), rr = r & 15, cc = c & 31, ob = rr * 64 + cc * 2; return st * 1024 + (ob ^ (((ob >> 9) & 1) << 5)); }
__host__ __device__ __forceinline__ void stage_rc(int b, int& R, int& C) { const int st = b / 1024, sb = b % 1024, swz = sb ^ (((sb >> 9) & 1) << 5); R = (st >> 1) * 16 + swz / 64; C = (st & 1) * 32 + (swz % 64) / 2; }
__host__ __device__ __forceinline__ int perm32(int rho) { const int n = rho >> 4, i = rho & 15; return 8 * (i >> 2) + 4 * n + (i & 3); }

struct Unit { int pm, pn; };
struct Gemm { const bf16_t* A; const bf16_t* Bt; int M, N, K; };

template <int AMODE> struct StaticOrderT {
    int nM, nN, nwg, G, c;
    __host__ __device__ void init(int M, int N, int G_, int c_) { nM = M / BM; nN = N / BM; nwg = nM * nN; G = G_; c = c_; }
    __host__ __device__ bool next(int i, Unit& u) const {
        const long L = (long)i * G + c; if (L >= nwg) return false;
        int wgid = (int)L; { const int q = nwg / NXCD, r = nwg % NXCD, xcd = wgid % NXCD, off = wgid / NXCD; wgid = (xcd < r ? xcd * (q + 1) : r * (q + 1) + (xcd - r) * q) + off; }
        const int nig = WGM * nN, gid = wgid / nig, fm = gid * WGM, gsz = (nM - fm) < WGM ? (nM - fm) : WGM;
        u.pm = fm + ((wgid % nig) % gsz); u.pn = (wgid % nig) / gsz; return true;
    }
    __host__ __device__ __forceinline__ int a_row0(const Unit& u) const { return AMODE == 0 ? u.pm * BM : (AMODE == 1 ? (u.pm >> 5) * 8208 + 16 + (u.pm & 31) * 256 : (u.pm / 33) * 8208 + 14 + 254 * (u.pm % 33)); }
    __device__ __forceinline__ void a_ready(const Unit&) const {}
    __device__ __forceinline__ void done(const Unit&) const {}
};

__device__ __forceinline__ unsigned cvt_pk_bf16(float lo, float hi) { unsigned r; asm volatile("v_cvt_pk_bf16_f32 %0, %1, %2" : "=v"(r) : "v"(lo), "v"(hi)); return r; }
typedef float f32x2 __attribute__((ext_vector_type(2)));
typedef unsigned u32x2 __attribute__((ext_vector_type(2)));
struct EpiBf16 {
    static constexpr bool PERM = true, AFTER_DRAIN = false;
    bf16_t* O; int ldc;
    __device__ __forceinline__ void operator()(f32x4 (&acc)[2][2][4][2], const Unit& u, int wr, int wc, int fr, int fq) const {
        const int row0 = u.pm * BM + wr * 64 + fr, col0 = u.pn * BM + wc * 32 + 8 * fq;
#pragma unroll
        for (int ai = 0; ai < 2; ++ai)
#pragma unroll
            for (int m = 0; m < 4; ++m) { bf16_t* rowp = O + (size_t)(row0 + ai * HALF + m * 16) * ldc + col0;
#pragma unroll
                for (int bj = 0; bj < 2; ++bj) { const f32x4 v0 = acc[ai][bj][m][0], v1 = acc[ai][bj][m][1];
                    u32x4 w; w.x = cvt_pk_bf16(v0[0], v0[1]); w.y = cvt_pk_bf16(v0[2], v0[3]); w.z = cvt_pk_bf16(v1[0], v1[1]); w.w = cvt_pk_bf16(v1[2], v1[3]);
                    *(u32x4*)(rowp + bj * HALF) = w; } }
    }
};
struct EpiH1 {
    static constexpr bool PERM = false, AFTER_DRAIN = false;
    const float* x; float* out; bf16_t* h1b; float* ssqp; int ssq_stride;
    __device__ __forceinline__ void operator()(f32x4 (&acc)[2][2][4][2], const Unit& u, int wr, int wc, int fr, int fq) const {
        const int col0 = u.pn * BM + wc * 32 + 4 * fq;
#pragma unroll
        for (int ai = 0; ai < 2; ++ai)
#pragma unroll
            for (int m = 0; m < 4; ++m) { const int rr = u.pm * BM + ai * HALF + wr * 64 + m * 16 + fr; const int U = (rr >> 13) * 8208 + 16 + (rr & 8191); float s = 0.f;
#pragma unroll
                for (int bj = 0; bj < 2; ++bj)
#pragma unroll
                    for (int n = 0; n < 2; ++n) { const size_t off = (size_t)rr * 1024 + col0 + bj * HALF + n * 16;
                        const f32x4 h = *(const f32x4*)(x + off) + acc[ai][bj][m][n]; *(f32x4*)(out + off) = h;
                        s += (h[0] * h[0] + h[1] * h[1]) + (h[2] * h[2] + h[3] * h[3]);
                        u32x2 w; w.x = cvt_pk_bf16(h[0], h[1]); w.y = cvt_pk_bf16(h[2], h[3]); *(u32x2*)(h1b + (size_t)U * 1024 + col0 + bj * HALF + n * 16) = w; }
                s += __shfl_xor(s, 16); s += __shfl_xor(s, 32);
                if (fq == 0) ssqp[(size_t)(u.pn * 4 + wc) * ssq_stride + U] = s; }
    }
};
struct EpiOut {
    static constexpr bool PERM = false, AFTER_DRAIN = false;
    float* out;
    __device__ __forceinline__ void operator()(f32x4 (&acc)[2][2][4][2], const Unit& u, int wr, int wc, int fr, int fq) const {
        const int col0 = u.pn * BM + wc * 32 + 4 * fq;
#pragma unroll
        for (int ai = 0; ai < 2; ++ai)
#pragma unroll
            for (int m = 0; m < 4; ++m) { const int rr = u.pm * BM + ai * HALF + wr * 64 + m * 16 + fr;
#pragma unroll
                for (int bj = 0; bj < 2; ++bj)
#pragma unroll
                    for (int n = 0; n < 2; ++n) { const size_t off = (size_t)rr * 1024 + col0 + bj * HALF + n * 16; *(f32x4*)(out + off) = *(const f32x4*)(out + off) + acc[ai][bj][m][n]; } }
    }
};
struct EpiAct {
    static constexpr bool PERM = true, AFTER_DRAIN = false;
    bf16_t* act; const float* ssqp; int ssq_stride; const float* conv_w; const float* conv_b; PG8_LAS float* halo;
    __device__ __forceinline__ void operator()(f32x4 (&acc)[2][2][4][2], const Unit& u, int wr, int wc, int fr, int fq) const {
        const int b = u.pm / 33, ti = u.pm % 33, lane = fq * 16 + fr;
#pragma unroll
        for (int ai = 0; ai < 2; ++ai)
#pragma unroll
            for (int m = 0; m < 4; ++m) { const int pos = 14 + 254 * ti + ai * HALF + wr * 64 + m * 16 + fr; float rs = 0.f;
                if (pos <= 8207) { const int U = b * 8208 + pos; float s = 0.f;
#pragma unroll
                    for (int p = 0; p < 16; ++p) s += ssqp[(size_t)p * ssq_stride + U];
                    rs = 1.0f / sqrtf(s * (1.0f / 1024.0f) + 1e-6f); }
#pragma unroll
                for (int bj = 0; bj < 2; ++bj)
#pragma unroll
                    for (int n = 0; n < 2; ++n) acc[ai][bj][m][n] = acc[ai][bj][m][n] * rs; }
        if (fr >= 14) {
#pragma unroll
            for (int ai = 0; ai < 2; ++ai)
#pragma unroll
                for (int bj = 0; bj < 2; ++bj)
#pragma unroll
                    for (int n = 0; n < 2; ++n) *(PG8_LAS f32x4*)(halo + ((2 * ai + wr) * 2 + (fr - 14)) * 256 + bj * 128 + wc * 32 + 8 * fq + 4 * n) = acc[ai][bj][3][n];
        }
        asm volatile("s_waitcnt lgkmcnt(0)" ::: "memory"); __builtin_amdgcn_s_barrier(); asm volatile("" ::: "memory");
        const int src1 = (lane & 48) | ((fr + 15) & 15), src2 = (lane & 48) | ((fr + 14) & 15);
        u32x2 res[2][4][2];
#pragma unroll
        for (int n = 0; n < 2; ++n) {
            const int jg = u.pn * 128 + wc * 32 + 8 * fq + 4 * n;
            const f32x4 g0 = *(const f32x4*)(conv_w + jg), g1 = *(const f32x4*)(conv_w + 5632 + jg), g2 = *(const f32x4*)(conv_w + 2 * 5632 + jg), gb = *(const f32x4*)(conv_b + jg);
            const f32x4 v0 = *(const f32x4*)(conv_w + 2816 + jg), v1 = *(const f32x4*)(conv_w + 5632 + 2816 + jg), v2 = *(const f32x4*)(conv_w + 2 * 5632 + 2816 + jg), vb = *(const f32x4*)(conv_b + 2816 + jg);
#pragma unroll
            for (int ai = 0; ai < 2; ++ai) { const int seg = 2 * ai + wr;
                f32x4 pg = (f32x4){0.f, 0.f, 0.f, 0.f}, pv = (f32x4){0.f, 0.f, 0.f, 0.f};
                if (seg > 0 && fr >= 14) { const PG8_LAS float* hp = halo + ((seg - 1) * 2 + (fr - 14)) * 256 + wc * 32 + 8 * fq + 4 * n; pg = *(const PG8_LAS f32x4*)hp; pv = *(const PG8_LAS f32x4*)(hp + 128); }
#pragma unroll
                for (int m = 0; m < 4; ++m) { const f32x4 xg = acc[ai][0][m][n], xv = acc[ai][1][m][n]; float o[4];
#pragma unroll
                    for (int c = 0; c < 4; ++c) {
                        const float zg1 = fr == 15 ? pg[c] : xg[c], zg2 = fr >= 14 ? pg[c] : xg[c], zv1 = fr == 15 ? pv[c] : xv[c], zv2 = fr >= 14 ? pv[c] : xv[c];
                        const float xg1 = __shfl(zg1, src1), xg2 = __shfl(zg2, src2), xv1 = __shfl(zv1, src1), xv2 = __shfl(zv2, src2);
                        const float gate = g0[c] * xg[c] + g1[c] * xg1 + g2[c] * xg2 + gb[c];
                        const float val = v0[c] * xv[c] + v1[c] * xv1 + v2[c] * xv2 + vb[c];
                        o[c] = gate * __builtin_amdgcn_rcpf(1.0f + __expf(-gate)) * val; }
                    res[ai][m][n].x = cvt_pk_bf16(o[0], o[1]); res[ai][m][n].y = cvt_pk_bf16(o[2], o[3]);
                    pg = xg; pv = xv; } }
        }
#pragma unroll
        for (int ai = 0; ai < 2; ++ai)
#pragma unroll
            for (int m = 0; m < 4; ++m) { const int r = ai * HALF + wr * 64 + m * 16 + fr, t = 254 * ti + r - 2;
                if (r >= 2 && t < 8192) { u32x4 w; w.x = res[ai][m][0].x; w.y = res[ai][m][0].y; w.z = res[ai][m][1].x; w.w = res[ai][m][1].y;
                    *(u32x4*)(act + (size_t)(b * 8192 + t) * 2816 + u.pn * 128 + wc * 32 + 8 * fq) = w; } }
    }
};

template <class Epi, class Sched, bool ALIGN_EPI = false, bool SP2 = false>
__device__ __forceinline__ void gemm_phase(PG8_LAS unsigned char* lds, const Gemm g, const Sched& S, const Epi& E) {
    const int tid = threadIdx.x, wid = __builtin_amdgcn_readfirstlane(tid >> 6), lane = tid & 63, wr = wid >> 2, wc = wid & 3, fr = lane & 15, fq = lane >> 4;
    const int K = g.K, nt = K / BK;
    unsigned voffA[2], voffB[2];
#pragma unroll
    for (int i = 0; i < 2; ++i) { int R, C; stage_rc(tid * 16 + i * 8192, R, C); const int Rb = Epi::PERM ? ((R & ~31) + perm32(R & 31)) : R;
        voffA[i] = (unsigned)(R * K + C) * 2u; voffB[i] = (unsigned)(Rb * K + C) * 2u; }
    const size_t kstep = (size_t)(BK * 2);
    const size_t hstep = (size_t)HALF * K * 2;
    const size_t tstep = 2 * hstep;
    const unsigned ldsw = (unsigned)wid * 1024u;
    const int aoff = lds_byte(wr * 64 + fr, fq * 8), boff = lds_byte(wc * 32 + fr, fq * 8);
#define PG8_SA(b, h) (((b) * 2 + (h)) * HTB)
#define PG8_SB(b, h) ((4 + (b) * 2 + (h)) * HTB)
#define PG8_STAGE(bufoff, gbase, voff) do { _Pragma("unroll") for (int _i = 0; _i < 2; ++_i) \
        __builtin_amdgcn_global_load_lds((const unsigned*)((const char*)(gbase) + (voff)[_i]), (PG8_LAS unsigned*)(lds + (bufoff) + ldsw + _i * 8192), 16, 0, 0); } while (0)
#define PG8_LDA(dst, b, h) do { _Pragma("unroll") for (int m = 0; m < 4; ++m) _Pragma("unroll") for (int k = 0; k < 2; ++k) dst[m][k] = *(const PG8_LAS bf16x8*)(lds + PG8_SA(b, h) + aoff + m * 2048 + k * 1024); } while (0)
#define PG8_LDB(dst, b, h) do { _Pragma("unroll") for (int n = 0; n < 2; ++n) _Pragma("unroll") for (int k = 0; k < 2; ++k) dst[n][k] = *(const PG8_LAS bf16x8*)(lds + PG8_SB(b, h) + boff + n * 2048 + k * 1024); } while (0)
#define PG8_MMA(ai, bj, At, Bt) do { __builtin_amdgcn_s_setprio(1); _Pragma("unroll") for (int m = 0; m < 4; ++m) _Pragma("unroll") for (int n = 0; n < 2; ++n) _Pragma("unroll") for (int k = 0; k < 2; ++k) \
        acc[ai][bj][m][n] = __builtin_amdgcn_mfma_f32_16x16x32_bf16(Bt[n][k], At[m][k], acc[ai][bj][m][n], 0, 0, 0); __builtin_amdgcn_s_setprio(0); } while (0)
#define PG8_WAIT_V(n) asm volatile("s_waitcnt vmcnt(" #n ")" ::: "memory")
#define PG8_WAIT_L(n) asm volatile("s_waitcnt lgkmcnt(" #n ")" ::: "memory")
#define PG8_BAR __builtin_amdgcn_s_barrier()
#define PG8_SCHED __builtin_amdgcn_sched_barrier(0)
    Unit cur, nxt; int ui = 0;
    if (!S.next(0, cur)) return;
    f32x4 acc[2][2][4][2];
#pragma unroll
    for (int a = 0; a < 2; ++a)
#pragma unroll
        for (int b = 0; b < 2; ++b)
#pragma unroll
            for (int m = 0; m < 4; ++m)
#pragma unroll
                for (int n = 0; n < 2; ++n) acc[a][b][m][n] = (f32x4){0.f, 0.f, 0.f, 0.f};
    bf16x8 At[4][2], B0[2][2], B1[2][2];
    const size_t rowb = (size_t)K * 2; const char* cA = (const char*)g.A + (size_t)S.a_row0(cur) * rowb; const char* cB = (const char*)g.Bt + (size_t)cur.pn * tstep;
    S.a_ready(cur);
    if constexpr (SP2) {
        PG8_STAGE(PG8_SB(0, 0), cB, voffB); PG8_STAGE(PG8_SB(0, 1), cB + hstep, voffB); PG8_STAGE(PG8_SA(0, 0), cA, voffA); PG8_STAGE(PG8_SA(0, 1), cA + hstep, voffA);
        if (wr == 1) PG8_BAR;
        PG8_WAIT_V(2); PG8_BAR;
        PG8_STAGE(PG8_SB(1, 0), cB + kstep, voffB); PG8_STAGE(PG8_SA(1, 0), cA + kstep, voffA); PG8_STAGE(PG8_SB(1, 1), cB + hstep + kstep, voffB);
        PG8_WAIT_V(6); PG8_BAR;
    } else {
        PG8_STAGE(PG8_SB(0, 0), cB, voffB); PG8_STAGE(PG8_SA(0, 0), cA, voffA); PG8_STAGE(PG8_SB(0, 1), cB + hstep, voffB); PG8_STAGE(PG8_SA(0, 1), cA + hstep, voffA);
        if (wr == 1) PG8_BAR;
        PG8_WAIT_V(4); PG8_BAR;
        PG8_STAGE(PG8_SB(1, 0), cB + kstep, voffB); PG8_STAGE(PG8_SA(1, 0), cA + kstep, voffA); PG8_STAGE(PG8_SB(1, 1), cB + hstep + kstep, voffB);
        PG8_WAIT_V(6); PG8_BAR;
    }
    for (;;) {
        const bool has_next = S.next(ui + 1, nxt);
        const char* nA = has_next ? (const char*)g.A + (size_t)S.a_row0(nxt) * rowb : cA; const char* nB = has_next ? (const char*)g.Bt + (size_t)nxt.pn * tstep : cB;
        for (int t = 0; t < nt; t += 2) {
            const bool last = (t == nt - 2);
            const char* a1 = cA + (size_t)(t + 1) * kstep;
            const char* a2 = last ? nA : cA + (size_t)(t + 2) * kstep; const char* b2 = last ? nB : cB + (size_t)(t + 2) * kstep;
            const char* a3 = a2 + kstep; const char* b3 = b2 + kstep;
            if (last && has_next) S.a_ready(nxt);
            if constexpr (SP2) {
            PG8_LDB(B0, 0, 0); PG8_LDB(B1, 0, 1); PG8_SCHED; PG8_LDA(At, 0, 0); PG8_STAGE(PG8_SA(1, 1), a1 + hstep, voffA);
            PG8_WAIT_V(8); PG8_WAIT_L(0); PG8_BAR; PG8_MMA(0, 0, At, B0); PG8_MMA(0, 1, At, B1); PG8_BAR; PG8_SCHED;
            PG8_LDA(At, 0, 1); PG8_STAGE(PG8_SB(0, 0), b2, voffB); PG8_STAGE(PG8_SB(0, 1), b2 + hstep, voffB); PG8_STAGE(PG8_SA(0, 0), a2, voffA);
            PG8_WAIT_V(8); PG8_WAIT_L(0); PG8_BAR; PG8_MMA(1, 0, At, B0); PG8_MMA(1, 1, At, B1); PG8_BAR; PG8_SCHED;
            PG8_LDB(B0, 1, 0); PG8_LDB(B1, 1, 1); PG8_SCHED; PG8_LDA(At, 1, 0); PG8_STAGE(PG8_SA(0, 1), a2 + hstep, voffA);
            PG8_WAIT_V(8); PG8_WAIT_L(0); PG8_BAR; PG8_MMA(0, 0, At, B0); PG8_MMA(0, 1, At, B1); PG8_BAR; PG8_SCHED;
            PG8_LDA(At, 1, 1); PG8_STAGE(PG8_SB(1, 0), b3, voffB); PG8_STAGE(PG8_SB(1, 1), b3 + hstep, voffB); PG8_STAGE(PG8_SA(1, 0), a3, voffA);
            PG8_WAIT_V(8); PG8_WAIT_L(0); PG8_BAR; PG8_MMA(1, 0, At, B0); PG8_MMA(1, 1, At, B1); PG8_BAR; PG8_SCHED;
            } else {
            PG8_LDB(B0, 0, 0); PG8_SCHED; PG8_LDA(At, 0, 0); PG8_STAGE(PG8_SA(1, 1), a1 + hstep, voffA);
            PG8_WAIT_L(8); PG8_BAR; PG8_WAIT_L(0); PG8_MMA(0, 0, At, B0); PG8_BAR; PG8_SCHED;
            PG8_LDB(B1, 0, 1); PG8_STAGE(PG8_SB(0, 0), b2, voffB);
            PG8_BAR; PG8_WAIT_L(0); PG8_MMA(0, 1, At, B1); PG8_BAR;
            PG8_LDA(At, 0, 1); PG8_STAGE(PG8_SA(0, 0), a2, voffA);
            PG8_BAR; PG8_WAIT_L(0); PG8_MMA(1, 0, At, B0); PG8_BAR; PG8_SCHED;
            PG8_STAGE(PG8_SB(0, 1), b2 + hstep, voffB);
            PG8_WAIT_V(6); PG8_BAR; PG8_MMA(1, 1, At, B1); PG8_BAR;
            PG8_LDB(B0, 1, 0); PG8_SCHED; PG8_LDA(At, 1, 0); PG8_STAGE(PG8_SA(0, 1), a2 + hstep, voffA);
            PG8_WAIT_L(8); PG8_BAR; PG8_WAIT_L(0); PG8_MMA(0, 0, At, B0); PG8_BAR; PG8_SCHED;
            PG8_LDB(B1, 1, 1); PG8_STAGE(PG8_SB(1, 0), b3, voffB);
            PG8_BAR; PG8_WAIT_L(0); PG8_MMA(0, 1, At, B1); PG8_BAR;
            PG8_LDA(At, 1, 1); PG8_STAGE(PG8_SA(1, 0), a3, voffA);
            PG8_BAR; PG8_WAIT_L(0); PG8_MMA(1, 0, At, B0); PG8_BAR; PG8_SCHED;
            PG8_STAGE(PG8_SB(1, 1), b3 + hstep, voffB);
            PG8_WAIT_V(6); PG8_BAR; PG8_MMA(1, 1, At, B1); PG8_BAR;
            }
        }
        if constexpr (ALIGN_EPI) { if (wr == 0) PG8_BAR; }
        if constexpr (!Epi::AFTER_DRAIN) { E(acc, cur, wr, wc, fr, fq); S.done(cur); }
        if (!has_next) break;
#pragma unroll
        for (int a = 0; a < 2; ++a)
#pragma unroll
            for (int b = 0; b < 2; ++b)
#pragma unroll
                for (int m = 0; m < 4; ++m)
#pragma unroll
                    for (int n = 0; n < 2; ++n) acc[a][b][m][n] = (f32x4){0.f, 0.f, 0.f, 0.f};
        cur = nxt; cA = nA; cB = nB; ++ui;
        if constexpr (ALIGN_EPI) { if (wr == 1) PG8_BAR; }
    }
    PG8_WAIT_V(0);
    if constexpr (!ALIGN_EPI) { if (wr == 0) PG8_BAR; }
    PG8_BAR;
    if constexpr (Epi::AFTER_DRAIN) { E.fused(acc, cur, wr, wc, fr, fq, lds, wid, lane); S.done(cur); }
#undef PG8_SA
#undef PG8_SB
#undef PG8_STAGE
#undef PG8_LDA
#undef PG8_LDB
#undef PG8_MMA
#undef PG8_WAIT_V
#undef PG8_WAIT_L
#undef PG8_BAR
#undef PG8_SCHED
}
}
#define GAS __attribute__((address_space(1)))
#define LAS __attribute__((address_space(3)))
typedef unsigned short bf16;
typedef unsigned v4u __attribute__((ext_vector_type(4)));
typedef float f32x4 __attribute__((ext_vector_type(4)));
typedef short bf16x8 __attribute__((ext_vector_type(8)));
typedef GAS unsigned gu32;
typedef GAS unsigned long long gu64;
#define RLX_AGENT __ATOMIC_RELAXED, __HIP_MEMORY_SCOPE_AGENT
#define LDS_WAIT() asm volatile("s_waitcnt lgkmcnt(0)" ::: "memory")
#define VM_WAIT() asm volatile("s_waitcnt vmcnt(0)" ::: "memory")
__device__ __forceinline__ unsigned long long rt() { return __builtin_amdgcn_s_memrealtime(); }
__device__ __forceinline__ unsigned f2bf(float f) { unsigned u = __builtin_bit_cast(unsigned, f); return (u + 0x7fffu + ((u >> 16) & 1u)) >> 16; }
__device__ __forceinline__ unsigned pk2(float lo, float hi) { return f2bf(lo) | (f2bf(hi) << 16); }

#define XB_TMO      128
#define XB_XCNT(j)  (256  + 64 * (j))
#define XB_XSUB(j)  (1280 + 64 * (j))
#define XB_XGEN(j)  (2304 + 64 * (j))
#define XB_TOP      3328
#define XB_TOPGEN   3392
#define XCD_BAR_WORDS 3456
#define XB_SPIN_CAP (1u << 18)

__device__ __forceinline__ unsigned xb_ld(unsigned* p)              { return __hip_atomic_load(p, __ATOMIC_RELAXED, __HIP_MEMORY_SCOPE_AGENT); }
__device__ __forceinline__ unsigned xb_add(unsigned* p, unsigned v) { return __hip_atomic_fetch_add(p, v, __ATOMIC_RELAXED, __HIP_MEMORY_SCOPE_AGENT); }
__device__ __forceinline__ unsigned xb_xcc_id() { return (unsigned)__builtin_amdgcn_s_getreg((3 << 11) | 20) & 0xFu; }
#define XB_SPIN(cond, bar) do { unsigned _sp = 0; while (cond) { __builtin_amdgcn_s_sleep(1); \
    if ((++_sp & 255u) == 0u) { if (xb_ld(&(bar)[XB_TMO])) break; if (_sp > XB_SPIN_CAP) { atomicAdd(&(bar)[XB_TMO], 1u); break; } } } } while (0)

struct XcdBarrier {
    unsigned* bar; unsigned x;
    volatile LAS unsigned* st;
};

__device__ __forceinline__ XcdBarrier xcd_barrier_post(unsigned* bar, volatile LAS unsigned* st) {
    XcdBarrier b; b.bar = bar; b.x = xb_xcc_id(); b.st = st;
    if (threadIdx.x == 0) (void)xb_add(&bar[XB_XCNT(b.x)], 1u);
    return b;
}
__device__ __forceinline__ void xcd_barrier_complete(unsigned* bar, unsigned x, unsigned& nloc, unsigned& nx) {
    const unsigned G = gridDim.x * gridDim.y * gridDim.z;
    unsigned sum, cnt, mine, sp = 0u;
    for (;;) {
        sum = 0u; cnt = 0u; mine = 0u;
#pragma unroll
        for (unsigned j = 0; j < 16; ++j) { const unsigned c = xb_ld(&bar[XB_XCNT(j)]); sum += c; cnt += (c > 0u) ? 1u : 0u; mine = (j == x) ? c : mine; }
        if (sum == G) break;
        __builtin_amdgcn_s_sleep(1);
        if ((++sp & 255u) == 0u) { if (xb_ld(&bar[XB_TMO])) break; if (sp > XB_SPIN_CAP) { atomicAdd(&bar[XB_TMO], 1u); break; } }
    }
    nloc = mine > 0u ? mine : 1u; nx = cnt > 0u ? cnt : 1u;
}

__device__ __forceinline__ void xcd_barrier(const XcdBarrier& b) {
    asm volatile("s_waitcnt vmcnt(0)" ::: "memory");
    __syncthreads();
    if (threadIdx.x == 0) {
        unsigned* bar = b.bar;
        __builtin_amdgcn_s_waitcnt(0);
        unsigned nloc = b.st[0], nx = b.st[1];
        if (nloc == 0u) { xcd_barrier_complete(bar, b.x, nloc, nx); b.st[0] = nloc; b.st[1] = nx; }
        const unsigned old = xb_add(&bar[XB_XSUB(b.x)], 1u);
        const unsigned gen = old / nloc;
        if (old + 1u == (gen + 1u) * nloc) {
            __builtin_amdgcn_fence(__ATOMIC_RELEASE, "agent");
            asm volatile("s_waitcnt vmcnt(0)" ::: "memory");
            const unsigned og = xb_add(&bar[XB_TOP], 1u);
            const unsigned tg = og / nx;
            if (og + 1u == (tg + 1u) * nx) xb_add(&bar[XB_TOPGEN], 1u);
            else XB_SPIN(xb_ld(&bar[XB_TOPGEN]) == tg, bar);
            __builtin_amdgcn_fence(__ATOMIC_ACQUIRE, "agent");
            xb_add(&bar[XB_XGEN(b.x)], 1u);
            asm volatile("s_waitcnt vmcnt(0)" ::: "memory");
        } else {
            XB_SPIN(xb_ld(&bar[XB_XGEN(b.x)]) == gen, bar);
            __builtin_amdgcn_fence(__ATOMIC_ACQUIRE, "agent");
            asm volatile("s_waitcnt vmcnt(0)" ::: "memory");
        }
    }
    __syncthreads();
}
constexpr int NWAVES = 8;
constexpr int BATCH = 2, SEQ = 8192, NMETA = 16, LTOK = SEQ + NMETA  , DM = 1024, INDIM = 2560, RWKV_IN = 1792, RDIM = 512, DFF = 2816;
constexpr int MROWS = BATCH * LTOK  , MPAD = 16640  , MREAL = BATCH * SEQ;
constexpr int QOFF = RWKV_IN, KOFF = RWKV_IN + 512, VOFF = RWKV_IN + 512 + 128;
constexpr size_t MiB = 1u << 20;
constexpr size_t WS_CTL = 0, CTL_ZERO_BYTES = 64 * 1024;
constexpr size_t WS_WIN = 1 * MiB, WS_WOUT = 6 * MiB, WS_WUP = 8 * MiB, WS_WDN = 19 * MiB;
constexpr size_t WS_SSQP = 24 * MiB + 512 * 1024;
constexpr size_t WS_KN = 26 * MiB;
constexpr size_t WS_XN = 30 * MiB + 512 * 1024;
constexpr size_t WS_P = 63 * MiB;
constexpr size_t WS_YMIX = 144 * MiB + 512 * 1024;
constexpr size_t WS_H1B = 177 * MiB;
constexpr size_t WS_TAIL = 209 * MiB + 512 * 1024;
constexpr size_t WS_ACT = WS_XN;
constexpr size_t WS_END = 256 * MiB;
constexpr size_t PREPB = (size_t)MROWS * RDIM * 2;
static_assert(WS_WDN + (size_t)DM * DFF * 2 <= WS_SSQP && WS_SSQP + 16ull * MPAD * 4 <= WS_KN && WS_KN + (size_t)MROWS * 128 * 2 <= WS_XN, "ws map 1");
static_assert(WS_XN + (size_t)MPAD * DM * 2 <= WS_P && WS_XN + (size_t)MROWS * RDIM * 4 <= WS_P && WS_P + (size_t)MPAD * INDIM * 2 <= WS_YMIX && WS_YMIX + (size_t)MPAD * DM * 2 <= WS_H1B, "ws map 2");
static_assert(WS_H1B + (size_t)MPAD * DM * 2 <= WS_TAIL && WS_H1B + PREPB <= WS_TAIL && WS_TAIL + 2 * PREPB <= WS_END && WS_ACT + (size_t)MREAL * DFF * 2 <= WS_YMIX, "ws map 3");
static_assert(3 * PREPB <= (size_t)MREAL * DM * 4, "d_out holds RB, K2B, VB");
constexpr int CW_BAR = 4096;
constexpr int RING_OFF = 0, RING_BYTES = 131072, HALO_OFF = RING_BYTES  , LDSCTL_OFF = RING_BYTES + 8192, MISC_OFF = LDSCTL_OFF + 320, LDS_BYTES = 147456;

__constant__ unsigned char c_bucket[128] = {0, 1, 2, 3, 4, 5, 6, 7, 8, 9, 10, 11, 12, 13, 14, 15, 16, 16, 16, 17, 17, 18, 18, 18, 19, 19, 19, 20, 20, 20, 20, 21, 21, 21, 21, 22, 22, 22, 22, 22, 23, 23, 23, 23, 23, 23, 24, 24, 24, 24, 24, 24, 25, 25, 25, 25, 25, 25, 25, 26, 26, 26, 26, 26, 26, 26, 26, 27, 27, 27, 27, 27, 27, 27, 27, 27, 27, 28, 28, 28, 28, 28, 28, 28, 28, 28, 28, 29, 29, 29, 29, 29, 29, 29, 29, 29, 29, 29, 29, 30, 30, 30, 30, 30, 30, 30, 30, 30, 30, 30, 30, 30, 30, 31, 31, 31, 31, 31, 31, 31, 31, 31, 31, 31, 31, 31, 31, 31};

struct Frame {
    LAS unsigned char* lds;
    volatile LAS unsigned* MISC;
    gu32* ctl;
    int tid, lane, wave, vcu, G;
    const float* in[25]; float* out; unsigned char* ws;
};
__device__ __forceinline__ float wave_sum(float v) {
#pragma unroll
    for (int o = 1; o < 64; o <<= 1) v += __shfl_xor(v, o);
    return v;
}
__device__ __forceinline__ float bf2f(bf16 u) { return __uint_as_float((unsigned)u << 16); }
__device__ __forceinline__ float bflo(unsigned u) { return __uint_as_float(u << 16); }
__device__ __forceinline__ float bfhi(unsigned u) { return __uint_as_float(u & 0xffff0000u); }
__device__ __forceinline__ float sigmoidf_(float x) { return 1.0f / (1.0f + __expf(-x)); }

enum { I_X = 0, I_META, I_RELB, I_N1W, I_WIN, I_MU, I_W0, I_WDEC, I_A0, I_AUP, I_GUP, I_KK, I_KA, I_RK, I_LNW, I_LNB, I_QNW, I_KNW, I_SINK, I_WOUT, I_N2W, I_WUP, I_CONVW, I_CONVB, I_WDN };

__device__ __forceinline__ void p0_transpose_item(const float* W, int K, int N, bf16* WT, const float* ksc, int mode, LAS float* scr, int item, int lane) {
    const int nblk = N / 32, kb = item / nblk, nb = item % nblk, k0 = 64 * kb, n0 = 32 * nb;
#pragma unroll 8
    for (int i = 0; i < 32; ++i) { const int kk = 2 * i + (lane >> 5); float w = W[(size_t)(k0 + kk) * N + n0 + (lane & 31)]; if (ksc) w *= ksc[k0 + kk]; scr[kk * 33 + (lane & 31)] = w; }
    LDS_WAIT(); asm volatile("" ::: "memory");
    int d0 = n0;
    if (mode == 1) d0 = n0 < DFF ? (n0 / 128) * 256 + (n0 % 128) : ((n0 - DFF) / 128) * 256 + 128 + ((n0 - DFF) % 128);
    const int c = lane & 7;
#pragma unroll
    for (int j = 0; j < 4; ++j) { const int n = (lane >> 3) + 8 * j; const LAS float* s = scr + (8 * c) * 33 + n;
        v4u o; o.x = pk2(s[0 * 33], s[1 * 33]); o.y = pk2(s[2 * 33], s[3 * 33]); o.z = pk2(s[4 * 33], s[5 * 33]); o.w = pk2(s[6 * 33], s[7 * 33]);
        *(GAS v4u*)(WT + (size_t)(d0 + n) * K + k0 + 8 * c) = o; }
    LDS_WAIT(); asm volatile("" ::: "memory");
}
__device__ __forceinline__ void p0_prologue(Frame& F) {
    LAS float* scr = (LAS float*)(F.lds + RING_OFF + F.wave * 16384);
    const int gw = F.vcu * NWAVES + F.wave, NGW = F.G * NWAVES;
    constexpr int I_1 = (DM / 64) * (INDIM / 32), I_2 = (DM / 64) * (DM / 32), I_3 = (DM / 64) * (2 * DFF / 32), I_4 = (DFF / 64) * (DM / 32);
    constexpr int NITEMS = I_1 + I_2 + I_3 + I_4;
    for (int it = gw; it < NITEMS; it += NGW) {
        int r = it;
        if (r < I_1) { p0_transpose_item(F.in[I_WIN], DM, INDIM, (bf16*)(F.ws + WS_WIN), F.in[I_N1W], 0, scr, r, F.lane); continue; } r -= I_1;
        if (r < I_2) { p0_transpose_item(F.in[I_WOUT], DM, DM, (bf16*)(F.ws + WS_WOUT), nullptr, 0, scr, r, F.lane); continue; } r -= I_2;
        if (r < I_3) { p0_transpose_item(F.in[I_WUP], DM, 2 * DFF, (bf16*)(F.ws + WS_WUP), F.in[I_N2W], 1, scr, r, F.lane); continue; } r -= I_3;
        p0_transpose_item(F.in[I_WDN], DFF, DM, (bf16*)(F.ws + WS_WDN), nullptr, 0, scr, r, F.lane);
    }
    bf16* XN = (bf16*)(F.ws + WS_XN);
    for (int R = gw; R < MPAD; R += NGW) {
        GAS unsigned long long* o8 = (GAS unsigned long long*)(XN + (size_t)R * DM) + F.lane;
        if (R >= MROWS) {
#pragma unroll
            for (int j = 0; j < 4; ++j) o8[64 * j] = 0ull;
            continue; }
        const int b = R / LTOK, pos = R % LTOK;
        const float* src = pos < NMETA ? F.in[I_META] + (size_t)pos * DM : F.in[I_X] + ((size_t)b * SEQ + pos - NMETA) * DM;
        const GAS f32x4* xr = (const GAS f32x4*)src + F.lane;
        f32x4 v[4]; float s = 0.f;
#pragma unroll
        for (int j = 0; j < 4; ++j) { v[j] = xr[64 * j]; s += (v[j].x * v[j].x + v[j].y * v[j].y) + (v[j].z * v[j].z + v[j].w * v[j].w); }
        const float rs = 1.0f / sqrtf(wave_sum(s) * (1.0f / DM) + 1e-6f);
#pragma unroll
        for (int j = 0; j < 4; ++j) o8[64 * j] = (unsigned long long)pk2(v[j].x * rs, v[j].y * rs) | ((unsigned long long)pk2(v[j].z * rs, v[j].w * rs) << 32);
    }
}

__device__ __forceinline__ void p2_prep(Frame& F) {
    LAS float* inb = (LAS float*)(F.lds + RING_OFF + F.wave * 16384);
    const int lane = F.lane, gw = F.vcu * NWAVES + F.wave, NGW = F.G * NWAVES;
    const bf16* P = (const bf16*)(F.ws + WS_P);
    bf16* RB = (bf16*)F.out; bf16* K2B = (bf16*)((unsigned char*)F.out + PREPB); bf16* VB = (bf16*)((unsigned char*)F.out + 2 * PREPB);
    bf16* KKB = (bf16*)(F.ws + WS_H1B); bf16* BB = (bf16*)(F.ws + WS_TAIL); bf16* GB = (bf16*)(F.ws + WS_TAIL + PREPB);
    float* EB = (float*)(F.ws + WS_XN); bf16* KN = (bf16*)(F.ws + WS_KN);
    const float* mu = F.in[I_MU];
    for (int job = gw; job < MROWS / 8; job += NGW) {
        const int R0 = job * 8, pos0 = R0 % LTOK;
#pragma unroll 1
        for (int t = 0; t < 8; ++t) { const bf16* pr = P + (size_t)(R0 + t) * INDIM; const bool hp = (pos0 + t) > 0;
#pragma unroll
            for (int i2 = 0; i2 < 4; ++i2) { const int c = 1536 + 64 * i2 + lane; const float cur = bf2f(pr[c]); const float prv = hp ? bf2f(pr[c - INDIM]) : 0.f;
                const float xs = cur + (prv - cur) * mu[c];
                const float val = i2 == 0 ? tanhf(xs) : (i2 == 1 ? xs : sigmoidf_(xs));
                inb[(64 * i2 + lane) * 8 + t] = val; } }
        LDS_WAIT(); asm volatile("" ::: "memory");
        float acc[8][8], av[8][8];
#pragma unroll
        for (int i = 0; i < 8; ++i)
#pragma unroll
            for (int t = 0; t < 8; ++t) acc[i][t] = 0.f;
#pragma unroll 2
        for (int j = 0; j < 64; ++j) { const f32x4 a0 = *(const LAS f32x4*)(inb + j * 8), a1 = *(const LAS f32x4*)(inb + j * 8 + 4);
#pragma unroll
            for (int i = 0; i < 8; ++i) { const float w = F.in[I_WDEC][j * RDIM + 64 * i + lane];
                acc[i][0] += w * a0.x; acc[i][1] += w * a0.y; acc[i][2] += w * a0.z; acc[i][3] += w * a0.w; acc[i][4] += w * a1.x; acc[i][5] += w * a1.y; acc[i][6] += w * a1.z; acc[i][7] += w * a1.w; } }
#pragma unroll
        for (int i = 0; i < 8; ++i) { const float w0 = F.in[I_W0][64 * i + lane];
#pragma unroll
            for (int t = 0; t < 8; ++t) EB[(size_t)(R0 + t) * RDIM + 64 * i + lane] = 0.60653065971f * sigmoidf_(w0 + acc[i][t]); }
#pragma unroll
        for (int i = 0; i < 8; ++i)
#pragma unroll
            for (int t = 0; t < 8; ++t) acc[i][t] = 0.f;
#pragma unroll 2
        for (int j = 0; j < 64; ++j) { const f32x4 a0 = *(const LAS f32x4*)(inb + (64 + j) * 8), a1 = *(const LAS f32x4*)(inb + (64 + j) * 8 + 4);
#pragma unroll
            for (int i = 0; i < 8; ++i) { const float w = F.in[I_AUP][j * RDIM + 64 * i + lane];
                acc[i][0] += w * a0.x; acc[i][1] += w * a0.y; acc[i][2] += w * a0.z; acc[i][3] += w * a0.w; acc[i][4] += w * a1.x; acc[i][5] += w * a1.y; acc[i][6] += w * a1.z; acc[i][7] += w * a1.w; } }
#pragma unroll
        for (int i = 0; i < 8; ++i) { const float a0 = F.in[I_A0][64 * i + lane];
#pragma unroll
            for (int t = 0; t < 8; ++t) av[i][t] = sigmoidf_(a0 + acc[i][t]); }
#pragma unroll
        for (int i = 0; i < 8; ++i) { const int c = 64 * i + lane; const float kkw = F.in[I_KK][c], kaw = F.in[I_KA][c], mur = mu[c], muk = mu[512 + c], muv = mu[1024 + c];
#pragma unroll
            for (int t = 0; t < 8; ++t) { const bf16* pr = P + (size_t)(R0 + t) * INDIM; const bool hp = (pos0 + t) > 0;
                const float rc = bf2f(pr[c]), kc = bf2f(pr[512 + c]), vc = bf2f(pr[1024 + c]);
                const float rp = hp ? bf2f(pr[c - INDIM]) : 0.f, kp = hp ? bf2f(pr[512 + c - INDIM]) : 0.f, vp = hp ? bf2f(pr[1024 + c - INDIM]) : 0.f;
                const float r = rc + (rp - rc) * mur, k = kc + (kp - kc) * muk, v = vc + (vp - vc) * muv;
                const float kkv = k * kkw; const float ss = wave_sum(kkv * kkv); const float kk = kkv / fmaxf(sqrtf(ss), 1e-12f);
                const float a = av[i][t]; const float k2 = k * (1.0f + (a - 1.0f) * kaw);
                const size_t o = (size_t)(R0 + t) * RDIM + c;
                RB[o] = (bf16)f2bf(r); K2B[o] = (bf16)f2bf(k2); VB[o] = (bf16)f2bf(v); KKB[o] = (bf16)f2bf(kk); BB[o] = (bf16)f2bf(kk * a); } }
#pragma unroll
        for (int i = 0; i < 8; ++i)
#pragma unroll
            for (int t = 0; t < 8; ++t) acc[i][t] = 0.f;
#pragma unroll 2
        for (int j = 0; j < 128; ++j) { const f32x4 a0 = *(const LAS f32x4*)(inb + (128 + j) * 8), a1 = *(const LAS f32x4*)(inb + (128 + j) * 8 + 4);
#pragma unroll
            for (int i = 0; i < 8; ++i) { const float w = F.in[I_GUP][j * RDIM + 64 * i + lane];
                acc[i][0] += w * a0.x; acc[i][1] += w * a0.y; acc[i][2] += w * a0.z; acc[i][3] += w * a0.w; acc[i][4] += w * a1.x; acc[i][5] += w * a1.y; acc[i][6] += w * a1.z; acc[i][7] += w * a1.w; } }
#pragma unroll
        for (int i = 0; i < 8; ++i)
#pragma unroll
            for (int t = 0; t < 8; ++t) GB[(size_t)(R0 + t) * RDIM + 64 * i + lane] = (bf16)f2bf(acc[i][t]);
#pragma unroll 1
        for (int t = 0; t < 8; ++t)
#pragma unroll
            for (int hk = 0; hk < 2; ++hk) { const float k = bf2f(P[(size_t)(R0 + t) * INDIM + KOFF + 64 * hk + lane]); const float ss = wave_sum(k * k);
                KN[(size_t)(R0 + t) * 128 + 64 * hk + lane] = (bf16)f2bf(k * (1.0f / sqrtf(ss * (1.0f / 64.0f) + 1e-6f)) * F.in[I_KNW][lane]); }
        LDS_WAIT(); asm volatile("" ::: "memory");
    }
}

__device__ __forceinline__ void p3_scan(Frame& F, int bh) {
    const int b = bh >> 3, h = bh & 7, tid = F.tid;
    LAS float* sw = (LAS float*)(F.lds + RING_OFF); LAS float* sa = sw + 2048; LAS float* sb = sa + 2048; LAS float* sk = sb + 2048; LAS float* sr = sk + 2048; LAS float* sv = sr + 2048; LAS float* sy = sv + 2048;
    const bf16* RB = (const bf16*)F.out; const bf16* K2B = (const bf16*)((unsigned char*)F.out + PREPB); const bf16* VB = (const bf16*)((unsigned char*)F.out + 2 * PREPB);
    const bf16* KKB = (const bf16*)(F.ws + WS_H1B); const bf16* BB = (const bf16*)(F.ws + WS_TAIL);
    float* EB = (float*)(F.ws + WS_XN);
    const int i = tid >> 2, q = tid & 3;
    float S[16];
#pragma unroll
    for (int j = 0; j < 16; ++j) S[j] = 0.f;
#pragma unroll 1
    for (int c0 = 0; c0 < LTOK; c0 += 32) {
        const int nst = (LTOK - c0) < 32 ? (LTOK - c0) : 32;
        for (int e = tid; e < 2048; e += 512) { const int s = e >> 6, j = e & 63;
            if (s < nst) { const size_t idx = (size_t)(b * LTOK + c0 + s) * RDIM + 64 * h + j; const float kk = bf2f(KKB[idx]);
                sw[e] = __expf(-EB[idx]); sa[e] = -kk; sb[e] = bf2f(BB[idx]); sk[e] = bf2f(K2B[idx]); sr[e] = bf2f(RB[idx]); sv[e] = bf2f(VB[idx]); } }
        __syncthreads();
        if (tid < 256) {
#pragma unroll 1
            for (int s = 0; s < nst; ++s) {
                const int o = s * 64 + 16 * q; float wv[16], avv[16], bv[16], kv[16], rv[16];
#pragma unroll
                for (int j4 = 0; j4 < 4; ++j4) { const f32x4 t0 = *(const LAS f32x4*)(sw + o + 4 * j4), t1 = *(const LAS f32x4*)(sa + o + 4 * j4), t2 = *(const LAS f32x4*)(sb + o + 4 * j4), t3 = *(const LAS f32x4*)(sk + o + 4 * j4), t4 = *(const LAS f32x4*)(sr + o + 4 * j4);
#pragma unroll
                    for (int c = 0; c < 4; ++c) { wv[4 * j4 + c] = t0[c]; avv[4 * j4 + c] = t1[c]; bv[4 * j4 + c] = t2[c]; kv[4 * j4 + c] = t3[c]; rv[4 * j4 + c] = t4[c]; } }
                const float v = sv[s * 64 + i];
                float sacc = 0.f;
#pragma unroll
                for (int j = 0; j < 16; ++j) sacc += S[j] * avv[j];
                sacc += __shfl_xor(sacc, 1); sacc += __shfl_xor(sacc, 2);
                float y = 0.f;
#pragma unroll
                for (int j = 0; j < 16; ++j) { S[j] = S[j] * wv[j] + sacc * bv[j] + v * kv[j]; y += S[j] * rv[j]; }
                y += __shfl_xor(y, 1); y += __shfl_xor(y, 2);
                if (q == 0) sy[s * 64 + i] = y;
            }
        }
        __syncthreads();
        for (int e = tid; e < 2048; e += 512) { const int s = e >> 6, j = e & 63; if (s < nst) EB[(size_t)(b * LTOK + c0 + s) * RDIM + 64 * h + j] = sy[e]; }
    }
}

__device__ __forceinline__ void p3b_finalize(Frame& F) {
    const int lane = F.lane, gw = F.vcu * NWAVES + F.wave, NGW = F.G * NWAVES;
    const bf16* RB = (const bf16*)F.out; const bf16* K2B = (const bf16*)((unsigned char*)F.out + PREPB); const bf16* VB = (const bf16*)((unsigned char*)F.out + 2 * PREPB);
    const bf16* GB = (const bf16*)(F.ws + WS_TAIL + PREPB); const float* YR = (const float*)(F.ws + WS_XN); bf16* YMIX = (bf16*)(F.ws + WS_YMIX);
    for (int R = gw; R < MROWS; R += NGW) {
#pragma unroll
        for (int i = 0; i < 8; ++i) { const int c = 64 * i + lane; const size_t o = (size_t)R * RDIM + c;
            const float y = YR[o]; const float mean = wave_sum(y) * (1.0f / 64.0f); const float d = y - mean; const float var = wave_sum(d * d) * (1.0f / 64.0f);
            const float yn = d * (1.0f / sqrtf(var + 64e-5f)) * F.in[I_LNW][c] + F.in[I_LNB][c];
            const float r = bf2f(RB[o]), k2 = bf2f(K2B[o]), v = bf2f(VB[o]);
            const float bs = wave_sum(r * k2 * F.in[I_RK][c]);
            YMIX[(size_t)R * DM + c] = (bf16)f2bf((yn + bs * v) * bf2f(GB[o])); }
    }
}

__device__ __forceinline__ void p4_attention(Frame& F, int w0, int nw) {
    const int lane = F.lane;
    const bf16* P = (const bf16*)(F.ws + WS_P); const bf16* KN = (const bf16*)(F.ws + WS_KN); bf16* YMIX = (bf16*)(F.ws + WS_YMIX);
    const float* relb = F.in[I_RELB];
    constexpr int NPB = (LTOK + 63) / 64;
    for (int job = w0; job < BATCH * NPB * 8; job += nw) {
        const int hq = job & 7, pb = (job >> 3) % NPB, b = (job >> 3) / NPB, hkv = hq >> 2;
        const int qpos_raw = 64 * pb + lane; const bool live = qpos_raw < LTOK; const int qpos = live ? qpos_raw : LTOK - 1;
        const size_t R = (size_t)b * LTOK + qpos;
        float q[64], o[64];
        { const v4u* qp = (const v4u*)(P + R * INDIM + QOFF + 64 * hq); float ss = 0.f;
#pragma unroll
            for (int c8 = 0; c8 < 8; ++c8) { const v4u u = qp[c8]; q[8 * c8 + 0] = bflo(u.x); q[8 * c8 + 1] = bfhi(u.x); q[8 * c8 + 2] = bflo(u.y); q[8 * c8 + 3] = bfhi(u.y); q[8 * c8 + 4] = bflo(u.z); q[8 * c8 + 5] = bfhi(u.z); q[8 * c8 + 6] = bflo(u.w); q[8 * c8 + 7] = bfhi(u.w); }
#pragma unroll
            for (int d = 0; d < 64; ++d) ss += q[d] * q[d];
            const float rs = 0.125f / sqrtf(ss * (1.0f / 64.0f) + 1e-6f);
#pragma unroll
            for (int d = 0; d < 64; ++d) { q[d] = q[d] * rs * F.in[I_QNW][d]; o[d] = 0.f; } }
        float m = F.in[I_SINK][hq], l = 1.0f;
#pragma unroll 1
        for (int it = 0; it < NMETA + 128; ++it) {
            int kpos; bool valid; float bias;
            if (it < NMETA) { kpos = it; valid = kpos <= qpos; const int dist = qpos - kpos; const int bk = (dist >= 0 && dist < 128) ? c_bucket[dist] : 31; bias = relb[bk * 8 + hq]; }
            else { const int dd = it - NMETA; kpos = qpos - dd; valid = kpos >= NMETA; bias = relb[c_bucket[dd] * 8 + hq]; }
            if (kpos < 0) kpos = 0;
            const size_t KR = (size_t)b * LTOK + kpos;
            const v4u* kp = (const v4u*)(KN + KR * 128 + 64 * hkv);
            float s = 0.f;
#pragma unroll
            for (int c8 = 0; c8 < 8; ++c8) { const v4u u = kp[c8];
                s += q[8 * c8 + 0] * bflo(u.x) + q[8 * c8 + 1] * bfhi(u.x) + q[8 * c8 + 2] * bflo(u.y) + q[8 * c8 + 3] * bfhi(u.y) + q[8 * c8 + 4] * bflo(u.z) + q[8 * c8 + 5] * bfhi(u.z) + q[8 * c8 + 6] * bflo(u.w) + q[8 * c8 + 7] * bfhi(u.w); }
            s += bias;
            if (valid) {
                const float mn = fmaxf(m, s), alpha = __expf(m - mn), p = __expf(s - mn); l = l * alpha + p; m = mn;
                const v4u* vp = (const v4u*)(P + KR * INDIM + VOFF + 64 * hkv);
#pragma unroll
                for (int c8 = 0; c8 < 8; ++c8) { const v4u u = vp[c8];
                    o[8 * c8 + 0] = o[8 * c8 + 0] * alpha + p * bflo(u.x); o[8 * c8 + 1] = o[8 * c8 + 1] * alpha + p * bfhi(u.x); o[8 * c8 + 2] = o[8 * c8 + 2] * alpha + p * bflo(u.y); o[8 * c8 + 3] = o[8 * c8 + 3] * alpha + p * bfhi(u.y);
                    o[8 * c8 + 4] = o[8 * c8 + 4] * alpha + p * bflo(u.z); o[8 * c8 + 5] = o[8 * c8 + 5] * alpha + p * bfhi(u.z); o[8 * c8 + 6] = o[8 * c8 + 6] * alpha + p * bflo(u.w); o[8 * c8 + 7] = o[8 * c8 + 7] * alpha + p * bfhi(u.w); }
            }
        }
        if (live) { const float il = 1.0f / l; v4u* op = (v4u*)(YMIX + R * DM + 512 + 64 * hq);
#pragma unroll
            for (int c8 = 0; c8 < 8; ++c8) { v4u w; w.x = pk2(o[8 * c8 + 0] * il, o[8 * c8 + 1] * il); w.y = pk2(o[8 * c8 + 2] * il, o[8 * c8 + 3] * il); w.z = pk2(o[8 * c8 + 4] * il, o[8 * c8 + 5] * il); w.w = pk2(o[8 * c8 + 6] * il, o[8 * c8 + 7] * il); op[c8] = w; } }
    }
}

__device__ __forceinline__ void p5_meta_rows(Frame& F, int blk) {
    const int b = blk >> 1, row = 14 + (blk & 1), U = b * LTOK + row, tid = F.tid;
    LAS float* ys = (LAS float*)(F.lds + RING_OFF); LAS float* red = ys + 1024;
    const bf16* YMIX = (const bf16*)(F.ws + WS_YMIX); const bf16* WT = (const bf16*)(F.ws + WS_WOUT); bf16* H1B = (bf16*)(F.ws + WS_H1B); float* SSQP = (float*)(F.ws + WS_SSQP);
    for (int k = tid; k < DM; k += 512) ys[k] = bf2f(YMIX[(size_t)U * DM + k]);
    __syncthreads();
    float ssq = 0.f;
#pragma unroll 1
    for (int cc = 0; cc < 2; ++cc) { const int col = tid + 512 * cc; const v4u* wp = (const v4u*)(WT + (size_t)col * DM); float acc = 0.f;
#pragma unroll 4
        for (int k8 = 0; k8 < DM / 8; ++k8) { const v4u u = wp[k8]; const f32x4 y0 = *(const LAS f32x4*)(ys + 8 * k8), y1 = *(const LAS f32x4*)(ys + 8 * k8 + 4);
            acc += bflo(u.x) * y0.x + bfhi(u.x) * y0.y + bflo(u.y) * y0.z + bfhi(u.y) * y0.w + bflo(u.z) * y1.x + bfhi(u.z) * y1.y + bflo(u.w) * y1.z + bfhi(u.w) * y1.w; }
        const float h = F.in[I_META][(size_t)row * DM + col] + acc; ssq += h * h; H1B[(size_t)U * DM + col] = (bf16)f2bf(h); }
    ssq = wave_sum(ssq);
    if (F.lane == 0) red[F.wave] = ssq;
    __syncthreads();
    if (tid < 16) { float t = 0.f; if (tid == 0) { for (int w = 0; w < NWAVES; ++w) t += red[w]; } SSQP[(size_t)tid * MPAD + U] = t; }
    __syncthreads();
}

#ifndef MK_N_LAUNCHES
#define MK_N_LAUNCHES 1
#endif
constexpr int N_LAUNCHES = MK_N_LAUNCHES;
constexpr int PER_PHASE = 8;
struct Args { const float* in[25]; float* out; unsigned char* ws; int ph_lo, ph_hi; };
__global__ void __launch_bounds__(NWAVES * 64, 2) hymba_fwd(Args args) {
    extern __shared__ __attribute__((aligned(16))) unsigned char lds[];
    Frame F;
    F.lds = (LAS unsigned char*)lds;
    F.MISC = (volatile LAS unsigned*)(F.lds + MISC_OFF);
    F.tid = threadIdx.x; F.lane = F.tid & 63; F.wave = __builtin_amdgcn_readfirstlane(F.tid >> 6);
    F.G = gridDim.x; { const int bx = blockIdx.x; F.vcu = (F.G % 8 == 0) ? (bx % 8) * (F.G / 8) + bx / 8 : bx; }
    F.ws = args.ws; F.out = args.out; F.ctl = (gu32*)(args.ws + WS_CTL);
#pragma unroll
    for (int i = 0; i < 25; ++i) F.in[i] = args.in[i];
    for (int u = F.tid; u < (LDS_BYTES - LDSCTL_OFF) / 4; u += NWAVES * 64) ((LAS unsigned*)(F.lds + LDSCTL_OFF))[u] = 0u;
    __syncthreads();
    XcdBarrier bar; bar.bar = (unsigned*)(F.ctl + CW_BAR); bar.x = 0; bar.st = nullptr;
    if (N_LAUNCHES == 1) bar = xcd_barrier_post((unsigned*)(F.ctl + CW_BAR), F.MISC + 8);
    const int lo = args.ph_lo, hi = args.ph_hi;
#define IN(k) (lo <= (k) && (k) < hi)
#define SEAM(k) do { if (IN(k) && IN((k) + 1)) xcd_barrier(bar); } while (0)
    bf16* XN = (bf16*)(F.ws + WS_XN); bf16* PB = (bf16*)(F.ws + WS_P); bf16* YMIX = (bf16*)(F.ws + WS_YMIX); bf16* H1B = (bf16*)(F.ws + WS_H1B); bf16* ACT = (bf16*)(F.ws + WS_ACT);
    float* SSQP = (float*)(F.ws + WS_SSQP);

    if (IN(0)) { p0_prologue(F); SEAM(0); }
    if (IN(1)) {
        pg8::Gemm g{XN, (const bf16*)(F.ws + WS_WIN), MPAD, INDIM, DM}; pg8::StaticOrderT<0> S; S.init(MPAD, INDIM, F.G, (int)blockIdx.x);
        pg8::EpiBf16 E{PB, INDIM};
        pg8::gemm_phase<pg8::EpiBf16, pg8::StaticOrderT<0>, true, true>(F.lds + RING_OFF, g, S, E);
        SEAM(1);
    }
    if (IN(2)) { p2_prep(F); SEAM(2); }
    if (IN(3)) {
        if (blockIdx.x < 16) p3_scan(F, (int)blockIdx.x);
        else p4_attention(F, ((int)blockIdx.x - 16) * NWAVES + F.wave, (F.G - 16) * NWAVES);
        SEAM(3);
    }
    if (IN(4)) { p3b_finalize(F); SEAM(4); }
    if (IN(5)) {
        if (blockIdx.x < 4) p5_meta_rows(F, (int)blockIdx.x);
        pg8::Gemm g{YMIX, (const bf16*)(F.ws + WS_WOUT), MREAL, DM, DM}; pg8::StaticOrderT<1> S; S.init(MREAL, DM, F.G, (int)blockIdx.x);
        pg8::EpiH1 E{F.in[I_X], F.out, H1B, SSQP, MPAD};
        pg8::gemm_phase<pg8::EpiH1, pg8::StaticOrderT<1>, true, true>(F.lds + RING_OFF, g, S, E);
        SEAM(5);
    }
    if (IN(6)) {
        pg8::Gemm g{H1B, (const bf16*)(F.ws + WS_WUP), 66 * 256, 2 * DFF, DM}; pg8::StaticOrderT<2> S; S.init(66 * 256, 2 * DFF, F.G, (int)blockIdx.x);
        pg8::EpiAct E{ACT, SSQP, MPAD, F.in[I_CONVW], F.in[I_CONVB], (LAS float*)(F.lds + HALO_OFF)};
        pg8::gemm_phase<pg8::EpiAct, pg8::StaticOrderT<2>, true, true>(F.lds + RING_OFF, g, S, E);
        SEAM(6);
    }
    if (IN(7)) {
        pg8::Gemm g{ACT, (const bf16*)(F.ws + WS_WDN), MREAL, DM, DFF}; pg8::StaticOrderT<0> S; S.init(MREAL, DM, F.G, (int)blockIdx.x);
        pg8::EpiOut E{F.out};
        pg8::gemm_phase<pg8::EpiOut, pg8::StaticOrderT<0>, true, true>(F.lds + RING_OFF, g, S, E);
    }
#undef IN
#undef SEAM
}

extern "C" void kernel_launch(void* const* d_in, const int* in_sizes, int n_in, void* d_out, int out_size, void* d_ws, size_t ws_size, hipStream_t stream) {
    static int grid = 0;
    if (grid == 0) {
        if (n_in != 25 || out_size != MREAL * DM || ws_size < WS_END) { fprintf(stderr, "kernel_launch: unexpected shapes n_in %d out %d ws %zu\n", n_in, out_size, ws_size); grid = -1; return; }
        int dev = 0, cus = 0;
        if (hipGetDevice(&dev) != hipSuccess || hipDeviceGetAttribute(&cus, hipDeviceAttributeMultiprocessorCount, dev) != hipSuccess) { grid = -1; return; }
        if (hipFuncSetAttribute((const void*)hymba_fwd, hipFuncAttributeMaxDynamicSharedMemorySize, LDS_BYTES) != hipSuccess) { fprintf(stderr, "kernel_launch: hipFuncSetAttribute failed\n"); grid = -1; return; }
        (void)hipGetLastError();
        grid = cus;
    }
    if (grid < 0) return;
    (void)hipMemsetAsync((char*)d_ws + WS_CTL, 0, CTL_ZERO_BYTES, stream);
    Args a{};
    for (int i = 0; i < 25; ++i) a.in[i] = (const float*)d_in[i];
    a.out = (float*)d_out; a.ws = (unsigned char*)d_ws;
    for (int li = 0; li < N_LAUNCHES; ++li) {
        a.ph_lo = (N_LAUNCHES == 1) ? 0 : li; a.ph_hi = (N_LAUNCHES == 1) ? PER_PHASE : li + 1;
        hipLaunchKernelGGL(hymba_fwd, dim3(grid), dim3(NWAVES * 64), LDS_BYTES, stream, a);
    }
}
```

```cpp
#include <hip/hip_runtime.h>
#include <cstdio>
#include <cstdint>
namespace pg8 {
#define PG8_LAS __attribute__((address_space(3)))
typedef unsigned short bf16_t;
typedef short bf16x8 __attribute__((ext_vector_type(8)));
typedef float f32x4 __attribute__((ext_vector_type(4)));
typedef unsigned u32x4 __attribute__((ext_vector_type(4)));
constexpr int BM = 256, BK = 64, HALF = 128, HTB = HALF * BK * 2  , STAGE_BYTES = 8 * HTB, NXCD = 8, WGM = 8;

__host__ __device__ __forceinline__ int lds_byte(int r, int c) { const int st = (r >> 4) * 2 + (c >> 5), rr = r & 15, cc = c & 31, ob = rr * 64 + cc * 2; return st * 1024 + (ob ^ (((ob >> 9) & 1) << 5)); }
__host__ __device__ __forceinline__ void stage_rc(int b, int& R, int& C) { const int st = b / 1024, sb = b % 1024, swz = sb ^ (((sb >> 9) & 1) << 5); R = (st >> 1) * 16 + swz / 64; C = (st & 1) * 32 + (swz % 64) / 2; }
__host__ __device__ __forceinline__ int perm32(int rho) { const int n = rho >> 4, i = rho & 15; return 8 * (i >> 2) + 4 * n + (i & 3); }

struct Unit { int pm, pn; };
struct Gemm { const bf16_t* A; const bf16_t* Bt; int M, N, K; };

template <int AMODE> struct StaticOrderT {
    int nM, nN, nwg, G, c;
    __host__ __device__ void init(int M, int N, int G_, int c_) { nM = M / BM; nN = N / BM; nwg = nM * nN; G = G_; c = c_; }
    __host__ __device__ bool next(int i, Unit& u) const {
        const long L = (long)i * G + c; if (L >= nwg) return false;
        int wgid = (int)L; { const int q = nwg / NXCD, r = nwg % NXCD, xcd = wgid % NXCD, off = wgid / NXCD; wgid = (xcd < r ? xcd * (q + 1) : r * (q + 1) + (xcd - r) * q) + off; }
        const int nig = WGM * nN, gid = wgid / nig, fm = gid * WGM, gsz = (nM - fm) < WGM ? (nM - fm) : WGM;
        u.pm = fm + ((wgid % nig) % gsz); u.pn = (wgid % nig) / gsz; return true;
    }
    __host__ __device__ __forceinline__ int a_row0(const Unit& u) const { return AMODE == 0 ? u.pm * BM : (AMODE == 1 ? (u.pm >> 5) * 8208 + 16 + (u.pm & 31) * 256 : (u.pm / 33) * 8208 + 14 + 254 * (u.pm % 33)); }
    __device__ __forceinline__ void a_ready(const Unit&) const {}
    __device__ __forceinline__ void done(const Unit&) const {}
};

__device__ __forceinline__ unsigned cvt_pk_bf16(float lo, float hi) { unsigned r; asm volatile("v_cvt_pk_bf16_f32 %0, %1, %2" : "=v"(r) : "v"(lo), "v"(hi)); return r; }
typedef float f32x2 __attribute__((ext_vector_type(2)));
typedef unsigned u32x2 __attribute__((ext_vector_type(2)));
struct EpiBf16 {
    static constexpr bool PERM = true, AFTER_DRAIN = false;
    bf16_t* O; int ldc;
    __device__ __forceinline__ void operator()(f32x4 (&acc)[2][2][4][2], const Unit& u, int wr, int wc, int fr, int fq) const {
        const int row0 = u.pm * BM + wr * 64 + fr, col0 = u.pn * BM + wc * 32 + 8 * fq;
#pragma unroll
        for (int ai = 0; ai < 2; ++ai)
#pragma unroll
            for (int m = 0; m < 4; ++m) { bf16_t* rowp = O + (size_t)(row0 + ai * HALF + m * 16) * ldc + col0;
#pragma unroll
                for (int bj = 0; bj < 2; ++bj) { const f32x4 v0 = acc[ai][bj][m][0], v1 = acc[ai][bj][m][1];
                    u32x4 w; w.x = cvt_pk_bf16(v0[0], v0[1]); w.y = cvt_pk_bf16(v0[2], v0[3]); w.z = cvt_pk_bf16(v1[0], v1[1]); w.w = cvt_pk_bf16(v1[2], v1[3]);
                    *(u32x4*)(rowp + bj * HALF) = w; } }
    }
};
struct EpiH1 {
    static constexpr bool PERM = false, AFTER_DRAIN = false;
    const float* x; float* out; bf16_t* h1b; float* ssqp; int ssq_stride;
    __device__ __forceinline__ void operator()(f32x4 (&acc)[2][2][4][2], const Unit& u, int wr, int wc, int fr, int fq) const {
        const int col0 = u.pn * BM + wc * 32 + 4 * fq;
#pragma unroll
        for (int ai = 0; ai < 2; ++ai)
#pragma unroll
            for (int m = 0; m < 4; ++m) { const int rr = u.pm * BM + ai * HALF + wr * 64 + m * 16 + fr; const int U = (rr >> 13) * 8208 + 16 + (rr & 8191); float s = 0.f;
#pragma unroll
                for (int bj = 0; bj < 2; ++bj)
#pragma unroll
                    for (int n = 0; n < 2; ++n) { const size_t off = (size_t)rr * 1024 + col0 + bj * HALF + n * 16;
                        const f32x4 h = *(const f32x4*)(x + off) + acc[ai][bj][m][n]; *(f32x4*)(out + off) = h;
                        s += (h[0] * h[0] + h[1] * h[1]) + (h[2] * h[2] + h[3] * h[3]);
                        u32x2 w; w.x = cvt_pk_bf16(h[0], h[1]); w.y = cvt_pk_bf16(h[2], h[3]); *(u32x2*)(h1b + (size_t)U * 1024 + col0 + bj * HALF + n * 16) = w; }
                s += __shfl_xor(s, 16); s += __shfl_xor(s, 32);
                if (fq == 0) ssqp[(size_t)(u.pn * 4 + wc) * ssq_stride + U] = s; }
    }
};
struct EpiOut {
    static constexpr bool PERM = false, AFTER_DRAIN = false;
    float* out;
    __device__ __forceinline__ void operator()(f32x4 (&acc)[2][2][4][2], const Unit& u, int wr, int wc, int fr, int fq) const {
        const int col0 = u.pn * BM + wc * 32 + 4 * fq;
#pragma unroll
        for (int ai = 0; ai < 2; ++ai)
#pragma unroll
            for (int m = 0; m < 4; ++m) { const int rr = u.pm * BM + ai * HALF + wr * 64 + m * 16 + fr;
#pragma unroll
                for (int bj = 0; bj < 2; ++bj)
#pragma unroll
                    for (int n = 0; n < 2; ++n) { const size_t off = (size_t)rr * 1024 + col0 + bj * HALF + n * 16; *(f32x4*)(out + off) = *(const f32x4*)(out + off) + acc[ai][bj][m][n]; } }
    }
};
struct EpiAct {
    static constexpr bool PERM = true, AFTER_DRAIN = false;
    bf16_t* act; const float* ssqp; int ssq_stride; const float* conv_w; const float* conv_b; PG8_LAS float* halo;
    __device__ __forceinline__ void operator()(f32x4 (&acc)[2][2][4][2], const Unit& u, int wr, int wc, int fr, int fq) const {
        const int b = u.pm / 33, ti = u.pm % 33, lane = fq * 16 + fr;
#pragma unroll
        for (int ai = 0; ai < 2; ++ai)
#pragma unroll
            for (int m = 0; m < 4; ++m) { const int pos = 14 + 254 * ti + ai * HALF + wr * 64 + m * 16 + fr; float rs = 0.f;
                if (pos <= 8207) { const int U = b * 8208 + pos; float s = 0.f;
#pragma unroll
                    for (int p = 0; p < 16; ++p) s += ssqp[(size_t)p * ssq_stride + U];
                    rs = 1.0f / sqrtf(s * (1.0f / 1024.0f) + 1e-6f); }
#pragma unroll
                for (int bj = 0; bj < 2; ++bj)
#pragma unroll
                    for (int n = 0; n < 2; ++n) acc[ai][bj][m][n] = acc[ai][bj][m][n] * rs; }
        if (fr >= 14) {
#pragma unroll
            for (int ai = 0; ai < 2; ++ai)
#pragma unroll
                for (int bj = 0; bj < 2; ++bj)
#pragma unroll
                    for (int n = 0; n < 2; ++n) *(PG8_LAS f32x4*)(halo + ((2 * ai + wr) * 2 + (fr - 14)) * 256 + bj * 128 + wc * 32 + 8 * fq + 4 * n) = acc[ai][bj][3][n];
        }
        asm volatile("s_waitcnt lgkmcnt(0)" ::: "memory"); __builtin_amdgcn_s_barrier(); asm volatile("" ::: "memory");
        const int src1 = (lane & 48) | ((fr + 15) & 15), src2 = (lane & 48) | ((fr + 14) & 15);
        u32x2 res[2][4][2];
#pragma unroll
        for (int n = 0; n < 2; ++n) {
            const int jg = u.pn * 128 + wc * 32 + 8 * fq + 4 * n;
            const f32x4 g0 = *(const f32x4*)(conv_w + jg), g1 = *(const f32x4*)(conv_w + 5632 + jg), g2 = *(const f32x4*)(conv_w + 2 * 5632 + jg), gb = *(const f32x4*)(conv_b + jg);
            const f32x4 v0 = *(const f32x4*)(conv_w + 2816 + jg), v1 = *(const f32x4*)(conv_w + 5632 + 2816 + jg), v2 = *(const f32x4*)(conv_w + 2 * 5632 + 2816 + jg), vb = *(const f32x4*)(conv_b + 2816 + jg);
#pragma unroll
            for (int ai = 0; ai < 2; ++ai) { const int seg = 2 * ai + wr;
                f32x4 pg = (f32x4){0.f, 0.f, 0.f, 0.f}, pv = (f32x4){0.f, 0.f, 0.f, 0.f};
                if (seg > 0 && fr >= 14) { const PG8_LAS float* hp = halo + ((seg - 1) * 2 + (fr - 14)) * 256 + wc * 32 + 8 * fq + 4 * n; pg = *(const PG8_LAS f32x4*)hp; pv = *(const PG8_LAS f32x4*)(hp + 128); }
#pragma unroll
                for (int m = 0; m < 4; ++m) { const f32x4 xg = acc[ai][0][m][n], xv = acc[ai][1][m][n]; float o[4];
#pragma unroll
                    for (int c = 0; c < 4; ++c) {
                        const float zg1 = fr == 15 ? pg[c] : xg[c], zg2 = fr >= 14 ? pg[c] : xg[c], zv1 = fr == 15 ? pv[c] : xv[c], zv2 = fr >= 14 ? pv[c] : xv[c];
                        const float xg1 = __shfl(zg1, src1), xg2 = __shfl(zg2, src2), xv1 = __shfl(zv1, src1), xv2 = __shfl(zv2, src2);
                        const float gate = g0[c] * xg[c] + g1[c] * xg1 + g2[c] * xg2 + gb[c];
                        const float val = v0[c] * xv[c] + v1[c] * xv1 + v2[c] * xv2 + vb[c];
                        o[c] = gate * __builtin_amdgcn_rcpf(1.0f + __expf(-gate)) * val; }
                    res[ai][m][n].x = cvt_pk_bf16(o[0], o[1]); res[ai][m][n].y = cvt_pk_bf16(o[2], o[3]);
                    pg = xg; pv = xv; } }
        }
#pragma unroll
        for (int ai = 0; ai < 2; ++ai)
#pragma unroll
            for (int m = 0; m < 4; ++m) { const int r = ai * HALF + wr * 64 + m * 16 + fr, t = 254 * ti + r - 2;
                if (r >= 2 && t < 8192) { u32x4 w; w.x = res[ai][m][0].x; w.y = res[ai][m][0].y; w.z = res[ai][m][1].x; w.w = res[ai][m][1].y;
                    *(u32x4*)(act + (size_t)(b * 8192 + t) * 2816 + u.pn * 128 + wc * 32 + 8 * fq) = w; } }
    }
};

template <class Epi, class Sched, bool ALIGN_EPI = false, bool SP2 = false>
__device__ __forceinline__ void gemm_phase(PG8_LAS unsigned char* lds, const Gemm g, const Sched& S, const Epi& E) {
    const int tid = threadIdx.x, wid = __builtin_amdgcn_readfirstlane(tid >> 6), lane = tid & 63, wr = wid >> 2, wc = wid & 3, fr = lane & 15, fq = lane >> 4;
    const int K = g.K, nt = K / BK;
    unsigned voffA[2], voffB[2];
#pragma unroll
    for (int i = 0; i < 2; ++i) { int R, C; stage_rc(tid * 16 + i * 8192, R, C); const int Rb = Epi::PERM ? ((R & ~31) + perm32(R & 31)) : R;
        voffA[i] = (unsigned)(R * K + C) * 2u; voffB[i] = (unsigned)(Rb * K + C) * 2u; }
    const size_t kstep = (size_t)(BK * 2);
    const size_t hstep = (size_t)HALF * K * 2;
    const size_t tstep = 2 * hstep;
    const unsigned ldsw = (unsigned)wid * 1024u;
    const int aoff = lds_byte(wr * 64 + fr, fq * 8), boff = lds_byte(wc * 32 + fr, fq * 8);
#define PG8_SA(b, h) (((b) * 2 + (h)) * HTB)
#define PG8_SB(b, h) ((4 + (b) * 2 + (h)) * HTB)
#define PG8_STAGE(bufoff, gbase, voff) do { _Pragma("unroll") for (int _i = 0; _i < 2; ++_i) \
        __builtin_amdgcn_global_load_lds((const unsigned*)((const char*)(gbase) + (voff)[_i]), (PG8_LAS unsigned*)(lds + (bufoff) + ldsw + _i * 8192), 16, 0, 0); } while (0)
#define PG8_LDA(dst, b, h) do { _Pragma("unroll") for (int m = 0; m < 4; ++m) _Pragma("unroll") for (int k = 0; k < 2; ++k) dst[m][k] = *(const PG8_LAS bf16x8*)(lds + PG8_SA(b, h) + aoff + m * 2048 + k * 1024); } while (0)
#define PG8_LDB(dst, b, h) do { _Pragma("unroll") for (int n = 0; n < 2; ++n) _Pragma("unroll") for (int k = 0; k < 2; ++k) dst[n][k] = *(const PG8_LAS bf16x8*)(lds + PG8_SB(b, h) + boff + n * 2048 + k * 1024); } while (0)
#define PG8_MMA(ai, bj, At, Bt) do { __builtin_amdgcn_s_setprio(1); _Pragma("unroll") for (int m = 0; m < 4; ++m) _Pragma("unroll") for (int n = 0; n < 2; ++n) _Pragma("unroll") for (int k = 0; k < 2; ++k) \
        acc[ai][bj][m][n] = __builtin_amdgcn_mfma_f32_16x16x32_bf16(Bt[n][k], At[m][k], acc[ai][bj][m][n], 0, 0, 0); __builtin_amdgcn_s_setprio(0); } while (0)
#define PG8_WAIT_V(n) asm volatile("s_waitcnt vmcnt(" #n ")" ::: "memory")
#define PG8_WAIT_L(n) asm volatile("s_waitcnt lgkmcnt(" #n ")" ::: "memory")
#define PG8_BAR __builtin_amdgcn_s_barrier()
#define PG8_SCHED __builtin_amdgcn_sched_barrier(0)
    Unit cur, nxt; int ui = 0;
    if (!S.next(0, cur)) return;
    f32x4 acc[2][2][4][2];
#pragma unroll
    for (int a = 0; a < 2; ++a)
#pragma unroll
        for (int b = 0; b < 2; ++b)
#pragma unroll
            for (int m = 0; m < 4; ++m)
#pragma unroll
                for (int n = 0; n < 2; ++n) acc[a][b][m][n] = (f32x4){0.f, 0.f, 0.f, 0.f};
    bf16x8 At[4][2], B0[2][2], B1[2][2];
    const size_t rowb = (size_t)K * 2; const char* cA = (const char*)g.A + (size_t)S.a_row0(cur) * rowb; const char* cB = (const char*)g.Bt + (size_t)cur.pn * tstep;
    S.a_ready(cur);
    if constexpr (SP2) {
        PG8_STAGE(PG8_SB(0, 0), cB, voffB); PG8_STAGE(PG8_SB(0, 1), cB + hstep, voffB); PG8_STAGE(PG8_SA(0, 0), cA, voffA); PG8_STAGE(PG8_SA(0, 1), cA + hstep, voffA);
        if (wr == 1) PG8_BAR;
        PG8_WAIT_V(2); PG8_BAR;
        PG8_STAGE(PG8_SB(1, 0), cB + kstep, voffB); PG8_STAGE(PG8_SA(1, 0), cA + kstep, voffA); PG8_STAGE(PG8_SB(1, 1), cB + hstep + kstep, voffB);
        PG8_WAIT_V(6); PG8_BAR;
    } else {
        PG8_STAGE(PG8_SB(0, 0), cB, voffB); PG8_STAGE(PG8_SA(0, 0), cA, voffA); PG8_STAGE(PG8_SB(0, 1), cB + hstep, voffB); PG8_STAGE(PG8_SA(0, 1), cA + hstep, voffA);
        if (wr == 1) PG8_BAR;
        PG8_WAIT_V(4); PG8_BAR;
        PG8_STAGE(PG8_SB(1, 0), cB + kstep, voffB); PG8_STAGE(PG8_SA(1, 0), cA + kstep, voffA); PG8_STAGE(PG8_SB(1, 1), cB + hstep + kstep, voffB);
        PG8_WAIT_V(6); PG8_BAR;
    }
    for (;;) {
        const bool has_next = S.next(ui + 1, nxt);
        const char* nA = has_next ? (const char*)g.A + (size_t)S.a_row0(nxt) * rowb : cA; const char* nB = has_next ? (const char*)g.Bt + (size_t)nxt.pn * tstep : cB;
        for (int t = 0; t < nt; t += 2) {
            const bool last = (t == nt - 2);
            const char* a1 = cA + (size_t)(t + 1) * kstep;
            const char* a2 = last ? nA : cA + (size_t)(t + 2) * kstep; const char* b2 = last ? nB : cB + (size_t)(t + 2) * kstep;
            const char* a3 = a2 + kstep; const char* b3 = b2 + kstep;
            if (last && has_next) S.a_ready(nxt);
            if constexpr (SP2) {
            PG8_LDB(B0, 0, 0); PG8_LDB(B1, 0, 1); PG8_SCHED; PG8_LDA(At, 0, 0); PG8_STAGE(PG8_SA(1, 1), a1 + hstep, voffA);
            PG8_WAIT_V(8); PG8_WAIT_L(0); PG8_BAR; PG8_MMA(0, 0, At, B0); PG8_MMA(0, 1, At, B1); PG8_BAR; PG8_SCHED;
            PG8_LDA(At, 0, 1); PG8_STAGE(PG8_SB(0, 0), b2, voffB); PG8_STAGE(PG8_SB(0, 1), b2 + hstep, voffB); PG8_STAGE(PG8_SA(0, 0), a2, voffA);
            PG8_WAIT_V(8); PG8_WAIT_L(0); PG8_BAR; PG8_MMA(1, 0, At, B0); PG8_MMA(1, 1, At, B1); PG8_BAR; PG8_SCHED;
            PG8_LDB(B0, 1, 0); PG8_LDB(B1, 1, 1); PG8_SCHED; PG8_LDA(At, 1, 0); PG8_STAGE(PG8_SA(0, 1), a2 + hstep, voffA);
            PG8_WAIT_V(8); PG8_WAIT_L(0); PG8_BAR; PG8_MMA(0, 0, At, B0); PG8_MMA(0, 1, At, B1); PG8_BAR; PG8_SCHED;
            PG8_LDA(At, 1, 1); PG8_STAGE(PG8_SB(1, 0), b3, voffB); PG8_STAGE(PG8_SB(1, 1), b3 + hstep, voffB); PG8_STAGE(PG8_SA(1, 0), a3, voffA);
            PG8_WAIT_V(8); PG8_WAIT_L(0); PG8_BAR; PG8_MMA(1, 0, At, B0); PG8_MMA(1, 1, At, B1); PG8_BAR; PG8_SCHED;
            } else {
            PG8_LDB(B0, 0, 0); PG8_SCHED; PG8_LDA(At, 0, 0); PG8_STAGE(PG8_SA(1, 1), a1 + hstep, voffA);
            PG8_WAIT_L(8); PG8_BAR; PG8_WAIT_L(0); PG8_MMA(0, 0, At, B0); PG8_BAR; PG8_SCHED;
            PG8_LDB(B1, 0, 1); PG8_STAGE(PG8_SB(0, 0), b2, voffB);
            PG8_BAR; PG8_WAIT_L(0); PG8_MMA(0, 1, At, B1); PG8_BAR;
            PG8_LDA(At, 0, 1); PG8_STAGE(PG8_SA(0, 0), a2, voffA);
            PG8_BAR; PG8_WAIT_L(0); PG8_MMA(1, 0, At, B0); PG8_BAR; PG8_SCHED;
            PG8_STAGE(PG8_SB(0, 1), b2 + hstep, voffB);
            PG8_WAIT_V(6); PG8_BAR; PG8_MMA(1, 1, At, B1); PG8_BAR;
            PG8_LDB(B0, 1, 0); PG8_SCHED; PG8_LDA(At, 1, 0); PG8_STAGE(PG8_SA(0, 1), a2 + hstep, voffA);
            PG8_WAIT_L(8); PG8_BAR; PG8_WAIT_L(0); PG8_MMA(0, 0, At, B0); PG8_BAR; PG8_SCHED;
            PG8_LDB(B1, 1, 1); PG8_STAGE(PG8_SB(1, 0), b3, voffB);
            PG8_BAR; PG8_WAIT_L(0); PG8_MMA(0, 1, At, B1); PG8_BAR;
            PG8_LDA(At, 1, 1); PG8_STAGE(PG8_SA(1, 0), a3, voffA);
            PG8_BAR; PG8_WAIT_L(0); PG8_MMA(1, 0, At, B0); PG8_BAR; PG8_SCHED;
            PG8_STAGE(PG8_SB(1, 1), b3 + hstep, voffB);
            PG8_WAIT_V(6); PG8_BAR; PG8_MMA(1, 1, At, B1); PG8_BAR;
            }
        }
        if constexpr (ALIGN_EPI) { if (wr == 0) PG8_BAR; }
        if constexpr (!Epi::AFTER_DRAIN) { E(acc, cur, wr, wc, fr, fq); S.done(cur); }
        if (!has_next) break;
#pragma unroll
        for (int a = 0; a < 2; ++a)
#pragma unroll
            for (int b = 0; b < 2; ++b)
#pragma unroll
                for (int m = 0; m < 4; ++m)
#pragma unroll
                    for (int n = 0; n < 2; ++n) acc[a][b][m][n] = (f32x4){0.f, 0.f, 0.f, 0.f};
        cur = nxt; cA = nA; cB = nB; ++ui;
        if constexpr (ALIGN_EPI) { if (wr == 1) PG8_BAR; }
    }
    PG8_WAIT_V(0);
    if constexpr (!ALIGN_EPI) { if (wr == 0) PG8_BAR; }
    PG8_BAR;
    if constexpr (Epi::AFTER_DRAIN) { E.fused(acc, cur, wr, wc, fr, fq, lds, wid, lane); S.done(cur); }
#undef PG8_SA
#undef PG8_SB
#undef PG8_STAGE
#undef PG8_LDA
#undef PG8_LDB
#undef PG8_MMA
#undef PG8_WAIT_V
#undef PG8_WAIT_L
#undef PG8_BAR
#undef PG8_SCHED
}
}
#define GAS __attribute__((address_space(1)))
#define LAS __attribute__((address_space(3)))
typedef unsigned short bf16;
typedef unsigned v4u __attribute__((ext_vector_type(4)));
typedef float f32x4 __attribute__((ext_vector_type(4)));
typedef short bf16x8 __attribute__((ext_vector_type(8)));
typedef GAS unsigned gu32;
typedef GAS unsigned long long gu64;
#define RLX_AGENT __ATOMIC_RELAXED, __HIP_MEMORY_SCOPE_AGENT
#define LDS_WAIT() asm volatile("s_waitcnt lgkmcnt(0)" ::: "memory")
#define VM_WAIT() asm volatile("s_waitcnt vmcnt(0)" ::: "memory")
__device__ __forceinline__ unsigned long long rt() { return __builtin_amdgcn_s_memrealtime(); }
__device__ __forceinline__ unsigned f2bf(float f) { unsigned u = __builtin_bit_cast(unsigned, f); return (u + 0x7fffu + ((u >> 16) & 1u)) >> 16; }
__device__ __forceinline__ unsigned pk2(float lo, float hi) { return f2bf(lo) | (f2bf(hi) << 16); }

#define XB_TMO      128
#define XB_XCNT(j)  (256  + 64 * (j))
#define XB_XSUB(j)  (1280 + 64 * (j))
#define XB_XGEN(j)  (2304 + 64 * (j))
#define XB_TOP      3328
#define XB_TOPGEN   3392
#define XCD_BAR_WORDS 3456
#define XB_SPIN_CAP (1u << 18)

__device__ __forceinline__ unsigned xb_ld(unsigned* p)              { return __hip_atomic_load(p, __ATOMIC_RELAXED, __HIP_MEMORY_SCOPE_AGENT); }
__device__ __forceinline__ unsigned xb_add(unsigned* p, unsigned v) { return __hip_atomic_fetch_add(p, v, __ATOMIC_RELAXED, __HIP_MEMORY_SCOPE_AGENT); }
__device__ __forceinline__ unsigned xb_xcc_id() { return (unsigned)__builtin_amdgcn_s_getreg((3 << 11) | 20) & 0xFu; }
#define XB_SPIN(cond, bar) do { unsigned _sp = 0; while (cond) { __builtin_amdgcn_s_sleep(1); \
    if ((++_sp & 255u) == 0u) { if (xb_ld(&(bar)[XB_TMO])) break; if (_sp > XB_SPIN_CAP) { atomicAdd(&(bar)[XB_TMO], 1u); break; } } } } while (0)

struct XcdBarrier {
    unsigned* bar; unsigned x;
    volatile LAS unsigned* st;
};

__device__ __forceinline__ XcdBarrier xcd_barrier_post(unsigned* bar, volatile LAS unsigned* st) {
    XcdBarrier b; b.bar = bar; b.x = xb_xcc_id(); b.st = st;
    if (threadIdx.x == 0) (void)xb_add(&bar[XB_XCNT(b.x)], 1u);
    return b;
}
__device__ __forceinline__ void xcd_barrier_complete(unsigned* bar, unsigned x, unsigned& nloc, unsigned& nx) {
    const unsigned G = gridDim.x * gridDim.y * gridDim.z;
    unsigned sum, cnt, mine, sp = 0u;
    for (;;) {
        sum = 0u; cnt = 0u; mine = 0u;
#pragma unroll
        for (unsigned j = 0; j < 16; ++j) { const unsigned c = xb_ld(&bar[XB_XCNT(j)]); sum += c; cnt += (c > 0u) ? 1u : 0u; mine = (j == x) ? c : mine; }
        if (sum == G) break;
        __builtin_amdgcn_s_sleep(1);
        if ((++sp & 255u) == 0u) { if (xb_ld(&bar[XB_TMO])) break; if (sp > XB_SPIN_CAP) { atomicAdd(&bar[XB_TMO], 1u); break; } }
    }
    nloc = mine > 0u ? mine : 1u; nx = cnt > 0u ? cnt : 1u;
}

__device__ __forceinline__ void xcd_barrier(const XcdBarrier& b) {
    asm volatile("s_waitcnt vmcnt(0)" ::: "memory");
    __syncthreads();
    if (threadIdx.x == 0) {
        unsigned* bar = b.bar;
        __builtin_amdgcn_s_waitcnt(0);
        unsigned nloc = b.st[0], nx = b.st[1];
        if (nloc == 0u) { xcd_barrier_complete(bar, b.x, nloc, nx); b.st[0] = nloc; b.st[1] = nx; }
        const unsigned old = xb_add(&bar[XB_XSUB(b.x)], 1u);
        const unsigned gen = old / nloc;
        if (old + 1u == (gen + 1u) * nloc) {
            __builtin_amdgcn_fence(__ATOMIC_RELEASE, "agent");
            asm volatile("s_waitcnt vmcnt(0)" ::: "memory");
            const unsigned og = xb_add(&bar[XB_TOP], 1u);
            const unsigned tg = og / nx;
            if (og + 1u == (tg + 1u) * nx) xb_add(&bar[XB_TOPGEN], 1u);
            else XB_SPIN(xb_ld(&bar[XB_TOPGEN]) == tg, bar);
            __builtin_amdgcn_fence(__ATOMIC_ACQUIRE, "agent");
            xb_add(&bar[XB_XGEN(b.x)], 1u);
            asm volatile("s_waitcnt vmcnt(0)" ::: "memory");
        } else {
            XB_SPIN(xb_ld(&bar[XB_XGEN(b.x)]) == gen, bar);
            __builtin_amdgcn_fence(__ATOMIC_ACQUIRE, "agent");
            asm volatile("s_waitcnt vmcnt(0)" ::: "memory");
        }
    }
    __syncthreads();
}
constexpr int NWAVES = 8;
constexpr int BATCH = 2, SEQ = 8192, NMETA = 16, LTOK = SEQ + NMETA  , DM = 1024, INDIM = 2560, RWKV_IN = 1792, RDIM = 512, DFF = 2816;
constexpr int MROWS = BATCH * LTOK  , MPAD = 16640  , MREAL = BATCH * SEQ;
constexpr int QOFF = RWKV_IN, KOFF = RWKV_IN + 512, VOFF = RWKV_IN + 512 + 128;
constexpr size_t MiB = 1u << 20;
constexpr size_t WS_CTL = 0, CTL_ZERO_BYTES = 64 * 1024;
constexpr size_t WS_WIN = 1 * MiB, WS_WOUT = 6 * MiB, WS_WUP = 8 * MiB, WS_WDN = 19 * MiB;
constexpr size_t WS_SSQP = 24 * MiB + 512 * 1024;
constexpr size_t WS_KN = 26 * MiB;
constexpr size_t WS_XN = 30 * MiB + 512 * 1024;
constexpr size_t WS_P = 63 * MiB;
constexpr size_t WS_YMIX = 144 * MiB + 512 * 1024;
constexpr size_t WS_H1B = 177 * MiB;
constexpr size_t WS_TAIL = 209 * MiB + 512 * 1024;
constexpr size_t WS_ACT = WS_XN;
constexpr size_t WS_END = 256 * MiB;
constexpr size_t PREPB = (size_t)MROWS * RDIM * 2;
static_assert(WS_WDN + (size_t)DM * DFF * 2 <= WS_SSQP && WS_SSQP + 16ull * MPAD * 4 <= WS_KN && WS_KN + (size_t)MROWS * 128 * 2 <= WS_XN, "ws map 1");
static_assert(WS_XN + (size_t)MPAD * DM * 2 <= WS_P && WS_XN + (size_t)MROWS * RDIM * 4 <= WS_P && WS_P + (size_t)MPAD * INDIM * 2 <= WS_YMIX && WS_YMIX + (size_t)MPAD * DM * 2 <= WS_H1B, "ws map 2");
static_assert(WS_H1B + (size_t)MPAD * DM * 2 <= WS_TAIL && WS_H1B + PREPB <= WS_TAIL && WS_TAIL + 2 * PREPB <= WS_END && WS_ACT + (size_t)MREAL * DFF * 2 <= WS_YMIX, "ws map 3");
static_assert(3 * PREPB <= (size_t)MREAL * DM * 4, "d_out holds RB, K2B, VB");
constexpr int CW_BAR = 4096;
constexpr int RING_OFF = 0, RING_BYTES = 131072, HALO_OFF = RING_BYTES  , LDSCTL_OFF = 147456  , MISC_OFF = LDSCTL_OFF + 320, LDS_BYTES = 148480;

__constant__ unsigned char c_bucket[128] = {0, 1, 2, 3, 4, 5, 6, 7, 8, 9, 10, 11, 12, 13, 14, 15, 16, 16, 16, 17, 17, 18, 18, 18, 19, 19, 19, 20, 20, 20, 20, 21, 21, 21, 21, 22, 22, 22, 22, 22, 23, 23, 23, 23, 23, 23, 24, 24, 24, 24, 24, 24, 25, 25, 25, 25, 25, 25, 25, 26, 26, 26, 26, 26, 26, 26, 26, 27, 27, 27, 27, 27, 27, 27, 27, 27, 27, 28, 28, 28, 28, 28, 28, 28, 28, 28, 28, 29, 29, 29, 29, 29, 29, 29, 29, 29, 29, 29, 29, 30, 30, 30, 30, 30, 30, 30, 30, 30, 30, 30, 30, 30, 30, 31, 31, 31, 31, 31, 31, 31, 31, 31, 31, 31, 31, 31, 31, 31};

struct Frame {
    LAS unsigned char* lds;
    volatile LAS unsigned* MISC;
    gu32* ctl;
    int tid, lane, wave, vcu, G;
    const float* in[25]; float* out; unsigned char* ws;
};
__device__ __forceinline__ float wave_sum(float v) {
#pragma unroll
    for (int o = 1; o < 64; o <<= 1) v += __shfl_xor(v, o);
    return v;
}
__device__ __forceinline__ float bf2f(bf16 u) { return __uint_as_float((unsigned)u << 16); }
__device__ __forceinline__ float bflo(unsigned u) { return __uint_as_float(u << 16); }
__device__ __forceinline__ float bfhi(unsigned u) { return __uint_as_float(u & 0xffff0000u); }
__device__ __forceinline__ float sigmoidf_(float x) { return 1.0f / (1.0f + __expf(-x)); }

enum { I_X = 0, I_META, I_RELB, I_N1W, I_WIN, I_MU, I_W0, I_WDEC, I_A0, I_AUP, I_GUP, I_KK, I_KA, I_RK, I_LNW, I_LNB, I_QNW, I_KNW, I_SINK, I_WOUT, I_N2W, I_WUP, I_CONVW, I_CONVB, I_WDN };

typedef float f32x16 __attribute__((ext_vector_type(16)));
struct Op2 { bf16x8 s[2]; };
__device__ __forceinline__ f32x16 mfma32(bf16x8 a, bf16x8 b, f32x16 c) { return __builtin_amdgcn_mfma_f32_32x32x16_bf16(a, b, c, 0, 0, 0); }
__device__ __forceinline__ f32x16 zero16() { f32x16 z; for (int i = 0; i < 16; ++i) z[i] = 0.f; return z; }
typedef float f32x2_t __attribute__((ext_vector_type(2)));
typedef __bf16 bf16x2_t __attribute__((ext_vector_type(2)));
__device__ __forceinline__ unsigned cvtpk(float lo, float hi) { f32x2_t v = {lo, hi}; bf16x2_t b = __builtin_convertvector(v, bf16x2_t); return __builtin_bit_cast(unsigned, b); }
__device__ __forceinline__ bf16x8 pack8(float a0, float a1, float a2, float a3, float a4, float a5, float a6, float a7) {
    v4u u; u.x = cvtpk(a0, a1); u.y = cvtpk(a2, a3); u.z = cvtpk(a4, a5); u.w = cvtpk(a6, a7); return __builtin_bit_cast(bf16x8, u); }
__device__ __forceinline__ Op2 tile2op(const f32x16& t) { Op2 o; o.s[0] = pack8(t[0], t[1], t[2], t[3], t[4], t[5], t[6], t[7]); o.s[1] = pack8(t[8], t[9], t[10], t[11], t[12], t[13], t[14], t[15]); return o; }
__device__ __forceinline__ int opaque(int x) { asm volatile("" : "+v"(x)); return x; }
__device__ __forceinline__ int trow(int q, int hf) { return 8 * (q >> 2) + 4 * hf + (q & 3); }
__device__ __forceinline__ bf16x8 const_op(int kind, int s, int n, int hf) {
    v4u u; unsigned w[4];
#pragma unroll
    for (int p = 0; p < 4; ++p) { const int j0 = 2 * p, j1 = 2 * p + 1; const int r0 = 16 * s + 8 * (j0 >> 2) + 4 * hf + (j0 & 3), r1 = 16 * s + 8 * (j1 >> 2) + 4 * hf + (j1 & 3);
        const bool b0 = kind == 0 ? true : (kind == 1 ? r0 <= n : (kind == 2 ? r0 < n : r0 == n)), b1 = kind == 0 ? true : (kind == 1 ? r1 <= n : (kind == 2 ? r1 < n : r1 == n));
        w[p] = (b0 ? 0x3F80u : 0u) | (b1 ? 0x3F800000u : 0u); }
    u.x = w[0]; u.y = w[1]; u.z = w[2]; u.w = w[3]; return __builtin_bit_cast(bf16x8, u); }
__device__ __forceinline__ bf16x8 tri_op(int diag, int strict, int s, int n, int hf) {
    unsigned w[4];
#pragma unroll
    for (int p = 0; p < 4; ++p) { const int j0 = 2 * p, j1 = 2 * p + 1; const int r0 = 16 * s + 8 * (j0 >> 2) + 4 * hf + (j0 & 3) + strict, r1 = 16 * s + 8 * (j1 >> 2) + 4 * hf + (j1 & 3) + strict;
        const bool b0 = diag ? (r0 <= n) : true, b1 = diag ? (r1 <= n) : true; w[p] = (b0 ? 0x3F80u : 0u) | (b1 ? 0x3F800000u : 0u); }
    v4u u; u.x = w[0]; u.y = w[1]; u.z = w[2]; u.w = w[3]; return __builtin_bit_cast(bf16x8, u); }
__device__ __forceinline__ f32x4 ld_xs4(const bf16* prow, bool hasprev, int col, const float* mu) {
    const uint2 c = *(const uint2*)(prow + col); uint2 p; p.x = 0u; p.y = 0u; if (hasprev) p = *(const uint2*)(prow - INDIM + col);
    const f32x4 m = *(const f32x4*)(mu + col);
    const f32x4 cv = (f32x4){bflo(c.x), bfhi(c.x), bflo(c.y), bfhi(c.y)}, pv = (f32x4){bflo(p.x), bfhi(p.x), bflo(p.y), bfhi(p.y)};
    return cv + (pv - cv) * m; }
constexpr int NCHUNK = 129, NJOBS = BATCH * NCHUNK * 8;
constexpr size_t WS_IMG = 256 * 1024;
constexpr size_t IMG_DEC = 0, IMG_AUP = 65536, IMG_GUP = 131072;
constexpr size_t JOB16 = (size_t)NJOBS * 16384, JOB8 = (size_t)NJOBS * 8192;
static_assert(JOB16 + JOB8 + 2048ull * 6144 <= (size_t)MREAL * DM * 4 && 2 * JOB8 + (size_t)MROWS * 32 + 2048ull * 6144 <= WS_END - WS_TAIL && JOB16 <= WS_TAIL - WS_H1B && 2 * JOB8 + (size_t)MROWS * 8 * 4 <= WS_END - WS_TAIL, "chunk buffers");
__device__ __forceinline__ float* buf_YL(Frame& F) { return (float*)F.out; }
__device__ __forceinline__ bf16* buf_QC(Frame& F) { return (bf16*)((unsigned char*)F.out + JOB16); }
__device__ __forceinline__ float* buf_NC(Frame& F) { return (float*)(F.ws + WS_H1B); }
__device__ __forceinline__ bf16* buf_MC(Frame& F) { return (bf16*)(F.ws + WS_TAIL); }
__device__ __forceinline__ bf16* buf_SC(Frame& F) { return (bf16*)(F.ws + WS_TAIL + JOB8); }
__device__ __forceinline__ float* buf_BON(Frame& F) { return (float*)(F.ws + WS_TAIL + 2 * JOB8); }

__device__ __forceinline__ void build_lora_img(const float* W, int nI, bf16x8* img, int e) {
    const int lane = e & 63, s = (e >> 6) & 1, B = (e >> 7) & 1, I = (e >> 8) % nI, h = (e >> 8) / nI, n = lane & 31, hf = lane >> 5;
    float v[8];
#pragma unroll
    for (int jj = 0; jj < 8; ++jj) { const int m = 32 * I + 16 * s + 8 * (jj >> 2) + 4 * hf + (jj & 3); v[jj] = W[(size_t)m * RDIM + 64 * h + 32 * B + n]; }
    img[e] = pack8(v[0], v[1], v[2], v[3], v[4], v[5], v[6], v[7]);
}

#define PARK_ST(slot, v) (*(LAS bf16x8*)(park + (slot) * 1024 + lane * 16) = (v))
#define PARK_LD(slot) (*(const LAS bf16x8*)(park + (slot) * 1024 + lane * 16))
#define GS_ST(slot, v) (*(bf16x8*)(gscr + (slot) * 1024 + lane * 16) = (v))
#define GS_LD(slot) (*(const bf16x8*)(gscr + (slot) * 1024 + lane * 16))
#define GS2_ST(slot, v) (*(bf16x8*)(gscr2 + (slot) * 1024 + lane * 16) = (v))
#define GS2_LD(slot) (*(const bf16x8*)(gscr2 + (slot) * 1024 + lane * 16))
#define GS3_ST(slot, v) (*(bf16x8*)(gscr3 + (slot) * 1024 + lane * 16) = (v))
#define GS3_LD(slot) (*(const bf16x8*)(gscr3 + (slot) * 1024 + lane * 16))
#define GS4_ST(slot, v) (*(bf16x8*)(gscr4 + (slot) * 1024 + lane * 16) = (v))
#define GS4_LD(slot) (*(const bf16x8*)(gscr4 + (slot) * 1024 + lane * 16))
#define FENCE() do { asm volatile("" ::: "memory"); __builtin_amdgcn_sched_barrier(0); } while (0)
__device__ __forceinline__ void rwkv_chunk_local(Frame& F, int job, LAS unsigned char* park, unsigned char* gscr, unsigned char* gscr2, unsigned char* gscr3, unsigned char* gscr4) {
    int lane_ = (int)__builtin_amdgcn_mbcnt_hi(~0u, __builtin_amdgcn_mbcnt_lo(~0u, 0u)); asm volatile("" : "+v"(lane_));
    const int lane = lane_, n = lane & 31, hf = lane >> 5;
    const int h = job & 7, bc = job >> 3, c = bc % NCHUNK, b = bc / NCHUNK;
    const int pos0 = 64 * c, nvalid = (LTOK - pos0) < 64 ? (LTOK - pos0) : 64;
    const bf16* P = (const bf16*)(F.ws + WS_P) + (size_t)(b * LTOK + pos0) * INDIM;
    const float* mu = F.in[I_MU];
    const bf16x8* imgD = (const bf16x8*)(F.ws + WS_IMG + IMG_DEC) + (size_t)h * 512; const bf16x8* imgA = (const bf16x8*)(F.ws + WS_IMG + IMG_AUP) + (size_t)h * 512;
    const int hc = 64 * h;
    constexpr int SL_AK[3] = {8, 0, 6}, SL_RB[3] = {10, 2, 14}, SL_RK[3] = {12, 4, 16};
    float lamC[2];
    {
        Op2 TW[2][2];
#pragma unroll
        for (int J = 0; J < 2; ++J) { const int t = 32 * J + n; const bool live = t < nvalid; const bf16* prow = P + (size_t)(live ? t : nvalid - 1) * INDIM; const bool hp = (pos0 + t) > 0;
#pragma unroll
            for (int I = 0; I < 2; ++I)
#pragma unroll
                for (int s = 0; s < 2; ++s) { const int c0 = 1536 + 32 * I + 16 * s + 4 * hf; f32x4 x0 = ld_xs4(prow, hp, c0, mu), x1 = ld_xs4(prow, hp, c0 + 8, mu);
                    if (!live) { x0 = (f32x4){0.f, 0.f, 0.f, 0.f}; x1 = x0; }
                    TW[I][J].s[s] = pack8(tanhf(x0[0]), tanhf(x0[1]), tanhf(x0[2]), tanhf(x0[3]), tanhf(x1[0]), tanhf(x1[1]), tanhf(x1[2]), tanhf(x1[3])); FENCE(); } }
#pragma unroll
        for (int B = 0; B < 2; ++B) { lamC[B] = 0.f; const float w0 = F.in[I_W0][hc + 32 * B + n];
#pragma unroll
            for (int A = 0; A < 2; ++A) { f32x16 acc = zero16();
#pragma unroll
                for (int I = 0; I < 2; ++I)
#pragma unroll
                    for (int s = 0; s < 2; ++s) acc = mfma32(TW[I][A].s[s], imgD[((I * 2 + B) * 2 + s) * 64 + lane], acc);
#pragma unroll
                for (int q = 0; q < 16; ++q) { const int t = 32 * A + trow(q, hf); const float e = t < nvalid ? 0.60653065971f * sigmoidf_(w0 + acc[q]) : 0.f; acc[q] = e; lamC[B] += e; }
                const Op2 eo = tile2op(acc); PARK_ST((A * 2 + B) * 2, eo.s[0]); PARK_ST((A * 2 + B) * 2 + 1, eo.s[1]); FENCE(); }
            lamC[B] += __shfl_xor(lamC[B], 32); }
    }
    FENCE();
    bf16* QC = buf_QC(F) + (size_t)job * 4096; float* BON = buf_BON(F);
#pragma unroll 1
    for (int b2 = 0; b2 < 2; ++b2) {
        const int t = 32 * b2 + n; const bool live = t < nvalid; const bf16* prow = P + (size_t)(live ? t : nvalid - 1) * INDIM; const bool hp = (pos0 + t) > 0;
        Op2 ADT[2];
#pragma unroll
        for (int I = 0; I < 2; ++I)
#pragma unroll
            for (int s = 0; s < 2; ++s) { const int c0 = 1600 + 32 * I + 16 * s + 4 * hf; f32x4 x0 = ld_xs4(prow, hp, c0, mu), x1 = ld_xs4(prow, hp, c0 + 8, mu);
                if (!live) { x0 = (f32x4){0.f, 0.f, 0.f, 0.f}; x1 = x0; }
                ADT[I].s[s] = pack8(x0[0], x0[1], x0[2], x0[3], x1[0], x1[1], x1[2], x1[3]); }
        float ss = 0.f;
#pragma unroll
        for (int g8 = 0; g8 < 8; ++g8) { const int j0 = 8 * g8 + 4 * hf; const f32x4 k4 = ld_xs4(prow, hp, 512 + hc + j0, mu); const f32x4 kkw = *(const f32x4*)(F.in[I_KK] + hc + j0);
#pragma unroll
            for (int cc = 0; cc < 4; ++cc) { const float x = (live ? k4[cc] : 0.f) * kkw[cc]; ss += x * x; } }
        ss += __shfl_xor(ss, 32);
        const float inv = 1.0f / fmaxf(sqrtf(ss), 1e-12f);
        float bon = 0.f;
#pragma unroll 1
        for (int a = 0; a < 2; ++a) {
            f32x16 lam = zero16(), lamp = zero16(), alr = zero16();
#pragma unroll 1
            for (int I = 0; I <= b2; ++I) { const int kd = (I == b2) ? 1 : 0;
#pragma unroll
                for (int s = 0; s < 2; ++s) { const bf16x8 eo = PARK_LD((I * 2 + a) * 2 + s); lam = mfma32(eo, tri_op(kd, 0, s, n, hf), lam); lamp = mfma32(eo, tri_op(kd, 1, s, n, hf), lamp); } }
#pragma unroll
            for (int I = 0; I < 2; ++I)
#pragma unroll
                for (int s = 0; s < 2; ++s) alr = mfma32(imgA[((I * 2 + a) * 2 + s) * 64 + lane], ADT[I].s[s], alr);
#pragma unroll
            for (int s = 0; s < 2; ++s) { float at[8], bt[8], kt[8], rt[8];
#pragma unroll
                for (int g2 = 0; g2 < 2; ++g2) { const int g4 = 2 * s + g2, j0 = 32 * a + 8 * g4 + 4 * hf;
                    const f32x4 k4 = ld_xs4(prow, hp, 512 + hc + j0, mu), r4 = ld_xs4(prow, hp, hc + j0, mu);
                    const f32x4 kkw = *(const f32x4*)(F.in[I_KK] + hc + j0), a04 = *(const f32x4*)(F.in[I_A0] + hc + j0), ka4 = *(const f32x4*)(F.in[I_KA] + hc + j0), rk4 = *(const f32x4*)(F.in[I_RK] + hc + j0);
#pragma unroll
                    for (int cc = 0; cc < 4; ++cc) { const int q = 4 * g4 + cc, o = 4 * g2 + cc; const float k = live ? k4[cc] : 0.f, r = live ? r4[cc] : 0.f;
                        const float al = sigmoidf_(a04[cc] + alr[q]); const float kk = k * kkw[cc] * inv; const float k2 = k * (1.0f + (al - 1.0f) * ka4[cc]);
                        const float eL = __expf(lam[q]), emL = __expf(-lam[q]), emLp = __expf(-lamp[q]);
                        at[o] = -kk * emLp; bt[o] = kk * al * eL; kt[o] = k2 * eL; rt[o] = r * emL; bon += r * k2 * rk4[cc]; }
                    uint2 w; w.x = cvtpk(rt[4 * g2], rt[4 * g2 + 1]); w.y = cvtpk(rt[4 * g2 + 2], rt[4 * g2 + 3]); *(uint2*)(QC + t * 64 + j0) = w; }
                GS3_ST(a * 2 + s, pack8(at[0], at[1], at[2], at[3], at[4], at[5], at[6], at[7])); GS4_ST(a * 2 + s, pack8(rt[0], rt[1], rt[2], rt[3], rt[4], rt[5], rt[6], rt[7]));
                GS_ST((0 * 2 + b2) * 4 + a * 2 + s, pack8(bt[0], bt[1], bt[2], bt[3], bt[4], bt[5], bt[6], bt[7])); GS_ST((1 * 2 + b2) * 4 + a * 2 + s, pack8(kt[0], kt[1], kt[2], kt[3], kt[4], kt[5], kt[6], kt[7])); }
        }
        bon += __shfl_xor(bon, 32);
        if (live && hf == 0) BON[(size_t)(b * LTOK + pos0 + t) * 8 + h] = bon;
        FENCE();
#pragma unroll 1
        for (int A = 0; A <= b2; ++A) { const int ti = A + b2;
#pragma unroll 1
            for (int which = 0; which < 4; ++which) { f32x16 x = zero16(); const unsigned char* rp = (which & 2) ? gscr4 : gscr3;
#pragma unroll
                for (int I = 0; I < 2; ++I)
#pragma unroll
                    for (int s = 0; s < 2; ++s) x = mfma32(GS_LD(((which & 1) * 2 + A) * 4 + I * 2 + s), *(const bf16x8*)(rp + (I * 2 + s) * 1024 + lane * 16), x);
                const int incl = which >> 1;
#pragma unroll
                for (int q = 0; q < 16; ++q) { const int sidx = 32 * A + trow(q, hf), tidx = 32 * b2 + n; x[q] = (sidx < tidx + incl) ? x[q] : 0.f; }
                const Op2 o = tile2op(x);
                if (which == 0) { GS2_ST(8 + 2 * ti, o.s[0]); GS2_ST(8 + 2 * ti + 1, o.s[1]); }
                else { const int sl = (which == 1 ? (ti == 0 ? 8 : (ti == 1 ? 0 : 6)) : (which == 2 ? (ti == 0 ? 10 : (ti == 1 ? 2 : 14)) : (ti == 0 ? 12 : (ti == 1 ? 4 : 16)))); PARK_ST(sl, o.s[0]); PARK_ST(sl + 1, o.s[1]); } }
        }
        { f32x16 x = zero16();
#pragma unroll
            for (int I = 0; I < 2; ++I)
#pragma unroll
                for (int s = 0; s < 2; ++s) x = mfma32(GS3_LD(I * 2 + s), GS_LD((0 * 2 + b2) * 4 + I * 2 + s), x);
#pragma unroll
            for (int q = 0; q < 16; ++q) x[q] = (n < trow(q, hf)) ? x[q] : 0.f;
            const Op2 o = tile2op(x); unsigned char* dp = b2 ? gscr4 : gscr3; *(bf16x8*)(dp + 4 * 1024 + lane * 16) = o.s[0]; *(bf16x8*)(dp + 5 * 1024 + lane * 16) = o.s[1]; }
        { const bf16x8 id0 = const_op(3, 0, n, hf), id1 = const_op(3, 1, n, hf);
#pragma unroll
        for (int B = 0; B < 2; ++B) { f32x16 x = zero16(); x = mfma32(GS3_LD(B * 2), id0, x); x = mfma32(GS3_LD(B * 2 + 1), id1, x); const Op2 o = tile2op(x); GS2_ST((b2 * 2 + B) * 2, o.s[0]); GS2_ST((b2 * 2 + B) * 2 + 1, o.s[1]); } }
        FENCE();
    }
    { const bf16x8 id0 = const_op(3, 0, n, hf), id1 = const_op(3, 1, n, hf);
#pragma unroll 1
    for (int m = 0; m < 2; ++m)
#pragma unroll 1
        for (int B = 0; B < 2; ++B) { const float sc = __expf(-(B ? lamC[1] : lamC[0]));
#pragma unroll 1
            for (int A = 0; A < 2; ++A) { f32x16 y = zero16(); const int sl = (m * 2 + A) * 4 + B * 2;
                y = mfma32(GS_LD(sl), id0, y); y = mfma32(GS_LD(sl + 1), id1, y);
#pragma unroll
                for (int q = 0; q < 16; ++q) y[q] *= sc;
                const Op2 yo = tile2op(y); GS_ST(sl, yo.s[0]); GS_ST(sl + 1, yo.s[1]); } } }
    FENCE();
    Op2 TT[3];
    {
        Op2 T11;
#pragma unroll
        for (int d = 0; d < 2; ++d) {
            Op2 X, Xt; X.s[0] = d ? GS4_LD(4) : GS3_LD(4); X.s[1] = d ? GS4_LD(5) : GS3_LD(5); Xt.s[0] = GS2_LD(8 + 4 * d); Xt.s[1] = GS2_LD(8 + 4 * d + 1);
            f32x16 T, Tt;
            { const v4u x0 = __builtin_bit_cast(v4u, X.s[0]), x1 = __builtin_bit_cast(v4u, X.s[1]), y0 = __builtin_bit_cast(v4u, Xt.s[0]), y1 = __builtin_bit_cast(v4u, Xt.s[1]);
                T[0] = bflo(x0.x); T[1] = bfhi(x0.x); T[2] = bflo(x0.y); T[3] = bfhi(x0.y); T[4] = bflo(x0.z); T[5] = bfhi(x0.z); T[6] = bflo(x0.w); T[7] = bfhi(x0.w);
                T[8] = bflo(x1.x); T[9] = bfhi(x1.x); T[10] = bflo(x1.y); T[11] = bfhi(x1.y); T[12] = bflo(x1.z); T[13] = bfhi(x1.z); T[14] = bflo(x1.w); T[15] = bfhi(x1.w);
                Tt[0] = bflo(y0.x); Tt[1] = bfhi(y0.x); Tt[2] = bflo(y0.y); Tt[3] = bfhi(y0.y); Tt[4] = bflo(y0.z); Tt[5] = bfhi(y0.z); Tt[6] = bflo(y0.w); Tt[7] = bfhi(y0.w);
                Tt[8] = bflo(y1.x); Tt[9] = bfhi(y1.x); Tt[10] = bflo(y1.y); Tt[11] = bfhi(y1.y); Tt[12] = bflo(y1.z); Tt[13] = bfhi(y1.z); Tt[14] = bflo(y1.w); Tt[15] = bfhi(y1.w);
#pragma unroll
                for (int q = 0; q < 16; ++q) if (trow(q, hf) == n) { T[q] += 1.0f; Tt[q] += 1.0f; } }
#pragma unroll
            for (int it = 0; it < 4; ++it) {
                f32x16 X2 = zero16(), X2t = zero16();
                X2 = mfma32(Xt.s[0], X.s[0], X2); X2 = mfma32(Xt.s[1], X.s[1], X2);
                X2t = mfma32(X.s[0], Xt.s[0], X2t); X2t = mfma32(X.s[1], Xt.s[1], X2t);
                const Op2 X2o = tile2op(X2), X2to = tile2op(X2t), Tto = tile2op(Tt);
                T = mfma32(Tto.s[0], X2o.s[0], T); T = mfma32(Tto.s[1], X2o.s[1], T);
                Tt = mfma32(X2o.s[0], Tto.s[0], Tt); Tt = mfma32(X2o.s[1], Tto.s[1], Tt);
                X = X2o; Xt = X2to;
            }
            if (d == 0) { T11 = tile2op(T); TT[0] = tile2op(Tt); } else { TT[2] = tile2op(Tt); }
        }
        f32x16 Z = zero16(); Z = mfma32(GS2_LD(10), T11.s[0], Z); Z = mfma32(GS2_LD(11), T11.s[1], Z);
        const Op2 Zo = tile2op(Z); f32x16 T21t = zero16(); T21t = mfma32(Zo.s[0], TT[2].s[0], T21t); T21t = mfma32(Zo.s[1], TT[2].s[1], T21t);
        TT[1] = tile2op(T21t);
    }
    FENCE();
    Op2 VCL[2][2], UL[2][2], PC[2][2];
    {
        const int n_o = opaque(n), hf_o = opaque(hf); const bf16x8 id0 = const_op(3, 0, n_o, hf_o), id1 = const_op(3, 1, n_o, hf_o);
#pragma unroll
        for (int J = 0; J < 2; ++J) { const int t = 32 * J + n; const bool live = t < nvalid; const bf16* prow = P + (size_t)(live ? t : nvalid - 1) * INDIM; const bool hp = (pos0 + t) > 0;
#pragma unroll
            for (int I = 0; I < 2; ++I) { Op2 vt;
#pragma unroll
                for (int s = 0; s < 2; ++s) { const int c0 = 1024 + hc + 32 * I + 16 * s + 4 * hf; f32x4 x0 = ld_xs4(prow, hp, c0, mu), x1 = ld_xs4(prow, hp, c0 + 8, mu);
                    if (!live) { x0 = (f32x4){0.f, 0.f, 0.f, 0.f}; x1 = x0; }
                    vt.s[s] = pack8(x0[0], x0[1], x0[2], x0[3], x1[0], x1[1], x1[2], x1[3]); FENCE(); }
                f32x16 x = zero16(); x = mfma32(vt.s[0], id0, x); x = mfma32(vt.s[1], id1, x); VCL[J][I] = tile2op(x); } }
    }
    FENCE();
    {
        Op2 X1[2][2];
#pragma unroll
        for (int A = 0; A < 2; ++A)
#pragma unroll
            for (int B = 0; B < 2; ++B) { f32x16 x = zero16();
#pragma unroll
                for (int I = 0; I <= A; ++I) { const int sl = SL_AK[I + A];
#pragma unroll
                    for (int s = 0; s < 2; ++s) x = mfma32(PARK_LD(sl + s), VCL[I][B].s[s], x); }
                X1[A][B] = tile2op(x); }
#pragma unroll
        for (int A = 0; A < 2; ++A)
#pragma unroll
            for (int B = 0; B < 2; ++B) { f32x16 u = zero16(), p = zero16();
#pragma unroll
                for (int I = 0; I <= A; ++I) { const int ti = I + A;
#pragma unroll
                    for (int s = 0; s < 2; ++s) { u = mfma32(TT[ti].s[s], X1[I][B].s[s], u); p = mfma32(TT[ti].s[s], GS2_LD((I * 2 + B) * 2 + s), p); } }
                UL[A][B] = tile2op(u); PC[A][B] = tile2op(p); }
    }
    FENCE();
    float* YL = buf_YL(F) + (size_t)job * 4096; float* NC = buf_NC(F) + (size_t)job * 4096; bf16* MC = buf_MC(F) + (size_t)job * 4096;
#pragma unroll
    for (int B = 0; B < 2; ++B) { const int t = 32 * B + n;
#pragma unroll
        for (int A = 0; A < 2; ++A) {
            f32x16 qt, yt = zero16();
#pragma unroll
            for (int g4 = 0; g4 < 4; ++g4) { const uint2 w = *(const uint2*)(QC + t * 64 + 32 * A + 8 * g4 + 4 * hf); qt[4 * g4] = bflo(w.x); qt[4 * g4 + 1] = bfhi(w.x); qt[4 * g4 + 2] = bflo(w.y); qt[4 * g4 + 3] = bfhi(w.y); }
#pragma unroll
            for (int I = 0; I <= B; ++I) { const int ti = I + B;
#pragma unroll
                for (int s = 0; s < 2; ++s) { const bf16x8 rb = PARK_LD(SL_RB[ti] + s), rk = PARK_LD(SL_RK[ti] + s);
                    qt = mfma32(PC[I][A].s[s], rb, qt); yt = mfma32(UL[I][A].s[s], rb, yt); yt = mfma32(VCL[I][A].s[s], rk, yt); } }
#pragma unroll
            for (int g4 = 0; g4 < 4; ++g4) { uint2 w; w.x = cvtpk(qt[4 * g4], qt[4 * g4 + 1]); w.y = cvtpk(qt[4 * g4 + 2], qt[4 * g4 + 3]); *(uint2*)(QC + t * 64 + 32 * A + 8 * g4 + 4 * hf) = w;
                *(f32x4*)(YL + t * 64 + 32 * A + 8 * g4 + 4 * hf) = (f32x4){yt[4 * g4], yt[4 * g4 + 1], yt[4 * g4 + 2], yt[4 * g4 + 3]}; } } }
    FENCE();
#pragma unroll
    for (int B = 0; B < 2; ++B) { const float dg = __expf(-lamC[B]);
#pragma unroll
        for (int A = 0; A < 2; ++A) { f32x16 mt = zero16(), nn = zero16();
#pragma unroll
            for (int I = 0; I < 2; ++I)
#pragma unroll
                for (int s = 0; s < 2; ++s) { mt = mfma32(PC[I][A].s[s], GS_LD((0 * 2 + I) * 4 + B * 2 + s), mt); nn = mfma32(GS_LD((0 * 2 + I) * 4 + A * 2 + s), UL[I][B].s[s], nn); nn = mfma32(GS_LD((1 * 2 + I) * 4 + A * 2 + s), VCL[I][B].s[s], nn); }
            if (A == B) {
#pragma unroll
                for (int q = 0; q < 16; ++q) if (trow(q, hf) == n) mt[q] += dg; }
#pragma unroll
            for (int g4 = 0; g4 < 4; ++g4) { uint2 w; w.x = cvtpk(mt[4 * g4], mt[4 * g4 + 1]); w.y = cvtpk(mt[4 * g4 + 2], mt[4 * g4 + 3]);
                *(uint2*)(MC + (32 * B + n) * 64 + 32 * A + 8 * g4 + 4 * hf) = w;
                *(f32x4*)(NC + (32 * B + n) * 64 + 32 * A + 8 * g4 + 4 * hf) = (f32x4){nn[4 * g4], nn[4 * g4 + 1], nn[4 * g4 + 2], nn[4 * g4 + 3]}; }
            FENCE(); } }
}

__device__ __forceinline__ void rwkv_scan(Frame& F, int sj) {
    int lane_ = (int)__builtin_amdgcn_mbcnt_hi(~0u, __builtin_amdgcn_mbcnt_lo(~0u, 0u)); asm volatile("" : "+v"(lane_));
    const int lane = lane_, vv = lane & 15, g = lane >> 4, bh = sj >> 2, vg = sj & 3, b = bh >> 3, h = bh & 7, v = 16 * vg + vv;
    const bf16* MC = buf_MC(F); const float* NC = buf_NC(F); bf16* SC = buf_SC(F);
    f32x4 S[4];
#pragma unroll
    for (int r = 0; r < 4; ++r) S[r] = (f32x4){0.f, 0.f, 0.f, 0.f};
    uint2 mC[4][2][2]; f32x4 nC[4];
    {
        const size_t jo = (size_t)((b * NCHUNK) * 8 + h) * 4096;
#pragma unroll
        for (int r = 0; r < 4; ++r) { nC[r] = *(const f32x4*)(NC + jo + v * 64 + 16 * r + 4 * g);
#pragma unroll
            for (int kk = 0; kk < 2; ++kk) { mC[r][kk][0] = *(const uint2*)(MC + jo + (16 * r + vv) * 64 + 32 * kk + 4 * g); mC[r][kk][1] = *(const uint2*)(MC + jo + (16 * r + vv) * 64 + 32 * kk + 16 + 4 * g); } }
    }
#pragma unroll 1
    for (int c = 0; c < NCHUNK; ++c) {
        const size_t jo = (size_t)((b * NCHUNK + c) * 8 + h) * 4096;
        uint2 mN[4][2][2]; f32x4 nN[4];
        { const int c1 = (c + 1 < NCHUNK) ? c + 1 : c; const size_t jn = (size_t)((b * NCHUNK + c1) * 8 + h) * 4096;
#pragma unroll
            for (int r = 0; r < 4; ++r) { nN[r] = *(const f32x4*)(NC + jn + v * 64 + 16 * r + 4 * g);
#pragma unroll
                for (int kk = 0; kk < 2; ++kk) { mN[r][kk][0] = *(const uint2*)(MC + jn + (16 * r + vv) * 64 + 32 * kk + 4 * g); mN[r][kk][1] = *(const uint2*)(MC + jn + (16 * r + vv) * 64 + 32 * kk + 16 + 4 * g); } } }
        uint2 sb[4];
#pragma unroll
        for (int r = 0; r < 4; ++r) { sb[r].x = cvtpk(S[r][0], S[r][1]); sb[r].y = cvtpk(S[r][2], S[r][3]); *(uint2*)(SC + jo + v * 64 + 16 * r + 4 * g) = sb[r]; }
        bf16x8 Bop[2];
#pragma unroll
        for (int kk = 0; kk < 2; ++kk) { v4u u; u.x = sb[2 * kk].x; u.y = sb[2 * kk].y; u.z = sb[2 * kk + 1].x; u.w = sb[2 * kk + 1].y; Bop[kk] = __builtin_bit_cast(bf16x8, u); }
#pragma unroll
        for (int r = 0; r < 4; ++r) { f32x4 acc = nC[r];
#pragma unroll
            for (int kk = 0; kk < 2; ++kk) { v4u u; u.x = mC[r][kk][0].x; u.y = mC[r][kk][0].y; u.z = mC[r][kk][1].x; u.w = mC[r][kk][1].y;
                acc = __builtin_amdgcn_mfma_f32_16x16x32_bf16(__builtin_bit_cast(bf16x8, u), Bop[kk], acc, 0, 0, 0); }
            S[r] = acc; }
#pragma unroll
        for (int r = 0; r < 4; ++r) { nC[r] = nN[r];
#pragma unroll
            for (int kk = 0; kk < 2; ++kk) { mC[r][kk][0] = mN[r][kk][0]; mC[r][kk][1] = mN[r][kk][1]; } }
    }
}

__device__ __forceinline__ void rwkv_output(Frame& F, int job) {
    int lane_ = (int)__builtin_amdgcn_mbcnt_hi(~0u, __builtin_amdgcn_mbcnt_lo(~0u, 0u)); asm volatile("" : "+v"(lane_));
    const int lane = lane_, n = lane & 31, hf = lane >> 5;
    const int h = job & 7, bc = job >> 3, c = bc % NCHUNK, b = bc / NCHUNK, hc = 64 * h;
    const int pos0 = 64 * c, nvalid = (LTOK - pos0) < 64 ? (LTOK - pos0) : 64;
    const bf16* P = (const bf16*)(F.ws + WS_P) + (size_t)(b * LTOK + pos0) * INDIM; const float* mu = F.in[I_MU];
    const bf16* QC = buf_QC(F) + (size_t)job * 4096; const bf16* SC = buf_SC(F) + (size_t)job * 4096; const float* YL = buf_YL(F) + (size_t)job * 4096; const float* BON = buf_BON(F);
    const bf16x8* imgG = (const bf16x8*)(F.ws + WS_IMG + IMG_GUP) + (size_t)h * 1024;
    bf16* YMIX = (bf16*)(F.ws + WS_YMIX);
#pragma unroll 1
    for (int B = 0; B < 2; ++B) {
        const int t = 32 * B + n; const bool live = t < nvalid; const bf16* prow = P + (size_t)(live ? t : nvalid - 1) * INDIM; const bool hp = (pos0 + t) > 0;
        Op2 SG[4];
#pragma unroll
        for (int I = 0; I < 4; ++I)
#pragma unroll
            for (int s = 0; s < 2; ++s) { const int c0 = 1664 + 32 * I + 16 * s + 4 * hf; const f32x4 x0 = ld_xs4(prow, hp, c0, mu), x1 = ld_xs4(prow, hp, c0 + 8, mu);
                SG[I].s[s] = pack8(sigmoidf_(x0[0]), sigmoidf_(x0[1]), sigmoidf_(x0[2]), sigmoidf_(x0[3]), sigmoidf_(x1[0]), sigmoidf_(x1[1]), sigmoidf_(x1[2]), sigmoidf_(x1[3])); }
        bf16x8 qb[4];
#pragma unroll
        for (int ks = 0; ks < 4; ++ks) qb[ks] = *(const bf16x8*)(QC + t * 64 + 16 * ks + 8 * hf);
        f32x16 y[2], gt[2]; float sum = 0.f;
#pragma unroll
        for (int A = 0; A < 2; ++A) {
#pragma unroll
            for (int g4 = 0; g4 < 4; ++g4) { const f32x4 w = *(const f32x4*)(YL + t * 64 + 32 * A + 8 * g4 + 4 * hf); y[A][4 * g4] = w[0]; y[A][4 * g4 + 1] = w[1]; y[A][4 * g4 + 2] = w[2]; y[A][4 * g4 + 3] = w[3]; }
#pragma unroll
            for (int ks = 0; ks < 4; ++ks) y[A] = mfma32(*(const bf16x8*)(SC + (32 * A + n) * 64 + 16 * ks + 8 * hf), qb[ks], y[A]);
            gt[A] = zero16();
#pragma unroll
            for (int I = 0; I < 4; ++I)
#pragma unroll
                for (int s = 0; s < 2; ++s) gt[A] = mfma32(imgG[((I * 2 + A) * 2 + s) * 64 + lane], SG[I].s[s], gt[A]);
#pragma unroll
            for (int q = 0; q < 16; ++q) sum += y[A][q]; }
        sum += __shfl_xor(sum, 32); const float mean = sum * (1.0f / 64.0f); float sq = 0.f;
#pragma unroll
        for (int A = 0; A < 2; ++A)
#pragma unroll
            for (int q = 0; q < 16; ++q) { const float d = y[A][q] - mean; sq += d * d; }
        sq += __shfl_xor(sq, 32); const float rstd = 1.0f / sqrtf(sq * (1.0f / 64.0f) + 64e-5f);
        const float bon = BON[(size_t)(b * LTOK + pos0 + (live ? t : nvalid - 1)) * 8 + h];
#pragma unroll
        for (int A = 0; A < 2; ++A)
#pragma unroll
            for (int g4 = 0; g4 < 4; ++g4) { const int i0 = 32 * A + 8 * g4 + 4 * hf; const f32x4 v4 = ld_xs4(prow, hp, 1024 + hc + i0, mu);
                const f32x4 lw = *(const f32x4*)(F.in[I_LNW] + hc + i0), lb = *(const f32x4*)(F.in[I_LNB] + hc + i0); float o[4];
#pragma unroll
                for (int cc = 0; cc < 4; ++cc) { const int q = 4 * g4 + cc; o[cc] = ((y[A][q] - mean) * rstd * lw[cc] + lb[cc] + bon * v4[cc]) * gt[A][q]; }
                if (live) { uint2 w; w.x = cvtpk(o[0], o[1]); w.y = cvtpk(o[2], o[3]); *(uint2*)(YMIX + (size_t)(b * LTOK + pos0 + t) * DM + hc + i0) = w; } }
    }
}

__device__ __forceinline__ void kn_prep(Frame& F) {
    const int lane = F.lane, gw = F.vcu * NWAVES + F.wave, NGW = F.G * NWAVES;
    const bf16* P = (const bf16*)(F.ws + WS_P); bf16* KN = (bf16*)(F.ws + WS_KN);
    for (int R = gw; R < MROWS; R += NGW)
#pragma unroll
        for (int hk = 0; hk < 2; ++hk) { const float k = bf2f(P[(size_t)R * INDIM + KOFF + 64 * hk + lane]); const float ss = wave_sum(k * k);
            KN[(size_t)R * 128 + 64 * hk + lane] = (bf16)f2bf(k * (1.0f / sqrtf(ss * (1.0f / 64.0f) + 1e-6f)) * F.in[I_KNW][lane]); }
}
__device__ __forceinline__ void p0_transpose_item(const float* W, int K, int N, bf16* WT, const float* ksc, int mode, LAS float* scr, int item, int lane) {
    const int nblk = N / 32, kb = item / nblk, nb = item % nblk, k0 = 64 * kb, n0 = 32 * nb;
#pragma unroll 8
    for (int i = 0; i < 32; ++i) { const int kk = 2 * i + (lane >> 5); float w = W[(size_t)(k0 + kk) * N + n0 + (lane & 31)]; if (ksc) w *= ksc[k0 + kk]; scr[kk * 33 + (lane & 31)] = w; }
    LDS_WAIT(); asm volatile("" ::: "memory");
    int d0 = n0;
    if (mode == 1) d0 = n0 < DFF ? (n0 / 128) * 256 + (n0 % 128) : ((n0 - DFF) / 128) * 256 + 128 + ((n0 - DFF) % 128);
    const int c = lane & 7;
#pragma unroll
    for (int j = 0; j < 4; ++j) { const int n = (lane >> 3) + 8 * j; const LAS float* s = scr + (8 * c) * 33 + n;
        v4u o; o.x = pk2(s[0 * 33], s[1 * 33]); o.y = pk2(s[2 * 33], s[3 * 33]); o.z = pk2(s[4 * 33], s[5 * 33]); o.w = pk2(s[6 * 33], s[7 * 33]);
        *(GAS v4u*)(WT + (size_t)(d0 + n) * K + k0 + 8 * c) = o; }
    LDS_WAIT(); asm volatile("" ::: "memory");
}
__device__ __forceinline__ void p0_prologue(Frame& F) {
    LAS float* scr = (LAS float*)(F.lds + RING_OFF + F.wave * 16384);
    const int gw = F.vcu * NWAVES + F.wave, NGW = F.G * NWAVES;
    constexpr int I_1 = (DM / 64) * (INDIM / 32), I_2 = (DM / 64) * (DM / 32), I_3 = (DM / 64) * (2 * DFF / 32), I_4 = (DFF / 64) * (DM / 32);
    constexpr int NITEMS = I_1 + I_2 + I_3 + I_4;
    for (int it = gw; it < NITEMS; it += NGW) {
        int r = it;
        if (r < I_1) { p0_transpose_item(F.in[I_WIN], DM, INDIM, (bf16*)(F.ws + WS_WIN), F.in[I_N1W], 0, scr, r, F.lane); continue; } r -= I_1;
        if (r < I_2) { p0_transpose_item(F.in[I_WOUT], DM, DM, (bf16*)(F.ws + WS_WOUT), nullptr, 0, scr, r, F.lane); continue; } r -= I_2;
        if (r < I_3) { p0_transpose_item(F.in[I_WUP], DM, 2 * DFF, (bf16*)(F.ws + WS_WUP), F.in[I_N2W], 1, scr, r, F.lane); continue; } r -= I_3;
        p0_transpose_item(F.in[I_WDN], DFF, DM, (bf16*)(F.ws + WS_WDN), nullptr, 0, scr, r, F.lane);
    }
    { bf16x8* imgD = (bf16x8*)(F.ws + WS_IMG + IMG_DEC); bf16x8* imgA = (bf16x8*)(F.ws + WS_IMG + IMG_AUP); bf16x8* imgG = (bf16x8*)(F.ws + WS_IMG + IMG_GUP);
      for (int e = (F.vcu * NWAVES + F.wave) * 64 + F.lane; e < 16384; e += F.G * NWAVES * 64) {
          if (e < 4096) build_lora_img(F.in[I_WDEC], 2, imgD, e); else if (e < 8192) build_lora_img(F.in[I_AUP], 2, imgA, e - 4096); else build_lora_img(F.in[I_GUP], 4, imgG, e - 8192); } }
    bf16* XN = (bf16*)(F.ws + WS_XN);
    for (int R = gw; R < MPAD; R += NGW) {
        GAS unsigned long long* o8 = (GAS unsigned long long*)(XN + (size_t)R * DM) + F.lane;
        if (R >= MROWS) {
#pragma unroll
            for (int j = 0; j < 4; ++j) o8[64 * j] = 0ull;
            continue; }
        const int b = R / LTOK, pos = R % LTOK;
        const float* src = pos < NMETA ? F.in[I_META] + (size_t)pos * DM : F.in[I_X] + ((size_t)b * SEQ + pos - NMETA) * DM;
        const GAS f32x4* xr = (const GAS f32x4*)src + F.lane;
        f32x4 v[4]; float s = 0.f;
#pragma unroll
        for (int j = 0; j < 4; ++j) { v[j] = xr[64 * j]; s += (v[j].x * v[j].x + v[j].y * v[j].y) + (v[j].z * v[j].z + v[j].w * v[j].w); }
        const float rs = 1.0f / sqrtf(wave_sum(s) * (1.0f / DM) + 1e-6f);
#pragma unroll
        for (int j = 0; j < 4; ++j) o8[64 * j] = (unsigned long long)pk2(v[j].x * rs, v[j].y * rs) | ((unsigned long long)pk2(v[j].z * rs, v[j].w * rs) << 32);
    }
}

__device__ __forceinline__ void p4_attention(Frame& F, int w0, int nw) {
    const int lane = F.lane;
    const bf16* P = (const bf16*)(F.ws + WS_P); const bf16* KN = (const bf16*)(F.ws + WS_KN); bf16* YMIX = (bf16*)(F.ws + WS_YMIX);
    const float* relb = F.in[I_RELB];
    constexpr int NPB = (LTOK + 63) / 64;
    for (int job = w0; job < BATCH * NPB * 8; job += nw) {
        const int hq = job & 7, pb = (job >> 3) % NPB, b = (job >> 3) / NPB, hkv = hq >> 2;
        const int qpos_raw = 64 * pb + lane; const bool live = qpos_raw < LTOK; const int qpos = live ? qpos_raw : LTOK - 1;
        const size_t R = (size_t)b * LTOK + qpos;
        float q[64], o[64];
        { const v4u* qp = (const v4u*)(P + R * INDIM + QOFF + 64 * hq); float ss = 0.f;
#pragma unroll
            for (int c8 = 0; c8 < 8; ++c8) { const v4u u = qp[c8]; q[8 * c8 + 0] = bflo(u.x); q[8 * c8 + 1] = bfhi(u.x); q[8 * c8 + 2] = bflo(u.y); q[8 * c8 + 3] = bfhi(u.y); q[8 * c8 + 4] = bflo(u.z); q[8 * c8 + 5] = bfhi(u.z); q[8 * c8 + 6] = bflo(u.w); q[8 * c8 + 7] = bfhi(u.w); }
#pragma unroll
            for (int d = 0; d < 64; ++d) ss += q[d] * q[d];
            const float rs = 0.125f / sqrtf(ss * (1.0f / 64.0f) + 1e-6f);
#pragma unroll
            for (int d = 0; d < 64; ++d) { q[d] = q[d] * rs * F.in[I_QNW][d]; o[d] = 0.f; } }
        float m = F.in[I_SINK][hq], l = 1.0f;
#pragma unroll 1
        for (int it = 0; it < NMETA + 128; ++it) {
            int kpos; bool valid; float bias;
            if (it < NMETA) { kpos = it; valid = kpos <= qpos; const int dist = qpos - kpos; const int bk = (dist >= 0 && dist < 128) ? c_bucket[dist] : 31; bias = relb[bk * 8 + hq]; }
            else { const int dd = it - NMETA; kpos = qpos - dd; valid = kpos >= NMETA; bias = relb[c_bucket[dd] * 8 + hq]; }
            if (kpos < 0) kpos = 0;
            const size_t KR = (size_t)b * LTOK + kpos;
            const v4u* kp = (const v4u*)(KN + KR * 128 + 64 * hkv);
            float s = 0.f;
#pragma unroll
            for (int c8 = 0; c8 < 8; ++c8) { const v4u u = kp[c8];
                s += q[8 * c8 + 0] * bflo(u.x) + q[8 * c8 + 1] * bfhi(u.x) + q[8 * c8 + 2] * bflo(u.y) + q[8 * c8 + 3] * bfhi(u.y) + q[8 * c8 + 4] * bflo(u.z) + q[8 * c8 + 5] * bfhi(u.z) + q[8 * c8 + 6] * bflo(u.w) + q[8 * c8 + 7] * bfhi(u.w); }
            s += bias;
            if (valid) {
                const float mn = fmaxf(m, s), alpha = __expf(m - mn), p = __expf(s - mn); l = l * alpha + p; m = mn;
                const v4u* vp = (const v4u*)(P + KR * INDIM + VOFF + 64 * hkv);
#pragma unroll
                for (int c8 = 0; c8 < 8; ++c8) { const v4u u = vp[c8];
                    o[8 * c8 + 0] = o[8 * c8 + 0] * alpha + p * bflo(u.x); o[8 * c8 + 1] = o[8 * c8 + 1] * alpha + p * bfhi(u.x); o[8 * c8 + 2] = o[8 * c8 + 2] * alpha + p * bflo(u.y); o[8 * c8 + 3] = o[8 * c8 + 3] * alpha + p * bfhi(u.y);
                    o[8 * c8 + 4] = o[8 * c8 + 4] * alpha + p * bflo(u.z); o[8 * c8 + 5] = o[8 * c8 + 5] * alpha + p * bfhi(u.z); o[8 * c8 + 6] = o[8 * c8 + 6] * alpha + p * bflo(u.w); o[8 * c8 + 7] = o[8 * c8 + 7] * alpha + p * bfhi(u.w); }
            }
        }
        if (live) { const float il = 1.0f / l; v4u* op = (v4u*)(YMIX + R * DM + 512 + 64 * hq);
#pragma unroll
            for (int c8 = 0; c8 < 8; ++c8) { v4u w; w.x = pk2(o[8 * c8 + 0] * il, o[8 * c8 + 1] * il); w.y = pk2(o[8 * c8 + 2] * il, o[8 * c8 + 3] * il); w.z = pk2(o[8 * c8 + 4] * il, o[8 * c8 + 5] * il); w.w = pk2(o[8 * c8 + 6] * il, o[8 * c8 + 7] * il); op[c8] = w; } }
    }
}

__device__ __forceinline__ void p5_meta_rows(Frame& F, int blk) {
    const int b = blk >> 1, row = 14 + (blk & 1), U = b * LTOK + row, tid = F.tid;
    LAS float* ys = (LAS float*)(F.lds + RING_OFF); LAS float* red = ys + 1024;
    const bf16* YMIX = (const bf16*)(F.ws + WS_YMIX); const bf16* WT = (const bf16*)(F.ws + WS_WOUT); bf16* H1B = (bf16*)(F.ws + WS_H1B); float* SSQP = (float*)(F.ws + WS_SSQP);
    for (int k = tid; k < DM; k += 512) ys[k] = bf2f(YMIX[(size_t)U * DM + k]);
    __syncthreads();
    float ssq = 0.f;
#pragma unroll 1
    for (int cc = 0; cc < 2; ++cc) { const int col = tid + 512 * cc; const v4u* wp = (const v4u*)(WT + (size_t)col * DM); float acc = 0.f;
#pragma unroll 4
        for (int k8 = 0; k8 < DM / 8; ++k8) { const v4u u = wp[k8]; const f32x4 y0 = *(const LAS f32x4*)(ys + 8 * k8), y1 = *(const LAS f32x4*)(ys + 8 * k8 + 4);
            acc += bflo(u.x) * y0.x + bfhi(u.x) * y0.y + bflo(u.y) * y0.z + bfhi(u.y) * y0.w + bflo(u.z) * y1.x + bfhi(u.z) * y1.y + bflo(u.w) * y1.z + bfhi(u.w) * y1.w; }
        const float h = F.in[I_META][(size_t)row * DM + col] + acc; ssq += h * h; H1B[(size_t)U * DM + col] = (bf16)f2bf(h); }
    ssq = wave_sum(ssq);
    if (F.lane == 0) red[F.wave] = ssq;
    __syncthreads();
    if (tid < 16) { float t = 0.f; if (tid == 0) { for (int w = 0; w < NWAVES; ++w) t += red[w]; } SSQP[(size_t)tid * MPAD + U] = t; }
    __syncthreads();
}

#ifndef MK_N_LAUNCHES
#define MK_N_LAUNCHES 1
#endif
constexpr int N_LAUNCHES = MK_N_LAUNCHES;
constexpr int PER_PHASE = 8;
struct Args { const float* in[25]; float* out; unsigned char* ws; int ph_lo, ph_hi; };
__global__ void __launch_bounds__(NWAVES * 64, 2) hymba_fwd(Args args) {
    extern __shared__ __attribute__((aligned(16))) unsigned char lds[];
    Frame F;
    F.lds = (LAS unsigned char*)lds;
    F.MISC = (volatile LAS unsigned*)(F.lds + MISC_OFF);
    F.tid = threadIdx.x; F.lane = F.tid & 63; F.wave = __builtin_amdgcn_readfirstlane(F.tid >> 6);
    F.G = gridDim.x; { const int bx = blockIdx.x; F.vcu = (F.G % 8 == 0) ? (bx % 8) * (F.G / 8) + bx / 8 : bx; }
    F.ws = args.ws; F.out = args.out; F.ctl = (gu32*)(args.ws + WS_CTL);
#pragma unroll
    for (int i = 0; i < 25; ++i) F.in[i] = args.in[i];
    for (int u = F.tid; u < (LDS_BYTES - LDSCTL_OFF) / 4; u += NWAVES * 64) ((LAS unsigned*)(F.lds + LDSCTL_OFF))[u] = 0u;
    __syncthreads();
    XcdBarrier bar; bar.bar = (unsigned*)(F.ctl + CW_BAR); bar.x = 0; bar.st = nullptr;
    if (N_LAUNCHES == 1) bar = xcd_barrier_post((unsigned*)(F.ctl + CW_BAR), F.MISC + 8);
    const int lo = args.ph_lo, hi = args.ph_hi;
#define IN(k) (lo <= (k) && (k) < hi)
#define SEAM(k) do { if (IN(k) && IN((k) + 1)) xcd_barrier(bar); } while (0)
    bf16* XN = (bf16*)(F.ws + WS_XN); bf16* PB = (bf16*)(F.ws + WS_P); bf16* YMIX = (bf16*)(F.ws + WS_YMIX); bf16* H1B = (bf16*)(F.ws + WS_H1B); bf16* ACT = (bf16*)(F.ws + WS_ACT);
    float* SSQP = (float*)(F.ws + WS_SSQP);

    if (IN(0)) { p0_prologue(F); SEAM(0); }
    if (IN(1)) {
        pg8::Gemm g{XN, (const bf16*)(F.ws + WS_WIN), MPAD, INDIM, DM}; pg8::StaticOrderT<0> S; S.init(MPAD, INDIM, F.G, (int)blockIdx.x);
        pg8::EpiBf16 E{PB, INDIM};
        pg8::gemm_phase<pg8::EpiBf16, pg8::StaticOrderT<0>, true, true>(F.lds + RING_OFF, g, S, E);
        SEAM(1);
    }
    if (IN(2)) {
        LAS unsigned char* park = F.lds + F.wave * 18432;
        const int gw = F.vcu * NWAVES + F.wave, NGW = F.G * NWAVES;
#pragma unroll 1
        for (int job = gw; job < NJOBS; job += NGW) rwkv_chunk_local(F, job, park, F.ws + WS_XN + (size_t)gw * 16384, F.ws + WS_YMIX + (size_t)gw * 16384, (unsigned char*)F.out + JOB16 + JOB8 + (size_t)gw * 6144, F.ws + WS_TAIL + 2 * JOB8 + (size_t)MROWS * 32 + (size_t)gw * 6144);
        kn_prep(F);
        SEAM(2);
    }
    if (IN(3)) {
        const int blk = (int)blockIdx.x;
        if (blk < 64 && F.wave == 0) rwkv_scan(F, blk);
        else p4_attention(F, blk < 64 ? blk * 7 + F.wave - 1 : 448 + (blk - 64) * 8 + F.wave, 448 + (F.G - 64) * 8);
        SEAM(3);
    }
    if (IN(4)) {
        const int gw = F.vcu * NWAVES + F.wave, NGW = F.G * NWAVES;
#pragma unroll 1
        for (int job = gw; job < NJOBS; job += NGW) rwkv_output(F, job);
        SEAM(4);
    }
    if (IN(5)) {
        if (blockIdx.x < 4) p5_meta_rows(F, (int)blockIdx.x);
        pg8::Gemm g{YMIX, (const bf16*)(F.ws + WS_WOUT), MREAL, DM, DM}; pg8::StaticOrderT<1> S; S.init(MREAL, DM, F.G, (int)blockIdx.x);
        pg8::EpiH1 E{F.in[I_X], F.out, H1B, SSQP, MPAD};
        pg8::gemm_phase<pg8::EpiH1, pg8::StaticOrderT<1>, true, true>(F.lds + RING_OFF, g, S, E);
        SEAM(5);
    }
    if (IN(6)) {
        pg8::Gemm g{H1B, (const bf16*)(F.ws + WS_WUP), 66 * 256, 2 * DFF, DM}; pg8::StaticOrderT<2> S; S.init(66 * 256, 2 * DFF, F.G, (int)blockIdx.x);
        pg8::EpiAct E{ACT, SSQP, MPAD, F.in[I_CONVW], F.in[I_CONVB], (LAS float*)(F.lds + HALO_OFF)};
        pg8::gemm_phase<pg8::EpiAct, pg8::StaticOrderT<2>, true, true>(F.lds + RING_OFF, g, S, E);
        SEAM(6);
    }
    if (IN(7)) {
        pg8::Gemm g{ACT, (const bf16*)(F.ws + WS_WDN), MREAL, DM, DFF}; pg8::StaticOrderT<0> S; S.init(MREAL, DM, F.G, (int)blockIdx.x);
        pg8::EpiOut E{F.out};
        pg8::gemm_phase<pg8::EpiOut, pg8::StaticOrderT<0>, true, true>(F.lds + RING_OFF, g, S, E);
    }
#undef IN
#undef SEAM
}

extern "C" void kernel_launch(void* const* d_in, const int* in_sizes, int n_in, void* d_out, int out_size, void* d_ws, size_t ws_size, hipStream_t stream) {
    static int grid = 0;
    if (grid == 0) {
        if (n_in != 25 || out_size != MREAL * DM || ws_size < WS_END) { fprintf(stderr, "kernel_launch: unexpected shapes n_in %d out %d ws %zu\n", n_in, out_size, ws_size); grid = -1; return; }
        int dev = 0, cus = 0;
        if (hipGetDevice(&dev) != hipSuccess || hipDeviceGetAttribute(&cus, hipDeviceAttributeMultiprocessorCount, dev) != hipSuccess) { grid = -1; return; }
        if (hipFuncSetAttribute((const void*)hymba_fwd, hipFuncAttributeMaxDynamicSharedMemorySize, LDS_BYTES) != hipSuccess) { fprintf(stderr, "kernel_launch: hipFuncSetAttribute failed\n"); grid = -1; return; }
        (void)hipGetLastError();
        grid = cus;
    }
    if (grid < 0) return;
    (void)hipMemsetAsync((char*)d_ws + WS_CTL, 0, CTL_ZERO_BYTES, stream);
    Args a{};
    for (int i = 0; i < 25; ++i) a.in[i] = (const float*)d_in[i];
    a.out = (float*)d_out; a.ws = (unsigned char*)d_ws;
    for (int li = 0; li < N_LAUNCHES; ++li) {
        a.ph_lo = (N_LAUNCHES == 1) ? 0 : li; a.ph_hi = (N_LAUNCHES == 1) ? PER_PHASE : li + 1;
        hipLaunchKernelGGL(hymba_fwd, dim3(grid), dim3(NWAVES * 64), LDS_BYTES, stream, a);
    }
}
```

```cpp
#include <hip/hip_runtime.h>
#include <cstdio>
#include <cstdint>
namespace pg8 {
#define PG8_LAS __attribute__((address_space(3)))
typedef unsigned short bf16_t;
typedef short bf16x8 __attribute__((ext_vector_type(8)));
typedef float f32x4 __attribute__((ext_vector_type(4)));
typedef unsigned u32x4 __attribute__((ext_vector_type(4)));
constexpr int BM = 256, BK = 64, HALF = 128, HTB = HALF * BK * 2  , STAGE_BYTES = 8 * HTB, NXCD = 8, WGM = 8;

__host__ __device__ __forceinline__ int lds_byte(int r, int c) { const int st = (r >> 4) * 2 + (c >> 5), rr = r & 15, cc = c & 31, ob = rr * 64 + cc * 2; return st * 1024 + (ob ^ (((ob >> 9) & 1) << 5)); }
__host__ __device__ __forceinline__ void stage_rc(int b, int& R, int& C) { const int st = b / 1024, sb = b % 1024, swz = sb ^ (((sb >> 9) & 1) << 5); R = (st >> 1) * 16 + swz / 64; C = (st & 1) * 32 + (swz % 64) / 2; }
__host__ __device__ __forceinline__ int perm32(int rho) { const int n = rho >> 4, i = rho & 15; return 8 * (i >> 2) + 4 * n + (i & 3); }

struct Unit { int pm, pn; };
struct Gemm { const bf16_t* A; const bf16_t* Bt; int M, N, K; };

template <int AMODE> struct StaticOrderT {
    int nM, nN, nwg, G, c;
    __host__ __device__ void init(int M, int N, int G_, int c_) { nM = M / BM; nN = N / BM; nwg = nM * nN; G = G_; c = c_; }
    __host__ __device__ bool next(int i, Unit& u) const {
        const long L = (long)i * G + c; if (L >= nwg) return false;
        int wgid = (int)L; { const int q = nwg / NXCD, r = nwg % NXCD, xcd = wgid % NXCD, off = wgid / NXCD; wgid = (xcd < r ? xcd * (q + 1) : r * (q + 1) + (xcd - r) * q) + off; }
        const int nig = WGM * nN, gid = wgid / nig, fm = gid * WGM, gsz = (nM - fm) < WGM ? (nM - fm) : WGM;
        u.pm = fm + ((wgid % nig) % gsz); u.pn = (wgid % nig) / gsz; return true;
    }
    __host__ __device__ __forceinline__ int a_row0(const Unit& u) const { return AMODE == 0 ? u.pm * BM : (AMODE == 1 ? (u.pm >> 5) * 8208 + 16 + (u.pm & 31) * 256 : (u.pm / 33) * 8208 + 14 + 254 * (u.pm % 33)); }
    __device__ __forceinline__ void a_ready(const Unit&) const {}
    __device__ __forceinline__ void done(const Unit&) const {}
};

__device__ __forceinline__ unsigned cvt_pk_bf16(float lo, float hi) { unsigned r; asm volatile("v_cvt_pk_bf16_f32 %0, %1, %2" : "=v"(r) : "v"(lo), "v"(hi)); return r; }
typedef float f32x2 __attribute__((ext_vector_type(2)));
typedef unsigned u32x2 __attribute__((ext_vector_type(2)));
struct EpiBf16 {
    static constexpr bool PERM = true, AFTER_DRAIN = false;
    bf16_t* O; int ldc;
    __device__ __forceinline__ void operator()(f32x4 (&acc)[2][2][4][2], const Unit& u, int wr, int wc, int fr, int fq) const {
        const int row0 = u.pm * BM + wr * 64 + fr, col0 = u.pn * BM + wc * 32 + 8 * fq;
#pragma unroll
        for (int ai = 0; ai < 2; ++ai)
#pragma unroll
            for (int m = 0; m < 4; ++m) { bf16_t* rowp = O + (size_t)(row0 + ai * HALF + m * 16) * ldc + col0;
#pragma unroll
                for (int bj = 0; bj < 2; ++bj) { const f32x4 v0 = acc[ai][bj][m][0], v1 = acc[ai][bj][m][1];
                    u32x4 w; w.x = cvt_pk_bf16(v0[0], v0[1]); w.y = cvt_pk_bf16(v0[2], v0[3]); w.z = cvt_pk_bf16(v1[0], v1[1]); w.w = cvt_pk_bf16(v1[2], v1[3]);
                    *(u32x4*)(rowp + bj * HALF) = w; } }
    }
};
struct EpiH1 {
    static constexpr bool PERM = false, AFTER_DRAIN = false;
    const float* x; float* out; bf16_t* h1b; float* ssqp; int ssq_stride;
    __device__ __forceinline__ void operator()(f32x4 (&acc)[2][2][4][2], const Unit& u, int wr, int wc, int fr, int fq) const {
        const int col0 = u.pn * BM + wc * 32 + 4 * fq;
#pragma unroll
        for (int ai = 0; ai < 2; ++ai)
#pragma unroll
            for (int m = 0; m < 4; ++m) { const int rr = u.pm * BM + ai * HALF + wr * 64 + m * 16 + fr; const int U = (rr >> 13) * 8208 + 16 + (rr & 8191); float s = 0.f;
#pragma unroll
                for (int bj = 0; bj < 2; ++bj)
#pragma unroll
                    for (int n = 0; n < 2; ++n) { const size_t off = (size_t)rr * 1024 + col0 + bj * HALF + n * 16;
                        const f32x4 h = *(const f32x4*)(x + off) + acc[ai][bj][m][n]; *(f32x4*)(out + off) = h;
                        s += (h[0] * h[0] + h[1] * h[1]) + (h[2] * h[2] + h[3] * h[3]);
                        u32x2 w; w.x = cvt_pk_bf16(h[0], h[1]); w.y = cvt_pk_bf16(h[2], h[3]); *(u32x2*)(h1b + (size_t)U * 1024 + col0 + bj * HALF + n * 16) = w; }
                s += __shfl_xor(s, 16); s += __shfl_xor(s, 32);
                if (fq == 0) ssqp[(size_t)(u.pn * 4 + wc) * ssq_stride + U] = s; }
    }
};
struct EpiOut {
    static constexpr bool PERM = false, AFTER_DRAIN = false;
    float* out;
    __device__ __forceinline__ void operator()(f32x4 (&acc)[2][2][4][2], const Unit& u, int wr, int wc, int fr, int fq) const {
        const int col0 = u.pn * BM + wc * 32 + 4 * fq;
#pragma unroll
        for (int ai = 0; ai < 2; ++ai)
#pragma unroll
            for (int m = 0; m < 4; ++m) { const int rr = u.pm * BM + ai * HALF + wr * 64 + m * 16 + fr;
#pragma unroll
                for (int bj = 0; bj < 2; ++bj)
#pragma unroll
                    for (int n = 0; n < 2; ++n) { const size_t off = (size_t)rr * 1024 + col0 + bj * HALF + n * 16; *(f32x4*)(out + off) = *(const f32x4*)(out + off) + acc[ai][bj][m][n]; } }
    }
};
struct EpiAct {
    static constexpr bool PERM = true, AFTER_DRAIN = false;
    bf16_t* act; const float* ssqp; int ssq_stride; const float* conv_w; const float* conv_b; PG8_LAS float* halo;
    __device__ __forceinline__ void operator()(f32x4 (&acc)[2][2][4][2], const Unit& u, int wr, int wc, int fr, int fq) const {
        const int b = u.pm / 33, ti = u.pm % 33, lane = fq * 16 + fr;
#pragma unroll
        for (int ai = 0; ai < 2; ++ai)
#pragma unroll
            for (int m = 0; m < 4; ++m) { const int pos = 14 + 254 * ti + ai * HALF + wr * 64 + m * 16 + fr; float rs = 0.f;
                if (pos <= 8207) { const int U = b * 8208 + pos; float s = 0.f;
#pragma unroll
                    for (int p = 0; p < 16; ++p) s += ssqp[(size_t)p * ssq_stride + U];
                    rs = 1.0f / sqrtf(s * (1.0f / 1024.0f) + 1e-6f); }
#pragma unroll
                for (int bj = 0; bj < 2; ++bj)
#pragma unroll
                    for (int n = 0; n < 2; ++n) acc[ai][bj][m][n] = acc[ai][bj][m][n] * rs; }
        if (fr >= 14) {
#pragma unroll
            for (int ai = 0; ai < 2; ++ai)
#pragma unroll
                for (int bj = 0; bj < 2; ++bj)
#pragma unroll
                    for (int n = 0; n < 2; ++n) *(PG8_LAS f32x4*)(halo + ((2 * ai + wr) * 2 + (fr - 14)) * 256 + bj * 128 + wc * 32 + 8 * fq + 4 * n) = acc[ai][bj][3][n];
        }
        asm volatile("s_waitcnt lgkmcnt(0)" ::: "memory"); __builtin_amdgcn_s_barrier(); asm volatile("" ::: "memory");
        const int src1 = (lane & 48) | ((fr + 15) & 15), src2 = (lane & 48) | ((fr + 14) & 15);
        u32x2 res[2][4][2];
#pragma unroll
        for (int n = 0; n < 2; ++n) {
            const int jg = u.pn * 128 + wc * 32 + 8 * fq + 4 * n;
            const f32x4 g0 = *(const f32x4*)(conv_w + jg), g1 = *(const f32x4*)(conv_w + 5632 + jg), g2 = *(const f32x4*)(conv_w + 2 * 5632 + jg), gb = *(const f32x4*)(conv_b + jg);
            const f32x4 v0 = *(const f32x4*)(conv_w + 2816 + jg), v1 = *(const f32x4*)(conv_w + 5632 + 2816 + jg), v2 = *(const f32x4*)(conv_w + 2 * 5632 + 2816 + jg), vb = *(const f32x4*)(conv_b + 2816 + jg);
#pragma unroll
            for (int ai = 0; ai < 2; ++ai) { const int seg = 2 * ai + wr;
                f32x4 pg = (f32x4){0.f, 0.f, 0.f, 0.f}, pv = (f32x4){0.f, 0.f, 0.f, 0.f};
                if (seg > 0 && fr >= 14) { const PG8_LAS float* hp = halo + ((seg - 1) * 2 + (fr - 14)) * 256 + wc * 32 + 8 * fq + 4 * n; pg = *(const PG8_LAS f32x4*)hp; pv = *(const PG8_LAS f32x4*)(hp + 128); }
#pragma unroll
                for (int m = 0; m < 4; ++m) { const f32x4 xg = acc[ai][0][m][n], xv = acc[ai][1][m][n]; float o[4];
#pragma unroll
                    for (int c = 0; c < 4; ++c) {
                        const float zg1 = fr == 15 ? pg[c] : xg[c], zg2 = fr >= 14 ? pg[c] : xg[c], zv1 = fr == 15 ? pv[c] : xv[c], zv2 = fr >= 14 ? pv[c] : xv[c];
                        const float xg1 = __shfl(zg1, src1), xg2 = __shfl(zg2, src2), xv1 = __shfl(zv1, src1), xv2 = __shfl(zv2, src2);
                        const float gate = g0[c] * xg[c] + g1[c] * xg1 + g2[c] * xg2 + gb[c];
                        const float val = v0[c] * xv[c] + v1[c] * xv1 + v2[c] * xv2 + vb[c];
                        o[c] = gate * __builtin_amdgcn_rcpf(1.0f + __expf(-gate)) * val; }
                    res[ai][m][n].x = cvt_pk_bf16(o[0], o[1]); res[ai][m][n].y = cvt_pk_bf16(o[2], o[3]);
                    pg = xg; pv = xv; } }
        }
#pragma unroll
        for (int ai = 0; ai < 2; ++ai)
#pragma unroll
            for (int m = 0; m < 4; ++m) { const int r = ai * HALF + wr * 64 + m * 16 + fr, t = 254 * ti + r - 2;
                if (r >= 2 && t < 8192) { u32x4 w; w.x = res[ai][m][0].x; w.y = res[ai][m][0].y; w.z = res[ai][m][1].x; w.w = res[ai][m][1].y;
                    *(u32x4*)(act + (size_t)(b * 8192 + t) * 2816 + u.pn * 128 + wc * 32 + 8 * fq) = w; } }
    }
};

template <class Epi, class Sched, bool ALIGN_EPI = false, bool SP2 = false>
__device__ __forceinline__ void gemm_phase(PG8_LAS unsigned char* lds, const Gemm g, const Sched& S, const Epi& E) {
    const int tid = threadIdx.x, wid = __builtin_amdgcn_readfirstlane(tid >> 6), lane = tid & 63, wr = wid >> 2, wc = wid & 3, fr = lane & 15, fq = lane >> 4;
    const int K = g.K, nt = K / BK;
    unsigned voffA[2], voffB[2];
#pragma unroll
    for (int i = 0; i < 2; ++i) { int R, C; stage_rc(tid * 16 + i * 8192, R, C); const int Rb = Epi::PERM ? ((R & ~31) + perm32(R & 31)) : R;
        voffA[i] = (unsigned)(R * K + C) * 2u; voffB[i] = (unsigned)(Rb * K + C) * 2u; }
    const size_t kstep = (size_t)(BK * 2);
    const size_t hstep = (size_t)HALF * K * 2;
    const size_t tstep = 2 * hstep;
    const unsigned ldsw = (unsigned)wid * 1024u;
    const int aoff = lds_byte(wr * 64 + fr, fq * 8), boff = lds_byte(wc * 32 + fr, fq * 8);
#define PG8_SA(b, h) (((b) * 2 + (h)) * HTB)
#define PG8_SB(b, h) ((4 + (b) * 2 + (h)) * HTB)
#define PG8_STAGE(bufoff, gbase, voff) do { _Pragma("unroll") for (int _i = 0; _i < 2; ++_i) \
        __builtin_amdgcn_global_load_lds((const unsigned*)((const char*)(gbase) + (voff)[_i]), (PG8_LAS unsigned*)(lds + (bufoff) + ldsw + _i * 8192), 16, 0, 0); } while (0)
#define PG8_LDA(dst, b, h) do { _Pragma("unroll") for (int m = 0; m < 4; ++m) _Pragma("unroll") for (int k = 0; k < 2; ++k) dst[m][k] = *(const PG8_LAS bf16x8*)(lds + PG8_SA(b, h) + aoff + m * 2048 + k * 1024); } while (0)
#define PG8_LDB(dst, b, h) do { _Pragma("unroll") for (int n = 0; n < 2; ++n) _Pragma("unroll") for (int k = 0; k < 2; ++k) dst[n][k] = *(const PG8_LAS bf16x8*)(lds + PG8_SB(b, h) + boff + n * 2048 + k * 1024); } while (0)
#define PG8_MMA(ai, bj, At, Bt) do { __builtin_amdgcn_s_setprio(1); _Pragma("unroll") for (int m = 0; m < 4; ++m) _Pragma("unroll") for (int n = 0; n < 2; ++n) _Pragma("unroll") for (int k = 0; k < 2; ++k) \
        acc[ai][bj][m][n] = __builtin_amdgcn_mfma_f32_16x16x32_bf16(Bt[n][k], At[m][k], acc[ai][bj][m][n], 0, 0, 0); __builtin_amdgcn_s_setprio(0); } while (0)
#define PG8_WAIT_V(n) asm volatile("s_waitcnt vmcnt(" #n ")" ::: "memory")
#define PG8_WAIT_L(n) asm volatile("s_waitcnt lgkmcnt(" #n ")" ::: "memory")
#define PG8_BAR __builtin_amdgcn_s_barrier()
#define PG8_SCHED __builtin_amdgcn_sched_barrier(0)
    Unit cur, nxt; int ui = 0;
    if (!S.next(0, cur)) return;
    f32x4 acc[2][2][4][2];
#pragma unroll
    for (int a = 0; a < 2; ++a)
#pragma unroll
        for (int b = 0; b < 2; ++b)
#pragma unroll
            for (int m = 0; m < 4; ++m)
#pragma unroll
                for (int n = 0; n < 2; ++n) acc[a][b][m][n] = (f32x4){0.f, 0.f, 0.f, 0.f};
    bf16x8 At[4][2], B0[2][2], B1[2][2];
    const size_t rowb = (size_t)K * 2; const char* cA = (const char*)g.A + (size_t)S.a_row0(cur) * rowb; const char* cB = (const char*)g.Bt + (size_t)cur.pn * tstep;
    S.a_ready(cur);
    if constexpr (SP2) {
        PG8_STAGE(PG8_SB(0, 0), cB, voffB); PG8_STAGE(PG8_SB(0, 1), cB + hstep, voffB); PG8_STAGE(PG8_SA(0, 0), cA, voffA); PG8_STAGE(PG8_SA(0, 1), cA + hstep, voffA);
        if (wr == 1) PG8_BAR;
        PG8_WAIT_V(2); PG8_BAR;
        PG8_STAGE(PG8_SB(1, 0), cB + kstep, voffB); PG8_STAGE(PG8_SA(1, 0), cA + kstep, voffA); PG8_STAGE(PG8_SB(1, 1), cB + hstep + kstep, voffB);
        PG8_WAIT_V(6); PG8_BAR;
    } else {
        PG8_STAGE(PG8_SB(0, 0), cB, voffB); PG8_STAGE(PG8_SA(0, 0), cA, voffA); PG8_STAGE(PG8_SB(0, 1), cB + hstep, voffB); PG8_STAGE(PG8_SA(0, 1), cA + hstep, voffA);
        if (wr == 1) PG8_BAR;
        PG8_WAIT_V(4); PG8_BAR;
        PG8_STAGE(PG8_SB(1, 0), cB + kstep, voffB); PG8_STAGE(PG8_SA(1, 0), cA + kstep, voffA); PG8_STAGE(PG8_SB(1, 1), cB + hstep + kstep, voffB);
        PG8_WAIT_V(6); PG8_BAR;
    }
    for (;;) {
        const bool has_next = S.next(ui + 1, nxt);
        const char* nA = has_next ? (const char*)g.A + (size_t)S.a_row0(nxt) * rowb : cA; const char* nB = has_next ? (const char*)g.Bt + (size_t)nxt.pn * tstep : cB;
        for (int t = 0; t < nt; t += 2) {
            const bool last = (t == nt - 2);
            const char* a1 = cA + (size_t)(t + 1) * kstep;
            const char* a2 = last ? nA : cA + (size_t)(t + 2) * kstep; const char* b2 = last ? nB : cB + (size_t)(t + 2) * kstep;
            const char* a3 = a2 + kstep; const char* b3 = b2 + kstep;
            if (last && has_next) S.a_ready(nxt);
            if constexpr (SP2) {
            PG8_LDB(B0, 0, 0); PG8_LDB(B1, 0, 1); PG8_SCHED; PG8_LDA(At, 0, 0); PG8_STAGE(PG8_SA(1, 1), a1 + hstep, voffA);
            PG8_WAIT_V(8); PG8_WAIT_L(0); PG8_BAR; PG8_MMA(0, 0, At, B0); PG8_MMA(0, 1, At, B1); PG8_BAR; PG8_SCHED;
            PG8_LDA(At, 0, 1); PG8_STAGE(PG8_SB(0, 0), b2, voffB); PG8_STAGE(PG8_SB(0, 1), b2 + hstep, voffB); PG8_STAGE(PG8_SA(0, 0), a2, voffA);
            PG8_WAIT_V(8); PG8_WAIT_L(0); PG8_BAR; PG8_MMA(1, 0, At, B0); PG8_MMA(1, 1, At, B1); PG8_BAR; PG8_SCHED;
            PG8_LDB(B0, 1, 0); PG8_LDB(B1, 1, 1); PG8_SCHED; PG8_LDA(At, 1, 0); PG8_STAGE(PG8_SA(0, 1), a2 + hstep, voffA);
            PG8_WAIT_V(8); PG8_WAIT_L(0); PG8_BAR; PG8_MMA(0, 0, At, B0); PG8_MMA(0, 1, At, B1); PG8_BAR; PG8_SCHED;
            PG8_LDA(At, 1, 1); PG8_STAGE(PG8_SB(1, 0), b3, voffB); PG8_STAGE(PG8_SB(1, 1), b3 + hstep, voffB); PG8_STAGE(PG8_SA(1, 0), a3, voffA);
            PG8_WAIT_V(8); PG8_WAIT_L(0); PG8_BAR; PG8_MMA(1, 0, At, B0); PG8_MMA(1, 1, At, B1); PG8_BAR; PG8_SCHED;
            } else {
            PG8_LDB(B0, 0, 0); PG8_SCHED; PG8_LDA(At, 0, 0); PG8_STAGE(PG8_SA(1, 1), a1 + hstep, voffA);
            PG8_WAIT_L(8); PG8_BAR; PG8_WAIT_L(0); PG8_MMA(0, 0, At, B0); PG8_BAR; PG8_SCHED;
            PG8_LDB(B1, 0, 1); PG8_STAGE(PG8_SB(0, 0), b2, voffB);
            PG8_BAR; PG8_WAIT_L(0); PG8_MMA(0, 1, At, B1); PG8_BAR;
            PG8_LDA(At, 0, 1); PG8_STAGE(PG8_SA(0, 0), a2, voffA);
            PG8_BAR; PG8_WAIT_L(0); PG8_MMA(1, 0, At, B0); PG8_BAR; PG8_SCHED;
            PG8_STAGE(PG8_SB(0, 1), b2 + hstep, voffB);
            PG8_WAIT_V(6); PG8_BAR; PG8_MMA(1, 1, At, B1); PG8_BAR;
            PG8_LDB(B0, 1, 0); PG8_SCHED; PG8_LDA(At, 1, 0); PG8_STAGE(PG8_SA(0, 1), a2 + hstep, voffA);
            PG8_WAIT_L(8); PG8_BAR; PG8_WAIT_L(0); PG8_MMA(0, 0, At, B0); PG8_BAR; PG8_SCHED;
            PG8_LDB(B1, 1, 1); PG8_STAGE(PG8_SB(1, 0), b3, voffB);
            PG8_BAR; PG8_WAIT_L(0); PG8_MMA(0, 1, At, B1); PG8_BAR;
            PG8_LDA(At, 1, 1); PG8_STAGE(PG8_SA(1, 0), a3, voffA);
            PG8_BAR; PG8_WAIT_L(0); PG8_MMA(1, 0, At, B0); PG8_BAR; PG8_SCHED;
            PG8_STAGE(PG8_SB(1, 1), b3 + hstep, voffB);
            PG8_WAIT_V(6); PG8_BAR; PG8_MMA(1, 1, At, B1); PG8_BAR;
            }
        }
        if constexpr (ALIGN_EPI) { if (wr == 0) PG8_BAR; }
        if constexpr (!Epi::AFTER_DRAIN) { E(acc, cur, wr, wc, fr, fq); S.done(cur); }
        if (!has_next) break;
#pragma unroll
        for (int a = 0; a < 2; ++a)
#pragma unroll
            for (int b = 0; b < 2; ++b)
#pragma unroll
                for (int m = 0; m < 4; ++m)
#pragma unroll
                    for (int n = 0; n < 2; ++n) acc[a][b][m][n] = (f32x4){0.f, 0.f, 0.f, 0.f};
        cur = nxt; cA = nA; cB = nB; ++ui;
        if constexpr (ALIGN_EPI) { if (wr == 1) PG8_BAR; }
    }
    PG8_WAIT_V(0);
    if constexpr (!ALIGN_EPI) { if (wr == 0) PG8_BAR; }
    PG8_BAR;
    if constexpr (Epi::AFTER_DRAIN) { E.fused(acc, cur, wr, wc, fr, fq, lds, wid, lane); S.done(cur); }
#undef PG8_SA
#undef PG8_SB
#undef PG8_STAGE
#undef PG8_LDA
#undef PG8_LDB
#undef PG8_MMA
#undef PG8_WAIT_V
#undef PG8_WAIT_L
#undef PG8_BAR
#undef PG8_SCHED
}
}
#define GAS __attribute__((address_space(1)))
#define LAS __attribute__((address_space(3)))
typedef unsigned short bf16;
typedef unsigned v4u __attribute__((ext_vector_type(4)));
typedef float f32x4 __attribute__((ext_vector_type(4)));
typedef short bf16x8 __attribute__((ext_vector_type(8)));
typedef GAS unsigned gu32;
typedef GAS unsigned long long gu64;
#define RLX_AGENT __ATOMIC_RELAXED, __HIP_MEMORY_SCOPE_AGENT
#define LDS_WAIT() asm volatile("s_waitcnt lgkmcnt(0)" ::: "memory")
#define VM_WAIT() asm volatile("s_waitcnt vmcnt(0)" ::: "memory")
__device__ __forceinline__ unsigned long long rt() { return __builtin_amdgcn_s_memrealtime(); }
__device__ __forceinline__ unsigned f2bf(float f) { unsigned u = __builtin_bit_cast(unsigned, f); return (u + 0x7fffu + ((u >> 16) & 1u)) >> 16; }
__device__ __forceinline__ unsigned pk2(float lo, float hi) { return f2bf(lo) | (f2bf(hi) << 16); }

#define XB_TMO      128
#define XB_XCNT(j)  (256  + 64 * (j))
#define XB_XSUB(j)  (1280 + 64 * (j))
#define XB_XGEN(j)  (2304 + 64 * (j))
#define XB_TOP      3328
#define XB_TOPGEN   3392
#define XCD_BAR_WORDS 3456
#define XB_SPIN_CAP (1u << 18)

__device__ __forceinline__ unsigned xb_ld(unsigned* p)              { return __hip_atomic_load(p, __ATOMIC_RELAXED, __HIP_MEMORY_SCOPE_AGENT); }
__device__ __forceinline__ unsigned xb_add(unsigned* p, unsigned v) { return __hip_atomic_fetch_add(p, v, __ATOMIC_RELAXED, __HIP_MEMORY_SCOPE_AGENT); }
__device__ __forceinline__ unsigned xb_xcc_id() { return (unsigned)__builtin_amdgcn_s_getreg((3 << 11) | 20) & 0xFu; }
#define XB_SPIN(cond, bar) do { unsigned _sp = 0; while (cond) { __builtin_amdgcn_s_sleep(1); \
    if ((++_sp & 255u) == 0u) { if (xb_ld(&(bar)[XB_TMO])) break; if (_sp > XB_SPIN_CAP) { atomicAdd(&(bar)[XB_TMO], 1u); break; } } } } while (0)

struct XcdBarrier {
    unsigned* bar; unsigned x;
    volatile LAS unsigned* st;
};

__device__ __forceinline__ XcdBarrier xcd_barrier_post(unsigned* bar, volatile LAS unsigned* st) {
    XcdBarrier b; b.bar = bar; b.x = xb_xcc_id(); b.st = st;
    if (threadIdx.x == 0) (void)xb_add(&bar[XB_XCNT(b.x)], 1u);
    return b;
}
__device__ __forceinline__ void xcd_barrier_complete(unsigned* bar, unsigned x, unsigned& nloc, unsigned& nx) {
    const unsigned G = gridDim.x * gridDim.y * gridDim.z;
    unsigned sum, cnt, mine, sp = 0u;
    for (;;) {
        sum = 0u; cnt = 0u; mine = 0u;
#pragma unroll
        for (unsigned j = 0; j < 16; ++j) { const unsigned c = xb_ld(&bar[XB_XCNT(j)]); sum += c; cnt += (c > 0u) ? 1u : 0u; mine = (j == x) ? c : mine; }
        if (sum == G) break;
        __builtin_amdgcn_s_sleep(1);
        if ((++sp & 255u) == 0u) { if (xb_ld(&bar[XB_TMO])) break; if (sp > XB_SPIN_CAP) { atomicAdd(&bar[XB_TMO], 1u); break; } }
    }
    nloc = mine > 0u ? mine : 1u; nx = cnt > 0u ? cnt : 1u;
}

__device__ __forceinline__ void xcd_barrier(const XcdBarrier& b) {
    asm volatile("s_waitcnt vmcnt(0)" ::: "memory");
    __syncthreads();
    if (threadIdx.x == 0) {
        unsigned* bar = b.bar;
        __builtin_amdgcn_s_waitcnt(0);
        unsigned nloc = b.st[0], nx = b.st[1];
        if (nloc == 0u) { xcd_barrier_complete(bar, b.x, nloc, nx); b.st[0] = nloc; b.st[1] = nx; }
        const unsigned old = xb_add(&bar[XB_XSUB(b.x)], 1u);
        const unsigned gen = old / nloc;
        if (old + 1u == (gen + 1u) * nloc) {
            __builtin_amdgcn_fence(__ATOMIC_RELEASE, "agent");
            asm volatile("s_waitcnt vmcnt(0)" ::: "memory");
            const unsigned og = xb_add(&bar[XB_TOP], 1u);
            const unsigned tg = og / nx;
            if (og + 1u == (tg + 1u) * nx) xb_add(&bar[XB_TOPGEN], 1u);
            else XB_SPIN(xb_ld(&bar[XB_TOPGEN]) == tg, bar);
            __builtin_amdgcn_fence(__ATOMIC_ACQUIRE, "agent");
            xb_add(&bar[XB_XGEN(b.x)], 1u);
            asm volatile("s_waitcnt vmcnt(0)" ::: "memory");
        } else {
            XB_SPIN(xb_ld(&bar[XB_XGEN(b.x)]) == gen, bar);
            __builtin_amdgcn_fence(__ATOMIC_ACQUIRE, "agent");
            asm volatile("s_waitcnt vmcnt(0)" ::: "memory");
        }
    }
    __syncthreads();
}
constexpr int NWAVES = 8;
constexpr int BATCH = 2, SEQ = 8192, NMETA = 16, LTOK = SEQ + NMETA  , DM = 1024, INDIM = 2560, RWKV_IN = 1792, RDIM = 512, DFF = 2816;
constexpr int MROWS = BATCH * LTOK  , MPAD = 16640  , MREAL = BATCH * SEQ;
constexpr int QOFF = RWKV_IN, KOFF = RWKV_IN + 512, VOFF = RWKV_IN + 512 + 128;
constexpr size_t MiB = 1u << 20;
constexpr size_t WS_CTL = 0, CTL_ZERO_BYTES = 64 * 1024;
constexpr size_t WS_WIN = 1 * MiB, WS_WOUT = 6 * MiB, WS_WUP = 8 * MiB, WS_WDN = 19 * MiB;
constexpr size_t WS_SSQP = 24 * MiB + 512 * 1024;
constexpr size_t WS_KN = 26 * MiB;
constexpr size_t WS_XN = 30 * MiB + 512 * 1024;
constexpr size_t WS_P = 63 * MiB;
constexpr size_t WS_YMIX = 144 * MiB + 512 * 1024;
constexpr size_t WS_H1B = 177 * MiB;
constexpr size_t WS_TAIL = 209 * MiB + 512 * 1024;
constexpr size_t WS_ACT = WS_XN;
constexpr size_t WS_END = 256 * MiB;
constexpr size_t PREPB = (size_t)MROWS * RDIM * 2;
static_assert(WS_WDN + (size_t)DM * DFF * 2 <= WS_SSQP && WS_SSQP + 16ull * MPAD * 4 <= WS_KN && WS_KN + (size_t)MROWS * 128 * 2 <= WS_XN, "ws map 1");
static_assert(WS_XN + (size_t)MPAD * DM * 2 <= WS_P && WS_XN + (size_t)MROWS * RDIM * 4 <= WS_P && WS_P + (size_t)MPAD * INDIM * 2 <= WS_YMIX && WS_YMIX + (size_t)MPAD * DM * 2 <= WS_H1B, "ws map 2");
static_assert(WS_H1B + (size_t)MPAD * DM * 2 <= WS_TAIL && WS_H1B + PREPB <= WS_TAIL && WS_TAIL + 2 * PREPB <= WS_END && WS_ACT + (size_t)MREAL * DFF * 2 <= WS_YMIX, "ws map 3");
static_assert(3 * PREPB <= (size_t)MREAL * DM * 4, "d_out holds RB, K2B, VB");
constexpr int CW_BAR = 4096;
constexpr int RING_OFF = 0, RING_BYTES = 131072, HALO_OFF = RING_BYTES  , LDSCTL_OFF = 147456  , MISC_OFF = LDSCTL_OFF + 320, LDS_BYTES = 148480;

__constant__ unsigned char c_bucket[128] = {0, 1, 2, 3, 4, 5, 6, 7, 8, 9, 10, 11, 12, 13, 14, 15, 16, 16, 16, 17, 17, 18, 18, 18, 19, 19, 19, 20, 20, 20, 20, 21, 21, 21, 21, 22, 22, 22, 22, 22, 23, 23, 23, 23, 23, 23, 24, 24, 24, 24, 24, 24, 25, 25, 25, 25, 25, 25, 25, 26, 26, 26, 26, 26, 26, 26, 26, 27, 27, 27, 27, 27, 27, 27, 27, 27, 27, 28, 28, 28, 28, 28, 28, 28, 28, 28, 28, 29, 29, 29, 29, 29, 29, 29, 29, 29, 29, 29, 29, 30, 30, 30, 30, 30, 30, 30, 30, 30, 30, 30, 30, 30, 30, 31, 31, 31, 31, 31, 31, 31, 31, 31, 31, 31, 31, 31, 31, 31};

struct Frame {
    LAS unsigned char* lds;
    volatile LAS unsigned* MISC;
    gu32* ctl;
    int tid, lane, wave, vcu, G;
    const float* in[25]; float* out; unsigned char* ws;
};
__device__ __forceinline__ float wave_sum(float v) {
#pragma unroll
    for (int o = 1; o < 64; o <<= 1) v += __shfl_xor(v, o);
    return v;
}
__device__ __forceinline__ float bf2f(bf16 u) { return __uint_as_float((unsigned)u << 16); }
__device__ __forceinline__ float bflo(unsigned u) { return __uint_as_float(u << 16); }
__device__ __forceinline__ float bfhi(unsigned u) { return __uint_as_float(u & 0xffff0000u); }
__device__ __forceinline__ float sigmoidf_(float x) { return 1.0f / (1.0f + __expf(-x)); }

enum { I_X = 0, I_META, I_RELB, I_N1W, I_WIN, I_MU, I_W0, I_WDEC, I_A0, I_AUP, I_GUP, I_KK, I_KA, I_RK, I_LNW, I_LNB, I_QNW, I_KNW, I_SINK, I_WOUT, I_N2W, I_WUP, I_CONVW, I_CONVB, I_WDN };

typedef float f32x16 __attribute__((ext_vector_type(16)));
struct Op2 { bf16x8 s[2]; };
__device__ __forceinline__ f32x16 mfma32(bf16x8 a, bf16x8 b, f32x16 c) { return __builtin_amdgcn_mfma_f32_32x32x16_bf16(a, b, c, 0, 0, 0); }
__device__ __forceinline__ f32x16 zero16() { f32x16 z; for (int i = 0; i < 16; ++i) z[i] = 0.f; return z; }
typedef float f32x2_t __attribute__((ext_vector_type(2)));
typedef __bf16 bf16x2_t __attribute__((ext_vector_type(2)));
__device__ __forceinline__ unsigned cvtpk(float lo, float hi) { f32x2_t v = {lo, hi}; bf16x2_t b = __builtin_convertvector(v, bf16x2_t); return __builtin_bit_cast(unsigned, b); }
__device__ __forceinline__ bf16x8 pack8(float a0, float a1, float a2, float a3, float a4, float a5, float a6, float a7) {
    v4u u; u.x = cvtpk(a0, a1); u.y = cvtpk(a2, a3); u.z = cvtpk(a4, a5); u.w = cvtpk(a6, a7); return __builtin_bit_cast(bf16x8, u); }
__device__ __forceinline__ Op2 tile2op(const f32x16& t) { Op2 o; o.s[0] = pack8(t[0], t[1], t[2], t[3], t[4], t[5], t[6], t[7]); o.s[1] = pack8(t[8], t[9], t[10], t[11], t[12], t[13], t[14], t[15]); return o; }
__device__ __forceinline__ int opaque(int x) { asm volatile("" : "+v"(x)); return x; }
__device__ __forceinline__ int trow(int q, int hf) { return 8 * (q >> 2) + 4 * hf + (q & 3); }
__device__ __forceinline__ bf16x8 const_op(int kind, int s, int n, int hf) {
    v4u u; unsigned w[4];
#pragma unroll
    for (int p = 0; p < 4; ++p) { const int j0 = 2 * p, j1 = 2 * p + 1; const int r0 = 16 * s + 8 * (j0 >> 2) + 4 * hf + (j0 & 3), r1 = 16 * s + 8 * (j1 >> 2) + 4 * hf + (j1 & 3);
        const bool b0 = kind == 0 ? true : (kind == 1 ? r0 <= n : (kind == 2 ? r0 < n : r0 == n)), b1 = kind == 0 ? true : (kind == 1 ? r1 <= n : (kind == 2 ? r1 < n : r1 == n));
        w[p] = (b0 ? 0x3F80u : 0u) | (b1 ? 0x3F800000u : 0u); }
    u.x = w[0]; u.y = w[1]; u.z = w[2]; u.w = w[3]; return __builtin_bit_cast(bf16x8, u); }
__device__ __forceinline__ bf16x8 tri_op(int diag, int strict, int s, int n, int hf) {
    unsigned w[4];
#pragma unroll
    for (int p = 0; p < 4; ++p) { const int j0 = 2 * p, j1 = 2 * p + 1; const int r0 = 16 * s + 8 * (j0 >> 2) + 4 * hf + (j0 & 3) + strict, r1 = 16 * s + 8 * (j1 >> 2) + 4 * hf + (j1 & 3) + strict;
        const bool b0 = diag ? (r0 <= n) : true, b1 = diag ? (r1 <= n) : true; w[p] = (b0 ? 0x3F80u : 0u) | (b1 ? 0x3F800000u : 0u); }
    v4u u; u.x = w[0]; u.y = w[1]; u.z = w[2]; u.w = w[3]; return __builtin_bit_cast(bf16x8, u); }
__device__ __forceinline__ f32x4 ld_xs4(const bf16* prow, bool hasprev, int col, const float* mu) {
    const uint2 c = *(const uint2*)(prow + col); uint2 p; p.x = 0u; p.y = 0u; if (hasprev) p = *(const uint2*)(prow - INDIM + col);
    const f32x4 m = *(const f32x4*)(mu + col);
    const f32x4 cv = (f32x4){bflo(c.x), bfhi(c.x), bflo(c.y), bfhi(c.y)}, pv = (f32x4){bflo(p.x), bfhi(p.x), bflo(p.y), bfhi(p.y)};
    return cv + (pv - cv) * m; }
constexpr int NCHUNK = 129, NJOBS = BATCH * NCHUNK * 8;
constexpr size_t WS_IMG = 256 * 1024;
constexpr size_t IMG_DEC = 0, IMG_AUP = 65536, IMG_GUP = 131072;
constexpr size_t JOB16 = (size_t)NJOBS * 16384, JOB8 = (size_t)NJOBS * 8192;
static_assert(JOB16 + JOB8 + 2048ull * 6144 <= (size_t)MREAL * DM * 4 && 2 * JOB8 + (size_t)MROWS * 32 + 2048ull * 6144 <= WS_END - WS_TAIL && JOB16 <= WS_TAIL - WS_H1B && 2 * JOB8 + (size_t)MROWS * 8 * 4 <= WS_END - WS_TAIL, "chunk buffers");
__device__ __forceinline__ float* buf_YL(Frame& F) { return (float*)F.out; }
__device__ __forceinline__ bf16* buf_QC(Frame& F) { return (bf16*)((unsigned char*)F.out + JOB16); }
__device__ __forceinline__ float* buf_NC(Frame& F) { return (float*)(F.ws + WS_H1B); }
__device__ __forceinline__ bf16* buf_MC(Frame& F) { return (bf16*)(F.ws + WS_TAIL); }
__device__ __forceinline__ bf16* buf_SC(Frame& F) { return (bf16*)(F.ws + WS_TAIL + JOB8); }
__device__ __forceinline__ float* buf_BON(Frame& F) { return (float*)(F.ws + WS_TAIL + 2 * JOB8); }

__device__ __forceinline__ void build_lora_img(const float* W, int nI, bf16x8* img, int e) {
    const int lane = e & 63, s = (e >> 6) & 1, B = (e >> 7) & 1, I = (e >> 8) % nI, h = (e >> 8) / nI, n = lane & 31, hf = lane >> 5;
    float v[8];
#pragma unroll
    for (int jj = 0; jj < 8; ++jj) { const int m = 32 * I + 16 * s + 8 * (jj >> 2) + 4 * hf + (jj & 3); v[jj] = W[(size_t)m * RDIM + 64 * h + 32 * B + n]; }
    img[e] = pack8(v[0], v[1], v[2], v[3], v[4], v[5], v[6], v[7]);
}

#define PARK_ST(slot, v) (*(LAS bf16x8*)(park + (slot) * 1024 + lane * 16) = (v))
#define PARK_LD(slot) (*(const LAS bf16x8*)(park + (slot) * 1024 + lane * 16))
#define GS_ST(slot, v) (*(bf16x8*)(gscr + (slot) * 1024 + lane * 16) = (v))
#define GS_LD(slot) (*(const bf16x8*)(gscr + (slot) * 1024 + lane * 16))
#define GS2_ST(slot, v) (*(bf16x8*)(gscr2 + (slot) * 1024 + lane * 16) = (v))
#define GS2_LD(slot) (*(const bf16x8*)(gscr2 + (slot) * 1024 + lane * 16))
#define GS3_ST(slot, v) (*(bf16x8*)(gscr3 + (slot) * 1024 + lane * 16) = (v))
#define GS3_LD(slot) (*(const bf16x8*)(gscr3 + (slot) * 1024 + lane * 16))
#define GS4_ST(slot, v) (*(bf16x8*)(gscr4 + (slot) * 1024 + lane * 16) = (v))
#define GS4_LD(slot) (*(const bf16x8*)(gscr4 + (slot) * 1024 + lane * 16))
#define FENCE() do { asm volatile("" ::: "memory"); __builtin_amdgcn_sched_barrier(0); } while (0)
__device__ __forceinline__ void rwkv_chunk_local(Frame& F, int job, LAS unsigned char* park, unsigned char* gscr, unsigned char* gscr2, unsigned char* gscr3, unsigned char* gscr4) {
    int lane_ = (int)__builtin_amdgcn_mbcnt_hi(~0u, __builtin_amdgcn_mbcnt_lo(~0u, 0u)); asm volatile("" : "+v"(lane_));
    const int lane = lane_, n = lane & 31, hf = lane >> 5;
    const int h = job & 7, bc = job >> 3, c = bc % NCHUNK, b = bc / NCHUNK;
    const int pos0 = 64 * c, nvalid = (LTOK - pos0) < 64 ? (LTOK - pos0) : 64;
    const bf16* P = (const bf16*)(F.ws + WS_P) + (size_t)(b * LTOK + pos0) * INDIM;
    const float* mu = F.in[I_MU];
    const bf16x8* imgD = (const bf16x8*)(F.ws + WS_IMG + IMG_DEC) + (size_t)h * 512; const bf16x8* imgA = (const bf16x8*)(F.ws + WS_IMG + IMG_AUP) + (size_t)h * 512;
    const int hc = 64 * h;
    constexpr int SL_AK[3] = {8, 0, 6}, SL_RB[3] = {10, 2, 14}, SL_RK[3] = {12, 4, 16};
    float lamC[2];
    {
        Op2 TW[2][2];
#pragma unroll
        for (int J = 0; J < 2; ++J) { const int t = 32 * J + n; const bool live = t < nvalid; const bf16* prow = P + (size_t)(live ? t : nvalid - 1) * INDIM; const bool hp = (pos0 + t) > 0;
#pragma unroll
            for (int I = 0; I < 2; ++I)
#pragma unroll
                for (int s = 0; s < 2; ++s) { const int c0 = 1536 + 32 * I + 16 * s + 4 * hf; f32x4 x0 = ld_xs4(prow, hp, c0, mu), x1 = ld_xs4(prow, hp, c0 + 8, mu);
                    if (!live) { x0 = (f32x4){0.f, 0.f, 0.f, 0.f}; x1 = x0; }
                    TW[I][J].s[s] = pack8(tanhf(x0[0]), tanhf(x0[1]), tanhf(x0[2]), tanhf(x0[3]), tanhf(x1[0]), tanhf(x1[1]), tanhf(x1[2]), tanhf(x1[3])); FENCE(); } }
#pragma unroll
        for (int B = 0; B < 2; ++B) { lamC[B] = 0.f; const float w0 = F.in[I_W0][hc + 32 * B + n];
#pragma unroll
            for (int A = 0; A < 2; ++A) { f32x16 acc = zero16();
#pragma unroll
                for (int I = 0; I < 2; ++I)
#pragma unroll
                    for (int s = 0; s < 2; ++s) acc = mfma32(TW[I][A].s[s], imgD[((I * 2 + B) * 2 + s) * 64 + lane], acc);
#pragma unroll
                for (int q = 0; q < 16; ++q) { const int t = 32 * A + trow(q, hf); const float e = t < nvalid ? 0.60653065971f * sigmoidf_(w0 + acc[q]) : 0.f; acc[q] = e; lamC[B] += e; }
                const Op2 eo = tile2op(acc); PARK_ST((A * 2 + B) * 2, eo.s[0]); PARK_ST((A * 2 + B) * 2 + 1, eo.s[1]); FENCE(); }
            lamC[B] += __shfl_xor(lamC[B], 32); }
    }
    FENCE();
    bf16* QC = buf_QC(F) + (size_t)job * 4096; float* BON = buf_BON(F);
#pragma unroll 1
    for (int b2 = 0; b2 < 2; ++b2) {
        const int t = 32 * b2 + n; const bool live = t < nvalid; const bf16* prow = P + (size_t)(live ? t : nvalid - 1) * INDIM; const bool hp = (pos0 + t) > 0;
        Op2 ADT[2];
#pragma unroll
        for (int I = 0; I < 2; ++I)
#pragma unroll
            for (int s = 0; s < 2; ++s) { const int c0 = 1600 + 32 * I + 16 * s + 4 * hf; f32x4 x0 = ld_xs4(prow, hp, c0, mu), x1 = ld_xs4(prow, hp, c0 + 8, mu);
                if (!live) { x0 = (f32x4){0.f, 0.f, 0.f, 0.f}; x1 = x0; }
                ADT[I].s[s] = pack8(x0[0], x0[1], x0[2], x0[3], x1[0], x1[1], x1[2], x1[3]); }
        float ss = 0.f;
#pragma unroll
        for (int g8 = 0; g8 < 8; ++g8) { const int j0 = 8 * g8 + 4 * hf; const f32x4 k4 = ld_xs4(prow, hp, 512 + hc + j0, mu); const f32x4 kkw = *(const f32x4*)(F.in[I_KK] + hc + j0);
#pragma unroll
            for (int cc = 0; cc < 4; ++cc) { const float x = (live ? k4[cc] : 0.f) * kkw[cc]; ss += x * x; } }
        ss += __shfl_xor(ss, 32);
        const float inv = 1.0f / fmaxf(sqrtf(ss), 1e-12f);
        float bon = 0.f;
#pragma unroll 1
        for (int a = 0; a < 2; ++a) {
            f32x16 lam = zero16(), lamp = zero16(), alr = zero16();
#pragma unroll 1
            for (int I = 0; I <= b2; ++I) { const int kd = (I == b2) ? 1 : 0;
#pragma unroll
                for (int s = 0; s < 2; ++s) { const bf16x8 eo = PARK_LD((I * 2 + a) * 2 + s); lam = mfma32(eo, tri_op(kd, 0, s, n, hf), lam); lamp = mfma32(eo, tri_op(kd, 1, s, n, hf), lamp); } }
#pragma unroll
            for (int I = 0; I < 2; ++I)
#pragma unroll
                for (int s = 0; s < 2; ++s) alr = mfma32(imgA[((I * 2 + a) * 2 + s) * 64 + lane], ADT[I].s[s], alr);
#pragma unroll
            for (int s = 0; s < 2; ++s) { float at[8], bt[8], kt[8], rt[8];
#pragma unroll
                for (int g2 = 0; g2 < 2; ++g2) { const int g4 = 2 * s + g2, j0 = 32 * a + 8 * g4 + 4 * hf;
                    const f32x4 k4 = ld_xs4(prow, hp, 512 + hc + j0, mu), r4 = ld_xs4(prow, hp, hc + j0, mu);
                    const f32x4 kkw = *(const f32x4*)(F.in[I_KK] + hc + j0), a04 = *(const f32x4*)(F.in[I_A0] + hc + j0), ka4 = *(const f32x4*)(F.in[I_KA] + hc + j0), rk4 = *(const f32x4*)(F.in[I_RK] + hc + j0);
#pragma unroll
                    for (int cc = 0; cc < 4; ++cc) { const int q = 4 * g4 + cc, o = 4 * g2 + cc; const float k = live ? k4[cc] : 0.f, r = live ? r4[cc] : 0.f;
                        const float al = sigmoidf_(a04[cc] + alr[q]); const float kk = k * kkw[cc] * inv; const float k2 = k * (1.0f + (al - 1.0f) * ka4[cc]);
                        const float eL = __expf(lam[q]), emL = __expf(-lam[q]), emLp = __expf(-lamp[q]);
                        at[o] = -kk * emLp; bt[o] = kk * al * eL; kt[o] = k2 * eL; rt[o] = r * emL; bon += r * k2 * rk4[cc]; }
                    uint2 w; w.x = cvtpk(rt[4 * g2], rt[4 * g2 + 1]); w.y = cvtpk(rt[4 * g2 + 2], rt[4 * g2 + 3]); *(uint2*)(QC + t * 64 + j0) = w; }
                GS3_ST(a * 2 + s, pack8(at[0], at[1], at[2], at[3], at[4], at[5], at[6], at[7])); GS4_ST(a * 2 + s, pack8(rt[0], rt[1], rt[2], rt[3], rt[4], rt[5], rt[6], rt[7]));
                GS_ST((0 * 2 + b2) * 4 + a * 2 + s, pack8(bt[0], bt[1], bt[2], bt[3], bt[4], bt[5], bt[6], bt[7])); GS_ST((1 * 2 + b2) * 4 + a * 2 + s, pack8(kt[0], kt[1], kt[2], kt[3], kt[4], kt[5], kt[6], kt[7])); }
        }
        bon += __shfl_xor(bon, 32);
        if (live && hf == 0) BON[(size_t)(b * LTOK + pos0 + t) * 8 + h] = bon;
        FENCE();
#pragma unroll 1
        for (int A = 0; A <= b2; ++A) { const int ti = A + b2;
#pragma unroll 1
            for (int which = 0; which < 4; ++which) { f32x16 x = zero16(); const unsigned char* rp = (which & 2) ? gscr4 : gscr3;
#pragma unroll
                for (int I = 0; I < 2; ++I)
#pragma unroll
                    for (int s = 0; s < 2; ++s) x = mfma32(GS_LD(((which & 1) * 2 + A) * 4 + I * 2 + s), *(const bf16x8*)(rp + (I * 2 + s) * 1024 + lane * 16), x);
                const int incl = which >> 1;
#pragma unroll
                for (int q = 0; q < 16; ++q) { const int sidx = 32 * A + trow(q, hf), tidx = 32 * b2 + n; x[q] = (sidx < tidx + incl) ? x[q] : 0.f; }
                const Op2 o = tile2op(x);
                if (which == 0) { GS2_ST(8 + 2 * ti, o.s[0]); GS2_ST(8 + 2 * ti + 1, o.s[1]); }
                else { const int sl = (which == 1 ? (ti == 0 ? 8 : (ti == 1 ? 0 : 6)) : (which == 2 ? (ti == 0 ? 10 : (ti == 1 ? 2 : 14)) : (ti == 0 ? 12 : (ti == 1 ? 4 : 16)))); PARK_ST(sl, o.s[0]); PARK_ST(sl + 1, o.s[1]); } }
        }
        { f32x16 x = zero16();
#pragma unroll
            for (int I = 0; I < 2; ++I)
#pragma unroll
                for (int s = 0; s < 2; ++s) x = mfma32(GS3_LD(I * 2 + s), GS_LD((0 * 2 + b2) * 4 + I * 2 + s), x);
#pragma unroll
            for (int q = 0; q < 16; ++q) x[q] = (n < trow(q, hf)) ? x[q] : 0.f;
            const Op2 o = tile2op(x); unsigned char* dp = b2 ? gscr4 : gscr3; *(bf16x8*)(dp + 4 * 1024 + lane * 16) = o.s[0]; *(bf16x8*)(dp + 5 * 1024 + lane * 16) = o.s[1]; }
        { const bf16x8 id0 = const_op(3, 0, n, hf), id1 = const_op(3, 1, n, hf);
#pragma unroll
        for (int B = 0; B < 2; ++B) { f32x16 x = zero16(); x = mfma32(GS3_LD(B * 2), id0, x); x = mfma32(GS3_LD(B * 2 + 1), id1, x); const Op2 o = tile2op(x); GS2_ST((b2 * 2 + B) * 2, o.s[0]); GS2_ST((b2 * 2 + B) * 2 + 1, o.s[1]); } }
        FENCE();
    }
    { const bf16x8 id0 = const_op(3, 0, n, hf), id1 = const_op(3, 1, n, hf);
#pragma unroll 1
    for (int m = 0; m < 2; ++m)
#pragma unroll 1
        for (int B = 0; B < 2; ++B) { const float sc = __expf(-(B ? lamC[1] : lamC[0]));
#pragma unroll 1
            for (int A = 0; A < 2; ++A) { f32x16 y = zero16(); const int sl = (m * 2 + A) * 4 + B * 2;
                y = mfma32(GS_LD(sl), id0, y); y = mfma32(GS_LD(sl + 1), id1, y);
#pragma unroll
                for (int q = 0; q < 16; ++q) y[q] *= sc;
                const Op2 yo = tile2op(y); GS_ST(sl, yo.s[0]); GS_ST(sl + 1, yo.s[1]); } } }
    FENCE();
    Op2 TT[3];
    {
        Op2 T11;
#pragma unroll
        for (int d = 0; d < 2; ++d) {
            Op2 X, Xt; X.s[0] = d ? GS4_LD(4) : GS3_LD(4); X.s[1] = d ? GS4_LD(5) : GS3_LD(5); Xt.s[0] = GS2_LD(8 + 4 * d); Xt.s[1] = GS2_LD(8 + 4 * d + 1);
            f32x16 T, Tt;
            { const v4u x0 = __builtin_bit_cast(v4u, X.s[0]), x1 = __builtin_bit_cast(v4u, X.s[1]), y0 = __builtin_bit_cast(v4u, Xt.s[0]), y1 = __builtin_bit_cast(v4u, Xt.s[1]);
                T[0] = bflo(x0.x); T[1] = bfhi(x0.x); T[2] = bflo(x0.y); T[3] = bfhi(x0.y); T[4] = bflo(x0.z); T[5] = bfhi(x0.z); T[6] = bflo(x0.w); T[7] = bfhi(x0.w);
                T[8] = bflo(x1.x); T[9] = bfhi(x1.x); T[10] = bflo(x1.y); T[11] = bfhi(x1.y); T[12] = bflo(x1.z); T[13] = bfhi(x1.z); T[14] = bflo(x1.w); T[15] = bfhi(x1.w);
                Tt[0] = bflo(y0.x); Tt[1] = bfhi(y0.x); Tt[2] = bflo(y0.y); Tt[3] = bfhi(y0.y); Tt[4] = bflo(y0.z); Tt[5] = bfhi(y0.z); Tt[6] = bflo(y0.w); Tt[7] = bfhi(y0.w);
                Tt[8] = bflo(y1.x); Tt[9] = bfhi(y1.x); Tt[10] = bflo(y1.y); Tt[11] = bfhi(y1.y); Tt[12] = bflo(y1.z); Tt[13] = bfhi(y1.z); Tt[14] = bflo(y1.w); Tt[15] = bfhi(y1.w);
#pragma unroll
                for (int q = 0; q < 16; ++q) if (trow(q, hf) == n) { T[q] += 1.0f; Tt[q] += 1.0f; } }
#pragma unroll
            for (int it = 0; it < 4; ++it) {
                f32x16 X2 = zero16(), X2t = zero16();
                X2 = mfma32(Xt.s[0], X.s[0], X2); X2 = mfma32(Xt.s[1], X.s[1], X2);
                X2t = mfma32(X.s[0], Xt.s[0], X2t); X2t = mfma32(X.s[1], Xt.s[1], X2t);
                const Op2 X2o = tile2op(X2), X2to = tile2op(X2t), Tto = tile2op(Tt);
                T = mfma32(Tto.s[0], X2o.s[0], T); T = mfma32(Tto.s[1], X2o.s[1], T);
                Tt = mfma32(X2o.s[0], Tto.s[0], Tt); Tt = mfma32(X2o.s[1], Tto.s[1], Tt);
                X = X2o; Xt = X2to;
            }
            if (d == 0) { T11 = tile2op(T); TT[0] = tile2op(Tt); } else { TT[2] = tile2op(Tt); }
        }
        f32x16 Z = zero16(); Z = mfma32(GS2_LD(10), T11.s[0], Z); Z = mfma32(GS2_LD(11), T11.s[1], Z);
        const Op2 Zo = tile2op(Z); f32x16 T21t = zero16(); T21t = mfma32(Zo.s[0], TT[2].s[0], T21t); T21t = mfma32(Zo.s[1], TT[2].s[1], T21t);
        TT[1] = tile2op(T21t);
    }
    FENCE();
    Op2 VCL[2][2], UL[2][2], PC[2][2];
    {
        const int n_o = opaque(n), hf_o = opaque(hf); const bf16x8 id0 = const_op(3, 0, n_o, hf_o), id1 = const_op(3, 1, n_o, hf_o);
#pragma unroll
        for (int J = 0; J < 2; ++J) { const int t = 32 * J + n; const bool live = t < nvalid; const bf16* prow = P + (size_t)(live ? t : nvalid - 1) * INDIM; const bool hp = (pos0 + t) > 0;
#pragma unroll
            for (int I = 0; I < 2; ++I) { Op2 vt;
#pragma unroll
                for (int s = 0; s < 2; ++s) { const int c0 = 1024 + hc + 32 * I + 16 * s + 4 * hf; f32x4 x0 = ld_xs4(prow, hp, c0, mu), x1 = ld_xs4(prow, hp, c0 + 8, mu);
                    if (!live) { x0 = (f32x4){0.f, 0.f, 0.f, 0.f}; x1 = x0; }
                    vt.s[s] = pack8(x0[0], x0[1], x0[2], x0[3], x1[0], x1[1], x1[2], x1[3]); FENCE(); }
                f32x16 x = zero16(); x = mfma32(vt.s[0], id0, x); x = mfma32(vt.s[1], id1, x); VCL[J][I] = tile2op(x); } }
    }
    FENCE();
    {
        Op2 X1[2][2];
#pragma unroll
        for (int A = 0; A < 2; ++A)
#pragma unroll
            for (int B = 0; B < 2; ++B) { f32x16 x = zero16();
#pragma unroll
                for (int I = 0; I <= A; ++I) { const int sl = SL_AK[I + A];
#pragma unroll
                    for (int s = 0; s < 2; ++s) x = mfma32(PARK_LD(sl + s), VCL[I][B].s[s], x); }
                X1[A][B] = tile2op(x); }
#pragma unroll
        for (int A = 0; A < 2; ++A)
#pragma unroll
            for (int B = 0; B < 2; ++B) { f32x16 u = zero16(), p = zero16();
#pragma unroll
                for (int I = 0; I <= A; ++I) { const int ti = I + A;
#pragma unroll
                    for (int s = 0; s < 2; ++s) { u = mfma32(TT[ti].s[s], X1[I][B].s[s], u); p = mfma32(TT[ti].s[s], GS2_LD((I * 2 + B) * 2 + s), p); } }
                UL[A][B] = tile2op(u); PC[A][B] = tile2op(p); }
    }
    FENCE();
    float* YL = buf_YL(F) + (size_t)job * 4096; float* NC = buf_NC(F) + (size_t)job * 4096; bf16* MC = buf_MC(F) + (size_t)job * 4096;
#pragma unroll
    for (int B = 0; B < 2; ++B) { const int t = 32 * B + n;
#pragma unroll
        for (int A = 0; A < 2; ++A) {
            f32x16 qt, yt = zero16();
#pragma unroll
            for (int g4 = 0; g4 < 4; ++g4) { const uint2 w = *(const uint2*)(QC + t * 64 + 32 * A + 8 * g4 + 4 * hf); qt[4 * g4] = bflo(w.x); qt[4 * g4 + 1] = bfhi(w.x); qt[4 * g4 + 2] = bflo(w.y); qt[4 * g4 + 3] = bfhi(w.y); }
#pragma unroll
            for (int I = 0; I <= B; ++I) { const int ti = I + B;
#pragma unroll
                for (int s = 0; s < 2; ++s) { const bf16x8 rb = PARK_LD(SL_RB[ti] + s), rk = PARK_LD(SL_RK[ti] + s);
                    qt = mfma32(PC[I][A].s[s], rb, qt); yt = mfma32(UL[I][A].s[s], rb, yt); yt = mfma32(VCL[I][A].s[s], rk, yt); } }
#pragma unroll
            for (int g4 = 0; g4 < 4; ++g4) { uint2 w; w.x = cvtpk(qt[4 * g4], qt[4 * g4 + 1]); w.y = cvtpk(qt[4 * g4 + 2], qt[4 * g4 + 3]); *(uint2*)(QC + t * 64 + 32 * A + 8 * g4 + 4 * hf) = w;
                *(f32x4*)(YL + t * 64 + 32 * A + 8 * g4 + 4 * hf) = (f32x4){yt[4 * g4], yt[4 * g4 + 1], yt[4 * g4 + 2], yt[4 * g4 + 3]}; } } }
    FENCE();
#pragma unroll
    for (int B = 0; B < 2; ++B) { const float dg = __expf(-lamC[B]);
#pragma unroll
        for (int A = 0; A < 2; ++A) { f32x16 mt = zero16(), nn = zero16();
#pragma unroll
            for (int I = 0; I < 2; ++I)
#pragma unroll
                for (int s = 0; s < 2; ++s) { mt = mfma32(PC[I][A].s[s], GS_LD((0 * 2 + I) * 4 + B * 2 + s), mt); nn = mfma32(GS_LD((0 * 2 + I) * 4 + A * 2 + s), UL[I][B].s[s], nn); nn = mfma32(GS_LD((1 * 2 + I) * 4 + A * 2 + s), VCL[I][B].s[s], nn); }
            if (A == B) {
#pragma unroll
                for (int q = 0; q < 16; ++q) if (trow(q, hf) == n) mt[q] += dg; }
#pragma unroll
            for (int g4 = 0; g4 < 4; ++g4) { uint2 w; w.x = cvtpk(mt[4 * g4], mt[4 * g4 + 1]); w.y = cvtpk(mt[4 * g4 + 2], mt[4 * g4 + 3]);
                *(uint2*)(MC + (32 * B + n) * 64 + 32 * A + 8 * g4 + 4 * hf) = w;
                *(f32x4*)(NC + (32 * B + n) * 64 + 32 * A + 8 * g4 + 4 * hf) = (f32x4){nn[4 * g4], nn[4 * g4 + 1], nn[4 * g4 + 2], nn[4 * g4 + 3]}; }
            FENCE(); } }
}

__device__ __forceinline__ void rwkv_scan(Frame& F, int sj) {
    int lane_ = (int)__builtin_amdgcn_mbcnt_hi(~0u, __builtin_amdgcn_mbcnt_lo(~0u, 0u)); asm volatile("" : "+v"(lane_));
    const int lane = lane_, vv = lane & 15, g = lane >> 4, bh = sj >> 2, vg = sj & 3, b = bh >> 3, h = bh & 7, v = 16 * vg + vv;
    const bf16* MC = buf_MC(F); const float* NC = buf_NC(F); bf16* SC = buf_SC(F);
    f32x4 S[4];
#pragma unroll
    for (int r = 0; r < 4; ++r) S[r] = (f32x4){0.f, 0.f, 0.f, 0.f};
    uint2 mC[4][2][2]; f32x4 nC[4];
    {
        const size_t jo = (size_t)((b * NCHUNK) * 8 + h) * 4096;
#pragma unroll
        for (int r = 0; r < 4; ++r) { nC[r] = *(const f32x4*)(NC + jo + v * 64 + 16 * r + 4 * g);
#pragma unroll
            for (int kk = 0; kk < 2; ++kk) { mC[r][kk][0] = *(const uint2*)(MC + jo + (16 * r + vv) * 64 + 32 * kk + 4 * g); mC[r][kk][1] = *(const uint2*)(MC + jo + (16 * r + vv) * 64 + 32 * kk + 16 + 4 * g); } }
    }
#pragma unroll 1
    for (int c = 0; c < NCHUNK; ++c) {
        const size_t jo = (size_t)((b * NCHUNK + c) * 8 + h) * 4096;
        uint2 mN[4][2][2]; f32x4 nN[4];
        { const int c1 = (c + 1 < NCHUNK) ? c + 1 : c; const size_t jn = (size_t)((b * NCHUNK + c1) * 8 + h) * 4096;
#pragma unroll
            for (int r = 0; r < 4; ++r) { nN[r] = *(const f32x4*)(NC + jn + v * 64 + 16 * r + 4 * g);
#pragma unroll
                for (int kk = 0; kk < 2; ++kk) { mN[r][kk][0] = *(const uint2*)(MC + jn + (16 * r + vv) * 64 + 32 * kk + 4 * g); mN[r][kk][1] = *(const uint2*)(MC + jn + (16 * r + vv) * 64 + 32 * kk + 16 + 4 * g); } } }
        uint2 sb[4];
#pragma unroll
        for (int r = 0; r < 4; ++r) { sb[r].x = cvtpk(S[r][0], S[r][1]); sb[r].y = cvtpk(S[r][2], S[r][3]); *(uint2*)(SC + jo + v * 64 + 16 * r + 4 * g) = sb[r]; }
        bf16x8 Bop[2];
#pragma unroll
        for (int kk = 0; kk < 2; ++kk) { v4u u; u.x = sb[2 * kk].x; u.y = sb[2 * kk].y; u.z = sb[2 * kk + 1].x; u.w = sb[2 * kk + 1].y; Bop[kk] = __builtin_bit_cast(bf16x8, u); }
#pragma unroll
        for (int r = 0; r < 4; ++r) { f32x4 acc = nC[r];
#pragma unroll
            for (int kk = 0; kk < 2; ++kk) { v4u u; u.x = mC[r][kk][0].x; u.y = mC[r][kk][0].y; u.z = mC[r][kk][1].x; u.w = mC[r][kk][1].y;
                acc = __builtin_amdgcn_mfma_f32_16x16x32_bf16(__builtin_bit_cast(bf16x8, u), Bop[kk], acc, 0, 0, 0); }
            S[r] = acc; }
#pragma unroll
        for (int r = 0; r < 4; ++r) { nC[r] = nN[r];
#pragma unroll
            for (int kk = 0; kk < 2; ++kk) { mC[r][kk][0] = mN[r][kk][0]; mC[r][kk][1] = mN[r][kk][1]; } }
    }
}

__device__ __forceinline__ void rwkv_output(Frame& F, int job) {
    int lane_ = (int)__builtin_amdgcn_mbcnt_hi(~0u, __builtin_amdgcn_mbcnt_lo(~0u, 0u)); asm volatile("" : "+v"(lane_));
    const int lane = lane_, n = lane & 31, hf = lane >> 5;
    const int h = job & 7, bc = job >> 3, c = bc % NCHUNK, b = bc / NCHUNK, hc = 64 * h;
    const int pos0 = 64 * c, nvalid = (LTOK - pos0) < 64 ? (LTOK - pos0) : 64;
    const bf16* P = (const bf16*)(F.ws + WS_P) + (size_t)(b * LTOK + pos0) * INDIM; const float* mu = F.in[I_MU];
    const bf16* QC = buf_QC(F) + (size_t)job * 4096; const bf16* SC = buf_SC(F) + (size_t)job * 4096; const float* YL = buf_YL(F) + (size_t)job * 4096; const float* BON = buf_BON(F);
    const bf16x8* imgG = (const bf16x8*)(F.ws + WS_IMG + IMG_GUP) + (size_t)h * 1024;
    bf16* YMIX = (bf16*)(F.ws + WS_YMIX);
#pragma unroll 1
    for (int B = 0; B < 2; ++B) {
        const int t = 32 * B + n; const bool live = t < nvalid; const bf16* prow = P + (size_t)(live ? t : nvalid - 1) * INDIM; const bool hp = (pos0 + t) > 0;
        Op2 SG[4];
#pragma unroll
        for (int I = 0; I < 4; ++I)
#pragma unroll
            for (int s = 0; s < 2; ++s) { const int c0 = 1664 + 32 * I + 16 * s + 4 * hf; const f32x4 x0 = ld_xs4(prow, hp, c0, mu), x1 = ld_xs4(prow, hp, c0 + 8, mu);
                SG[I].s[s] = pack8(sigmoidf_(x0[0]), sigmoidf_(x0[1]), sigmoidf_(x0[2]), sigmoidf_(x0[3]), sigmoidf_(x1[0]), sigmoidf_(x1[1]), sigmoidf_(x1[2]), sigmoidf_(x1[3])); }
        bf16x8 qb[4];
#pragma unroll
        for (int ks = 0; ks < 4; ++ks) qb[ks] = *(const bf16x8*)(QC + t * 64 + 16 * ks + 8 * hf);
        f32x16 y[2], gt[2]; float sum = 0.f;
#pragma unroll
        for (int A = 0; A < 2; ++A) {
#pragma unroll
            for (int g4 = 0; g4 < 4; ++g4) { const f32x4 w = *(const f32x4*)(YL + t * 64 + 32 * A + 8 * g4 + 4 * hf); y[A][4 * g4] = w[0]; y[A][4 * g4 + 1] = w[1]; y[A][4 * g4 + 2] = w[2]; y[A][4 * g4 + 3] = w[3]; }
#pragma unroll
            for (int ks = 0; ks < 4; ++ks) y[A] = mfma32(*(const bf16x8*)(SC + (32 * A + n) * 64 + 16 * ks + 8 * hf), qb[ks], y[A]);
            gt[A] = zero16();
#pragma unroll
            for (int I = 0; I < 4; ++I)
#pragma unroll
                for (int s = 0; s < 2; ++s) gt[A] = mfma32(imgG[((I * 2 + A) * 2 + s) * 64 + lane], SG[I].s[s], gt[A]);
#pragma unroll
            for (int q = 0; q < 16; ++q) sum += y[A][q]; }
        sum += __shfl_xor(sum, 32); const float mean = sum * (1.0f / 64.0f); float sq = 0.f;
#pragma unroll
        for (int A = 0; A < 2; ++A)
#pragma unroll
            for (int q = 0; q < 16; ++q) { const float d = y[A][q] - mean; sq += d * d; }
        sq += __shfl_xor(sq, 32); const float rstd = 1.0f / sqrtf(sq * (1.0f / 64.0f) + 64e-5f);
        const float bon = BON[(size_t)(b * LTOK + pos0 + (live ? t : nvalid - 1)) * 8 + h];
#pragma unroll
        for (int A = 0; A < 2; ++A)
#pragma unroll
            for (int g4 = 0; g4 < 4; ++g4) { const int i0 = 32 * A + 8 * g4 + 4 * hf; const f32x4 v4 = ld_xs4(prow, hp, 1024 + hc + i0, mu);
                const f32x4 lw = *(const f32x4*)(F.in[I_LNW] + hc + i0), lb = *(const f32x4*)(F.in[I_LNB] + hc + i0); float o[4];
#pragma unroll
                for (int cc = 0; cc < 4; ++cc) { const int q = 4 * g4 + cc; o[cc] = ((y[A][q] - mean) * rstd * lw[cc] + lb[cc] + bon * v4[cc]) * gt[A][q]; }
                if (live) { uint2 w; w.x = cvtpk(o[0], o[1]); w.y = cvtpk(o[2], o[3]); *(uint2*)(YMIX + (size_t)(b * LTOK + pos0 + t) * DM + hc + i0) = w; } }
    }
}

__device__ __forceinline__ void p0_transpose_item(const float* W, int K, int N, bf16* WT, const float* ksc, int mode, LAS float* scr, int item, int lane) {
    const int nblk = N / 32, kb = item / nblk, nb = item % nblk, k0 = 64 * kb, n0 = 32 * nb;
#pragma unroll 8
    for (int i = 0; i < 32; ++i) { const int kk = 2 * i + (lane >> 5); float w = W[(size_t)(k0 + kk) * N + n0 + (lane & 31)]; if (ksc) w *= ksc[k0 + kk]; scr[kk * 33 + (lane & 31)] = w; }
    LDS_WAIT(); asm volatile("" ::: "memory");
    int d0 = n0;
    if (mode == 1) d0 = n0 < DFF ? (n0 / 128) * 256 + (n0 % 128) : ((n0 - DFF) / 128) * 256 + 128 + ((n0 - DFF) % 128);
    const int c = lane & 7;
#pragma unroll
    for (int j = 0; j < 4; ++j) { const int n = (lane >> 3) + 8 * j; const LAS float* s = scr + (8 * c) * 33 + n;
        v4u o; o.x = pk2(s[0 * 33], s[1 * 33]); o.y = pk2(s[2 * 33], s[3 * 33]); o.z = pk2(s[4 * 33], s[5 * 33]); o.w = pk2(s[6 * 33], s[7 * 33]);
        *(GAS v4u*)(WT + (size_t)(d0 + n) * K + k0 + 8 * c) = o; }
    LDS_WAIT(); asm volatile("" ::: "memory");
}
__device__ __forceinline__ void p0_prologue(Frame& F) {
    LAS float* scr = (LAS float*)(F.lds + RING_OFF + F.wave * 16384);
    const int gw = F.vcu * NWAVES + F.wave, NGW = F.G * NWAVES;
    constexpr int I_1 = (DM / 64) * (INDIM / 32), I_2 = (DM / 64) * (DM / 32), I_3 = (DM / 64) * (2 * DFF / 32), I_4 = (DFF / 64) * (DM / 32);
    constexpr int NITEMS = I_1 + I_2 + I_3 + I_4;
    for (int it = gw; it < NITEMS; it += NGW) {
        int r = it;
        if (r < I_1) { p0_transpose_item(F.in[I_WIN], DM, INDIM, (bf16*)(F.ws + WS_WIN), F.in[I_N1W], 0, scr, r, F.lane); continue; } r -= I_1;
        if (r < I_2) { p0_transpose_item(F.in[I_WOUT], DM, DM, (bf16*)(F.ws + WS_WOUT), nullptr, 0, scr, r, F.lane); continue; } r -= I_2;
        if (r < I_3) { p0_transpose_item(F.in[I_WUP], DM, 2 * DFF, (bf16*)(F.ws + WS_WUP), F.in[I_N2W], 1, scr, r, F.lane); continue; } r -= I_3;
        p0_transpose_item(F.in[I_WDN], DFF, DM, (bf16*)(F.ws + WS_WDN), nullptr, 0, scr, r, F.lane);
    }
    { bf16x8* imgD = (bf16x8*)(F.ws + WS_IMG + IMG_DEC); bf16x8* imgA = (bf16x8*)(F.ws + WS_IMG + IMG_AUP); bf16x8* imgG = (bf16x8*)(F.ws + WS_IMG + IMG_GUP);
      for (int e = (F.vcu * NWAVES + F.wave) * 64 + F.lane; e < 16384; e += F.G * NWAVES * 64) {
          if (e < 4096) build_lora_img(F.in[I_WDEC], 2, imgD, e); else if (e < 8192) build_lora_img(F.in[I_AUP], 2, imgA, e - 4096); else build_lora_img(F.in[I_GUP], 4, imgG, e - 8192); } }
    bf16* XN = (bf16*)(F.ws + WS_XN);
    for (int R = gw; R < MPAD; R += NGW) {
        GAS unsigned long long* o8 = (GAS unsigned long long*)(XN + (size_t)R * DM) + F.lane;
        if (R >= MROWS) {
#pragma unroll
            for (int j = 0; j < 4; ++j) o8[64 * j] = 0ull;
            continue; }
        const int b = R / LTOK, pos = R % LTOK;
        const float* src = pos < NMETA ? F.in[I_META] + (size_t)pos * DM : F.in[I_X] + ((size_t)b * SEQ + pos - NMETA) * DM;
        const GAS f32x4* xr = (const GAS f32x4*)src + F.lane;
        f32x4 v[4]; float s = 0.f;
#pragma unroll
        for (int j = 0; j < 4; ++j) { v[j] = xr[64 * j]; s += (v[j].x * v[j].x + v[j].y * v[j].y) + (v[j].z * v[j].z + v[j].w * v[j].w); }
        const float rs = 1.0f / sqrtf(wave_sum(s) * (1.0f / DM) + 1e-6f);
#pragma unroll
        for (int j = 0; j < 4; ++j) o8[64 * j] = (unsigned long long)pk2(v[j].x * rs, v[j].y * rs) | ((unsigned long long)pk2(v[j].z * rs, v[j].w * rs) << 32);
    }
}

constexpr int LPADV = 8384;
constexpr size_t WS_VT = WS_WIN;
static_assert(2ull * 2 * 64 * LPADV * 2 <= WS_WOUT - WS_WIN, "VT fits the dead in-proj copy");
constexpr int BIAS_LD = 132;
__device__ __forceinline__ void attn_build_bias(Frame& F, LAS float* biasT) {
    for (int e = F.tid; e < 8 * 129; e += NWAVES * 64) { const int h = e / 129, d = e % 129; biasT[h * BIAS_LD + d] = F.in[I_RELB][(d < 128 ? (int)c_bucket[d] : 31) * 8 + h]; }
}
__device__ __forceinline__ void kv_prep(Frame& F) {
    const int lane = F.lane, gw = F.vcu * NWAVES + F.wave, NGW = F.G * NWAVES;
    const bf16* P = (const bf16*)(F.ws + WS_P); bf16* KN = (bf16*)(F.ws + WS_KN); bf16* VT = (bf16*)(F.ws + WS_VT);
    for (int R = gw; R < MROWS; R += NGW)
#pragma unroll
        for (int hk = 0; hk < 2; ++hk) { const float k = bf2f(P[(size_t)R * INDIM + KOFF + 64 * hk + lane]); const float ss = wave_sum(k * k);
            KN[(size_t)R * 128 + 64 * hk + lane] = (bf16)f2bf(k * (1.0f / sqrtf(ss * (1.0f / 64.0f) + 1e-6f)) * F.in[I_KNW][lane]); }
    constexpr int NPB = LPADV / 64;
    for (int it = gw; it < BATCH * 2 * NPB; it += NGW) { const int pb = it % NPB, bg = it / NPB, b = bg >> 1, g = bg & 1; const int slot = 64 * pb + lane, pos = slot - 128;
        v4u v[8];
        if (pos >= 0 && pos < LTOK) { const v4u* vp = (const v4u*)(P + (size_t)(b * LTOK + pos) * INDIM + VOFF + 64 * g);
#pragma unroll
            for (int c8 = 0; c8 < 8; ++c8) v[c8] = vp[c8]; }
        else {
#pragma unroll
            for (int c8 = 0; c8 < 8; ++c8) v[c8] = (v4u){0u, 0u, 0u, 0u}; }
        bf16* o = VT + (size_t)(bg * 64) * LPADV + slot;
#pragma unroll
        for (int c8 = 0; c8 < 8; ++c8) { o[(size_t)(8 * c8 + 0) * LPADV] = (bf16)(v[c8].x & 0xffffu); o[(size_t)(8 * c8 + 1) * LPADV] = (bf16)(v[c8].x >> 16); o[(size_t)(8 * c8 + 2) * LPADV] = (bf16)(v[c8].y & 0xffffu); o[(size_t)(8 * c8 + 3) * LPADV] = (bf16)(v[c8].y >> 16);
            o[(size_t)(8 * c8 + 4) * LPADV] = (bf16)(v[c8].z & 0xffffu); o[(size_t)(8 * c8 + 5) * LPADV] = (bf16)(v[c8].z >> 16); o[(size_t)(8 * c8 + 6) * LPADV] = (bf16)(v[c8].w & 0xffffu); o[(size_t)(8 * c8 + 7) * LPADV] = (bf16)(v[c8].w >> 16); } }
}
constexpr int NQB = (LTOK + 31) / 32, NATT = BATCH * NQB * 8;
__device__ __forceinline__ void attn_unit(Frame& F, int unit, const LAS float* biasT) {
    int lane_ = (int)__builtin_amdgcn_mbcnt_hi(~0u, __builtin_amdgcn_mbcnt_lo(~0u, 0u)); asm volatile("" : "+v"(lane_));
    const int lane = lane_, n = lane & 31, hf = lane >> 5;
    const int gi = unit & 3, g = (unit >> 2) & 1, bq = unit >> 3, qb = bq % NQB, b = bq / NQB, hq = 4 * g + gi;
    const int q0 = 32 * qb, qpos = q0 + n; const bool live = qpos < LTOK;
    const bf16* P = (const bf16*)(F.ws + WS_P); const bf16* KN = (const bf16*)(F.ws + WS_KN) + (size_t)b * LTOK * 128 + 64 * g; const bf16* VT = (const bf16*)(F.ws + WS_VT) + (size_t)((b * 2 + g) * 64) * LPADV + 128;
    bf16x8 qop[4];
    { const bf16* qrow = P + (size_t)(b * LTOK + (live ? qpos : LTOK - 1)) * INDIM + QOFF + 64 * hq; float qv[4][8]; float ss = 0.f;
#pragma unroll
        for (int ks = 0; ks < 4; ++ks) { const v4u u = *(const v4u*)(qrow + 16 * ks + 8 * hf); qv[ks][0] = bflo(u.x); qv[ks][1] = bfhi(u.x); qv[ks][2] = bflo(u.y); qv[ks][3] = bfhi(u.y); qv[ks][4] = bflo(u.z); qv[ks][5] = bfhi(u.z); qv[ks][6] = bflo(u.w); qv[ks][7] = bfhi(u.w);
#pragma unroll
            for (int j = 0; j < 8; ++j) ss += qv[ks][j] * qv[ks][j]; }
        ss += __shfl_xor(ss, 32); const float rs = 0.125f / sqrtf(ss * (1.0f / 64.0f) + 1e-6f);
#pragma unroll
        for (int ks = 0; ks < 4; ++ks) { const f32x4 w0 = *(const f32x4*)(F.in[I_QNW] + 16 * ks + 8 * hf), w1 = *(const f32x4*)(F.in[I_QNW] + 16 * ks + 8 * hf + 4);
            qop[ks] = pack8(qv[ks][0] * rs * w0[0], qv[ks][1] * rs * w0[1], qv[ks][2] * rs * w0[2], qv[ks][3] * rs * w0[3], qv[ks][4] * rs * w1[0], qv[ks][5] * rs * w1[1], qv[ks][6] * rs * w1[2], qv[ks][7] * rs * w1[3]); } }
    f32x16 S[6]; const float sink = F.in[I_SINK][hq]; float mx = sink;
    const LAS float* bt = biasT + hq * BIAS_LD;
#pragma unroll
    for (int kt = 0; kt < 6; ++kt) { const int kp0 = kt < 5 ? q0 - 128 + 32 * kt : 0; int kl = kp0 + n; kl = kl < 0 ? 0 : (kl > LTOK - 1 ? LTOK - 1 : kl);
        const bf16* krow = KN + (size_t)kl * 128; f32x16 acc = zero16();
#pragma unroll
        for (int ks = 0; ks < 4; ++ks) acc = mfma32(*(const bf16x8*)(krow + 16 * ks + 8 * hf), qop[ks], acc);
#pragma unroll
        for (int q = 0; q < 16; ++q) { const int kr = trow(q, hf), kpos = kp0 + kr, d = qpos - kpos;
            const bool valid = kt < 5 ? (kpos >= NMETA && d >= 0 && d < 128) : (kr < NMETA && d >= 0);
            const int di = d < 0 ? 0 : (d > 128 ? 128 : d);
            const float sv = valid ? acc[q] + bt[di] : -1e30f; acc[q] = sv; mx = fmaxf(mx, sv); }
        S[kt] = acc; }
    mx = fmaxf(mx, __shfl_xor(mx, 32));
    float sum = 0.f; Op2 Pop[6];
#pragma unroll
    for (int kt = 0; kt < 6; ++kt) { f32x16 p;
#pragma unroll
        for (int q = 0; q < 16; ++q) { p[q] = __expf(S[kt][q] - mx); sum += p[q]; }
        Pop[kt] = tile2op(p); }
    sum += __shfl_xor(sum, 32); sum += __expf(sink - mx);
    const float il = 1.0f / sum;
    bf16* orow = (bf16*)(F.ws + WS_YMIX) + (size_t)(b * LTOK + qpos) * DM + 512 + 64 * hq;
#pragma unroll
    for (int db = 0; db < 2; ++db) { f32x16 o = zero16(); const bf16* vrow = VT + (size_t)(32 * db + n) * LPADV;
#pragma unroll
        for (int kt = 0; kt < 6; ++kt) { const int kp0 = kt < 5 ? q0 - 128 + 32 * kt : 0;
#pragma unroll
            for (int s = 0; s < 2; ++s) { const uint2 v0 = *(const uint2*)(vrow + kp0 + 16 * s + 4 * hf), v1 = *(const uint2*)(vrow + kp0 + 16 * s + 8 + 4 * hf);
                v4u u; u.x = v0.x; u.y = v0.y; u.z = v1.x; u.w = v1.y; o = mfma32(__builtin_bit_cast(bf16x8, u), Pop[kt].s[s], o); } }
        if (live) {
#pragma unroll
            for (int g4 = 0; g4 < 4; ++g4) { uint2 w; w.x = cvtpk(o[4 * g4] * il, o[4 * g4 + 1] * il); w.y = cvtpk(o[4 * g4 + 2] * il, o[4 * g4 + 3] * il); *(uint2*)(orow + 32 * db + 8 * g4 + 4 * hf) = w; } } }
}

__device__ __forceinline__ void p5_meta_rows(Frame& F, int blk) {
    const int b = blk >> 1, row = 14 + (blk & 1), U = b * LTOK + row, tid = F.tid;
    LAS float* ys = (LAS float*)(F.lds + RING_OFF); LAS float* red = ys + 1024;
    const bf16* YMIX = (const bf16*)(F.ws + WS_YMIX); const bf16* WT = (const bf16*)(F.ws + WS_WOUT); bf16* H1B = (bf16*)(F.ws + WS_H1B); float* SSQP = (float*)(F.ws + WS_SSQP);
    for (int k = tid; k < DM; k += 512) ys[k] = bf2f(YMIX[(size_t)U * DM + k]);
    __syncthreads();
    float ssq = 0.f;
#pragma unroll 1
    for (int cc = 0; cc < 2; ++cc) { const int col = tid + 512 * cc; const v4u* wp = (const v4u*)(WT + (size_t)col * DM); float acc = 0.f;
#pragma unroll 4
        for (int k8 = 0; k8 < DM / 8; ++k8) { const v4u u = wp[k8]; const f32x4 y0 = *(const LAS f32x4*)(ys + 8 * k8), y1 = *(const LAS f32x4*)(ys + 8 * k8 + 4);
            acc += bflo(u.x) * y0.x + bfhi(u.x) * y0.y + bflo(u.y) * y0.z + bfhi(u.y) * y0.w + bflo(u.z) * y1.x + bfhi(u.z) * y1.y + bflo(u.w) * y1.z + bfhi(u.w) * y1.w; }
        const float h = F.in[I_META][(size_t)row * DM + col] + acc; ssq += h * h; H1B[(size_t)U * DM + col] = (bf16)f2bf(h); }
    ssq = wave_sum(ssq);
    if (F.lane == 0) red[F.wave] = ssq;
    __syncthreads();
    if (tid < 16) { float t = 0.f; if (tid == 0) { for (int w = 0; w < NWAVES; ++w) t += red[w]; } SSQP[(size_t)tid * MPAD + U] = t; }
    __syncthreads();
}

#ifndef MK_N_LAUNCHES
#define MK_N_LAUNCHES 1
#endif
constexpr int N_LAUNCHES = MK_N_LAUNCHES;
constexpr int PER_PHASE = 8;
struct Args { const float* in[25]; float* out; unsigned char* ws; int ph_lo, ph_hi; };
__global__ void __launch_bounds__(NWAVES * 64, 2) hymba_fwd(Args args) {
    extern __shared__ __attribute__((aligned(16))) unsigned char lds[];
    Frame F;
    F.lds = (LAS unsigned char*)lds;
    F.MISC = (volatile LAS unsigned*)(F.lds + MISC_OFF);
    F.tid = threadIdx.x; F.lane = F.tid & 63; F.wave = __builtin_amdgcn_readfirstlane(F.tid >> 6);
    F.G = gridDim.x; { const int bx = blockIdx.x; F.vcu = (F.G % 8 == 0) ? (bx % 8) * (F.G / 8) + bx / 8 : bx; }
    F.ws = args.ws; F.out = args.out; F.ctl = (gu32*)(args.ws + WS_CTL);
#pragma unroll
    for (int i = 0; i < 25; ++i) F.in[i] = args.in[i];
    for (int u = F.tid; u < (LDS_BYTES - LDSCTL_OFF) / 4; u += NWAVES * 64) ((LAS unsigned*)(F.lds + LDSCTL_OFF))[u] = 0u;
    __syncthreads();
    XcdBarrier bar; bar.bar = (unsigned*)(F.ctl + CW_BAR); bar.x = 0; bar.st = nullptr;
    if (N_LAUNCHES == 1) bar = xcd_barrier_post((unsigned*)(F.ctl + CW_BAR), F.MISC + 8);
    const int lo = args.ph_lo, hi = args.ph_hi;
#define IN(k) (lo <= (k) && (k) < hi)
#define SEAM(k) do { if (IN(k) && IN((k) + 1)) xcd_barrier(bar); } while (0)
    bf16* XN = (bf16*)(F.ws + WS_XN); bf16* PB = (bf16*)(F.ws + WS_P); bf16* YMIX = (bf16*)(F.ws + WS_YMIX); bf16* H1B = (bf16*)(F.ws + WS_H1B); bf16* ACT = (bf16*)(F.ws + WS_ACT);
    float* SSQP = (float*)(F.ws + WS_SSQP);

    if (IN(0)) { p0_prologue(F); SEAM(0); }
    if (IN(1)) {
        pg8::Gemm g{XN, (const bf16*)(F.ws + WS_WIN), MPAD, INDIM, DM}; pg8::StaticOrderT<0> S; S.init(MPAD, INDIM, F.G, (int)blockIdx.x);
        pg8::EpiBf16 E{PB, INDIM};
        pg8::gemm_phase<pg8::EpiBf16, pg8::StaticOrderT<0>, true, true>(F.lds + RING_OFF, g, S, E);
        SEAM(1);
    }
    if (IN(2)) {
        LAS unsigned char* park = F.lds + F.wave * 18432;
        const int gw = F.vcu * NWAVES + F.wave, NGW = F.G * NWAVES;
#pragma unroll 1
        for (int job = gw; job < NJOBS; job += NGW) rwkv_chunk_local(F, job, park, F.ws + WS_XN + (size_t)gw * 16384, F.ws + WS_YMIX + (size_t)gw * 16384, (unsigned char*)F.out + JOB16 + JOB8 + (size_t)gw * 6144, F.ws + WS_TAIL + 2 * JOB8 + (size_t)MROWS * 32 + (size_t)gw * 6144);
        kv_prep(F);
        SEAM(2);
    }
    if (IN(3)) {
        const int blk = (int)blockIdx.x;
        LAS float* biasT = (LAS float*)(F.lds + RING_OFF);
        attn_build_bias(F, biasT);
        __syncthreads();
        if (blk < 64 && F.wave == 0) rwkv_scan(F, blk);
        else { const int w0 = blk < 64 ? blk * 7 + F.wave - 1 : 448 + (blk - 64) * 8 + F.wave, nw = 448 + (F.G - 64) * 8;
#pragma unroll 1
            for (int u = w0; u < NATT; u += nw) attn_unit(F, u, biasT); }
        SEAM(3);
    }
    if (IN(4)) {
        const int gw = F.vcu * NWAVES + F.wave, NGW = F.G * NWAVES;
#pragma unroll 1
        for (int job = gw; job < NJOBS; job += NGW) rwkv_output(F, job);
        SEAM(4);
    }
    if (IN(5)) {
        if (blockIdx.x < 4) p5_meta_rows(F, (int)blockIdx.x);
        pg8::Gemm g{YMIX, (const bf16*)(F.ws + WS_WOUT), MREAL, DM, DM}; pg8::StaticOrderT<1> S; S.init(MREAL, DM, F.G, (int)blockIdx.x);
        pg8::EpiH1 E{F.in[I_X], F.out, H1B, SSQP, MPAD};
        pg8::gemm_phase<pg8::EpiH1, pg8::StaticOrderT<1>, true, true>(F.lds + RING_OFF, g, S, E);
        SEAM(5);
    }
    if (IN(6)) {
        pg8::Gemm g{H1B, (const bf16*)(F.ws + WS_WUP), 66 * 256, 2 * DFF, DM}; pg8::StaticOrderT<2> S; S.init(66 * 256, 2 * DFF, F.G, (int)blockIdx.x);
        pg8::EpiAct E{ACT, SSQP, MPAD, F.in[I_CONVW], F.in[I_CONVB], (LAS float*)(F.lds + HALO_OFF)};
        pg8::gemm_phase<pg8::EpiAct, pg8::StaticOrderT<2>, true, true>(F.lds + RING_OFF, g, S, E);
        SEAM(6);
    }
    if (IN(7)) {
        pg8::Gemm g{ACT, (const bf16*)(F.ws + WS_WDN), MREAL, DM, DFF}; pg8::StaticOrderT<0> S; S.init(MREAL, DM, F.G, (int)blockIdx.x);
        pg8::EpiOut E{F.out};
        pg8::gemm_phase<pg8::EpiOut, pg8::StaticOrderT<0>, true, true>(F.lds + RING_OFF, g, S, E);
    }
#undef IN
#undef SEAM
}

extern "C" void kernel_launch(void* const* d_in, const int* in_sizes, int n_in, void* d_out, int out_size, void* d_ws, size_t ws_size, hipStream_t stream) {
    static int grid = 0;
    if (grid == 0) {
        if (n_in != 25 || out_size != MREAL * DM || ws_size < WS_END) { fprintf(stderr, "kernel_launch: unexpected shapes n_in %d out %d ws %zu\n", n_in, out_size, ws_size); grid = -1; return; }
        int dev = 0, cus = 0;
        if (hipGetDevice(&dev) != hipSuccess || hipDeviceGetAttribute(&cus, hipDeviceAttributeMultiprocessorCount, dev) != hipSuccess) { grid = -1; return; }
        if (hipFuncSetAttribute((const void*)hymba_fwd, hipFuncAttributeMaxDynamicSharedMemorySize, LDS_BYTES) != hipSuccess) { fprintf(stderr, "kernel_launch: hipFuncSetAttribute failed\n"); grid = -1; return; }
        (void)hipGetLastError();
        grid = cus;
    }
    if (grid < 0) return;
    (void)hipMemsetAsync((char*)d_ws + WS_CTL, 0, CTL_ZERO_BYTES, stream);
    Args a{};
    for (int i = 0; i < 25; ++i) a.in[i] = (const float*)d_in[i];
    a.out = (float*)d_out; a.ws = (unsigned char*)d_ws;
    for (int li = 0; li < N_LAUNCHES; ++li) {
        a.ph_lo = (N_LAUNCHES == 1) ? 0 : li; a.ph_hi = (N_LAUNCHES == 1) ? PER_PHASE : li + 1;
        hipLaunchKernelGGL(hymba_fwd, dim3(grid), dim3(NWAVES * 64), LDS_BYTES, stream, a);
    }
}
```

```cpp
#include <hip/hip_runtime.h>
#include <cstdio>
#include <cstdint>
namespace pg8 {
#define PG8_LAS __attribute__((address_space(3)))
typedef unsigned short bf16_t;
typedef short bf16x8 __attribute__((ext_vector_type(8)));
typedef float f32x4 __attribute__((ext_vector_type(4)));
typedef unsigned u32x4 __attribute__((ext_vector_type(4)));
constexpr int BM = 256, BK = 64, HALF = 128, HTB = HALF * BK * 2  , STAGE_BYTES = 8 * HTB, NXCD = 8, WGM = 8;

__host__ __device__ __forceinline__ int lds_byte(int r, int c) { const int st = (r >> 4) * 2 + (c >> 5), rr = r & 15, cc = c & 31, ob = rr * 64 + cc * 2; return st * 1024 + (ob ^ (((ob >> 9) & 1) << 5)); }
__host__ __device__ __forceinline__ void stage_rc(int b, int& R, int& C) { const int st = b / 1024, sb = b % 1024, swz = sb ^ (((sb >> 9) & 1) << 5); R = (st >> 1) * 16 + swz / 64; C = (st & 1) * 32 + (swz % 64) / 2; }
__host__ __device__ __forceinline__ int perm32(int rho) { const int n = rho >> 4, i = rho & 15; return 8 * (i >> 2) + 4 * n + (i & 3); }

struct Unit { int pm, pn; };
struct Gemm { const bf16_t* A; const bf16_t* Bt; int M, N, K; };

template <int AMODE> struct StaticOrderT {
    int nM, nN, nwg, G, c;
    __host__ __device__ __forceinline__ void init(int M, int N, int G_, int c_) { nM = M / BM; nN = N / BM; nwg = nM * nN; G = G_; c = c_; }
    __host__ __device__ __forceinline__ bool next(int i, Unit& u) const {
        const long L = (long)i * G + c; if (L >= nwg) return false;
        int wgid = (int)L; { const int q = nwg / NXCD, r = nwg % NXCD, xcd = wgid % NXCD, off = wgid / NXCD; wgid = (xcd < r ? xcd * (q + 1) : r * (q + 1) + (xcd - r) * q) + off; }
        const int nig = WGM * nN, gid = wgid / nig, fm = gid * WGM, gsz = (nM - fm) < WGM ? (nM - fm) : WGM;
        u.pm = fm + ((wgid % nig) % gsz); u.pn = (wgid % nig) / gsz; return true;
    }
    __host__ __device__ __forceinline__ int a_row0(const Unit& u) const { return AMODE == 0 ? u.pm * BM : (AMODE == 1 ? (u.pm >> 5) * 8208 + 16 + (u.pm & 31) * 256 : (u.pm / 33) * 8208 + 14 + 254 * (u.pm % 33)); }
    __device__ __forceinline__ void a_ready(const Unit&) const {}
    __device__ __forceinline__ void done(const Unit&) const {}
};

__device__ __forceinline__ unsigned cvt_pk_bf16(float lo, float hi) { unsigned r; asm volatile("v_cvt_pk_bf16_f32 %0, %1, %2" : "=v"(r) : "v"(lo), "v"(hi)); return r; }
typedef float f32x2 __attribute__((ext_vector_type(2)));
typedef unsigned u32x2 __attribute__((ext_vector_type(2)));
struct EpiBf16 {
    static constexpr bool PERM = true, AFTER_DRAIN = false;
    bf16_t* O; int ldc;
    __device__ __forceinline__ void operator()(f32x4 (&acc)[2][2][4][2], const Unit& u, int wr, int wc, int fr, int fq) const {
        const int row0 = u.pm * BM + wr * 64 + fr, col0 = u.pn * BM + wc * 32 + 8 * fq;
#pragma unroll
        for (int ai = 0; ai < 2; ++ai)
#pragma unroll
            for (int m = 0; m < 4; ++m) { bf16_t* rowp = O + (size_t)(row0 + ai * HALF + m * 16) * ldc + col0;
#pragma unroll
                for (int bj = 0; bj < 2; ++bj) { const f32x4 v0 = acc[ai][bj][m][0], v1 = acc[ai][bj][m][1];
                    u32x4 w; w.x = cvt_pk_bf16(v0[0], v0[1]); w.y = cvt_pk_bf16(v0[2], v0[3]); w.z = cvt_pk_bf16(v1[0], v1[1]); w.w = cvt_pk_bf16(v1[2], v1[3]);
                    *(u32x4*)(rowp + bj * HALF) = w; } }
    }
};
struct EpiH1 {
    static constexpr bool PERM = false, AFTER_DRAIN = false;
    const float* x; float* out; bf16_t* h1b; float* ssqp; int ssq_stride;
    __device__ __forceinline__ void operator()(f32x4 (&acc)[2][2][4][2], const Unit& u, int wr, int wc, int fr, int fq) const {
        const int col0 = u.pn * BM + wc * 32 + 4 * fq;
#pragma unroll
        for (int ai = 0; ai < 2; ++ai)
#pragma unroll
            for (int m = 0; m < 4; ++m) { const int rr = u.pm * BM + ai * HALF + wr * 64 + m * 16 + fr; const int U = (rr >> 13) * 8208 + 16 + (rr & 8191); float s = 0.f;
#pragma unroll
                for (int bj = 0; bj < 2; ++bj)
#pragma unroll
                    for (int n = 0; n < 2; ++n) { const size_t off = (size_t)rr * 1024 + col0 + bj * HALF + n * 16;
                        const f32x4 h = *(const f32x4*)(x + off) + acc[ai][bj][m][n]; *(f32x4*)(out + off) = h;
                        s += (h[0] * h[0] + h[1] * h[1]) + (h[2] * h[2] + h[3] * h[3]);
                        u32x2 w; w.x = cvt_pk_bf16(h[0], h[1]); w.y = cvt_pk_bf16(h[2], h[3]); *(u32x2*)(h1b + (size_t)U * 1024 + col0 + bj * HALF + n * 16) = w; }
                s += __shfl_xor(s, 16); s += __shfl_xor(s, 32);
                if (fq == 0) ssqp[(size_t)(u.pn * 4 + wc) * ssq_stride + U] = s; }
    }
};
struct EpiOut {
    static constexpr bool PERM = false, AFTER_DRAIN = false;
    float* out;
    __device__ __forceinline__ void operator()(f32x4 (&acc)[2][2][4][2], const Unit& u, int wr, int wc, int fr, int fq) const {
        const int col0 = u.pn * BM + wc * 32 + 4 * fq;
#pragma unroll
        for (int ai = 0; ai < 2; ++ai)
#pragma unroll
            for (int m = 0; m < 4; ++m) { const int rr = u.pm * BM + ai * HALF + wr * 64 + m * 16 + fr;
#pragma unroll
                for (int bj = 0; bj < 2; ++bj)
#pragma unroll
                    for (int n = 0; n < 2; ++n) { const size_t off = (size_t)rr * 1024 + col0 + bj * HALF + n * 16; *(f32x4*)(out + off) = *(const f32x4*)(out + off) + acc[ai][bj][m][n]; } }
    }
};
__device__ __forceinline__ float ror1(float x) { return __builtin_bit_cast(float, __builtin_amdgcn_mov_dpp(__builtin_bit_cast(int, x), 0x121, 0xf, 0xf, true)); }
__device__ __forceinline__ float ror2(float x) { return __builtin_bit_cast(float, __builtin_amdgcn_mov_dpp(__builtin_bit_cast(int, x), 0x122, 0xf, 0xf, true)); }
struct EpiAct {
    static constexpr bool PERM = true, AFTER_DRAIN = false;
    bf16_t* act; const float* rs2; const float* conv_w; const float* conv_b; PG8_LAS float* halo;
    __device__ __forceinline__ void operator()(f32x4 (&acc)[2][2][4][2], const Unit& u, int wr, int wc, int fr, int fq) const {
        const int b = u.pm / 33, ti = u.pm % 33;
#pragma unroll
        for (int ai = 0; ai < 2; ++ai)
#pragma unroll
            for (int m = 0; m < 4; ++m) { const int pos = 14 + 254 * ti + ai * HALF + wr * 64 + m * 16 + fr; const float rs = rs2[b * 8208 + (pos <= 8207 ? pos : 8207)];
#pragma unroll
                for (int bj = 0; bj < 2; ++bj)
#pragma unroll
                    for (int n = 0; n < 2; ++n) acc[ai][bj][m][n] = acc[ai][bj][m][n] * rs; }
        if (fr >= 14) {
#pragma unroll
            for (int ai = 0; ai < 2; ++ai)
#pragma unroll
                for (int bj = 0; bj < 2; ++bj)
#pragma unroll
                    for (int n = 0; n < 2; ++n) *(PG8_LAS f32x4*)(halo + ((2 * ai + wr) * 2 + (fr - 14)) * 256 + bj * 128 + wc * 32 + 8 * fq + 4 * n) = acc[ai][bj][3][n];
        }
        asm volatile("s_waitcnt lgkmcnt(0)" ::: "memory"); __builtin_amdgcn_s_barrier(); asm volatile("" ::: "memory");
        u32x2 res[2][4][2];
#pragma unroll
        for (int n = 0; n < 2; ++n) {
            const int jg = u.pn * 128 + wc * 32 + 8 * fq + 4 * n;
            const f32x4 g0 = *(const f32x4*)(conv_w + jg), g1 = *(const f32x4*)(conv_w + 5632 + jg), g2 = *(const f32x4*)(conv_w + 2 * 5632 + jg), gb = *(const f32x4*)(conv_b + jg);
            const f32x4 v0 = *(const f32x4*)(conv_w + 2816 + jg), v1 = *(const f32x4*)(conv_w + 5632 + 2816 + jg), v2 = *(const f32x4*)(conv_w + 2 * 5632 + 2816 + jg), vb = *(const f32x4*)(conv_b + 2816 + jg);
#pragma unroll
            for (int ai = 0; ai < 2; ++ai) { const int seg = 2 * ai + wr;
                f32x4 pg = (f32x4){0.f, 0.f, 0.f, 0.f}, pv = (f32x4){0.f, 0.f, 0.f, 0.f};
                if (seg > 0 && fr >= 14) { const PG8_LAS float* hp = halo + ((seg - 1) * 2 + (fr - 14)) * 256 + wc * 32 + 8 * fq + 4 * n; pg = *(const PG8_LAS f32x4*)hp; pv = *(const PG8_LAS f32x4*)(hp + 128); }
#pragma unroll
                for (int m = 0; m < 4; ++m) { const f32x4 xg = acc[ai][0][m][n], xv = acc[ai][1][m][n]; float o[4];
#pragma unroll
                    for (int c = 0; c < 4; ++c) {
                        const float zg1 = fr == 15 ? pg[c] : xg[c], zg2 = fr >= 14 ? pg[c] : xg[c], zv1 = fr == 15 ? pv[c] : xv[c], zv2 = fr >= 14 ? pv[c] : xv[c];
                        const float xg1 = ror1(zg1), xg2 = ror2(zg2), xv1 = ror1(zv1), xv2 = ror2(zv2);
                        const float gate = g0[c] * xg[c] + g1[c] * xg1 + g2[c] * xg2 + gb[c];
                        const float val = v0[c] * xv[c] + v1[c] * xv1 + v2[c] * xv2 + vb[c];
                        o[c] = gate * __builtin_amdgcn_rcpf(1.0f + __expf(-gate)) * val; }
                    res[ai][m][n].x = cvt_pk_bf16(o[0], o[1]); res[ai][m][n].y = cvt_pk_bf16(o[2], o[3]);
                    pg = xg; pv = xv; } }
        }
#pragma unroll
        for (int ai = 0; ai < 2; ++ai)
#pragma unroll
            for (int m = 0; m < 4; ++m) { const int r = ai * HALF + wr * 64 + m * 16 + fr, t = 254 * ti + r - 2;
                if (r >= 2 && t < 8192) { u32x4 w; w.x = res[ai][m][0].x; w.y = res[ai][m][0].y; w.z = res[ai][m][1].x; w.w = res[ai][m][1].y;
                    *(u32x4*)(act + (size_t)(b * 8192 + t) * 2816 + u.pn * 128 + wc * 32 + 8 * fq) = w; } }
    }
};

template <class Epi, class Sched, bool ALIGN_EPI = false, bool SP2 = false>
__device__ __forceinline__ void gemm_phase(PG8_LAS unsigned char* lds, const Gemm g, const Sched& S, const Epi& E) {
    const int tid = threadIdx.x, wid = __builtin_amdgcn_readfirstlane(tid >> 6), lane = tid & 63, wr = wid >> 2, wc = wid & 3, fr = lane & 15, fq = lane >> 4;
    const int K = g.K, nt = K / BK;
    unsigned voffA[2], voffB[2];
#pragma unroll
    for (int i = 0; i < 2; ++i) { int R, C; stage_rc(tid * 16 + i * 8192, R, C); const int Rb = Epi::PERM ? ((R & ~31) + perm32(R & 31)) : R;
        voffA[i] = (unsigned)(R * K + C) * 2u; voffB[i] = (unsigned)(Rb * K + C) * 2u; }
    const size_t kstep = (size_t)(BK * 2);
    const size_t hstep = (size_t)HALF * K * 2;
    const size_t tstep = 2 * hstep;
    const unsigned ldsw = (unsigned)wid * 1024u;
    const int aoff = lds_byte(wr * 64 + fr, fq * 8), boff = lds_byte(wc * 32 + fr, fq * 8);
#define PG8_SA(b, h) (((b) * 2 + (h)) * HTB)
#define PG8_SB(b, h) ((4 + (b) * 2 + (h)) * HTB)
#define PG8_STAGE(bufoff, gbase, voff) do { _Pragma("unroll") for (int _i = 0; _i < 2; ++_i) \
        __builtin_amdgcn_global_load_lds((const unsigned*)((const char*)(gbase) + (voff)[_i]), (PG8_LAS unsigned*)(lds + (bufoff) + ldsw + _i * 8192), 16, 0, 0); } while (0)
#define PG8_LDA(dst, b, h) do { _Pragma("unroll") for (int m = 0; m < 4; ++m) _Pragma("unroll") for (int k = 0; k < 2; ++k) dst[m][k] = *(const PG8_LAS bf16x8*)(lds + PG8_SA(b, h) + aoff + m * 2048 + k * 1024); } while (0)
#define PG8_LDB(dst, b, h) do { _Pragma("unroll") for (int n = 0; n < 2; ++n) _Pragma("unroll") for (int k = 0; k < 2; ++k) dst[n][k] = *(const PG8_LAS bf16x8*)(lds + PG8_SB(b, h) + boff + n * 2048 + k * 1024); } while (0)
#define PG8_MMA(ai, bj, At, Bt) do { __builtin_amdgcn_s_setprio(1); _Pragma("unroll") for (int m = 0; m < 4; ++m) _Pragma("unroll") for (int n = 0; n < 2; ++n) _Pragma("unroll") for (int k = 0; k < 2; ++k) \
        acc[ai][bj][m][n] = __builtin_amdgcn_mfma_f32_16x16x32_bf16(Bt[n][k], At[m][k], acc[ai][bj][m][n], 0, 0, 0); __builtin_amdgcn_s_setprio(0); } while (0)
#define PG8_WAIT_V(n) asm volatile("s_waitcnt vmcnt(" #n ")" ::: "memory")
#define PG8_WAIT_L(n) asm volatile("s_waitcnt lgkmcnt(" #n ")" ::: "memory")
#define PG8_BAR __builtin_amdgcn_s_barrier()
#define PG8_SCHED __builtin_amdgcn_sched_barrier(0)
    Unit cur, nxt; int ui = 0;
    if (!S.next(0, cur)) return;
    f32x4 acc[2][2][4][2];
#pragma unroll
    for (int a = 0; a < 2; ++a)
#pragma unroll
        for (int b = 0; b < 2; ++b)
#pragma unroll
            for (int m = 0; m < 4; ++m)
#pragma unroll
                for (int n = 0; n < 2; ++n) acc[a][b][m][n] = (f32x4){0.f, 0.f, 0.f, 0.f};
    bf16x8 At[4][2], B0[2][2], B1[2][2];
    const size_t rowb = (size_t)K * 2; const char* cA = (const char*)g.A + (size_t)S.a_row0(cur) * rowb; const char* cB = (const char*)g.Bt + (size_t)cur.pn * tstep;
    S.a_ready(cur);
    if constexpr (SP2) {
        PG8_STAGE(PG8_SB(0, 0), cB, voffB); PG8_STAGE(PG8_SB(0, 1), cB + hstep, voffB); PG8_STAGE(PG8_SA(0, 0), cA, voffA); PG8_STAGE(PG8_SA(0, 1), cA + hstep, voffA);
        if (wr == 1) PG8_BAR;
        PG8_WAIT_V(2); PG8_BAR;
        PG8_STAGE(PG8_SB(1, 0), cB + kstep, voffB); PG8_STAGE(PG8_SA(1, 0), cA + kstep, voffA); PG8_STAGE(PG8_SB(1, 1), cB + hstep + kstep, voffB);
        PG8_WAIT_V(6); PG8_BAR;
    } else {
        PG8_STAGE(PG8_SB(0, 0), cB, voffB); PG8_STAGE(PG8_SA(0, 0), cA, voffA); PG8_STAGE(PG8_SB(0, 1), cB + hstep, voffB); PG8_STAGE(PG8_SA(0, 1), cA + hstep, voffA);
        if (wr == 1) PG8_BAR;
        PG8_WAIT_V(4); PG8_BAR;
        PG8_STAGE(PG8_SB(1, 0), cB + kstep, voffB); PG8_STAGE(PG8_SA(1, 0), cA + kstep, voffA); PG8_STAGE(PG8_SB(1, 1), cB + hstep + kstep, voffB);
        PG8_WAIT_V(6); PG8_BAR;
    }
    for (;;) {
        const bool has_next = S.next(ui + 1, nxt);
        const char* nA = has_next ? (const char*)g.A + (size_t)S.a_row0(nxt) * rowb : cA; const char* nB = has_next ? (const char*)g.Bt + (size_t)nxt.pn * tstep : cB;
        for (int t = 0; t < nt; t += 2) {
            const bool last = (t == nt - 2);
            const char* a1 = cA + (size_t)(t + 1) * kstep;
            const char* a2 = last ? nA : cA + (size_t)(t + 2) * kstep; const char* b2 = last ? nB : cB + (size_t)(t + 2) * kstep;
            const char* a3 = a2 + kstep; const char* b3 = b2 + kstep;
            if (last && has_next) S.a_ready(nxt);
            if constexpr (SP2) {
            PG8_LDB(B0, 0, 0); PG8_LDB(B1, 0, 1); PG8_SCHED; PG8_LDA(At, 0, 0); PG8_STAGE(PG8_SA(1, 1), a1 + hstep, voffA);
            PG8_WAIT_V(8); PG8_WAIT_L(0); PG8_BAR; PG8_MMA(0, 0, At, B0); PG8_MMA(0, 1, At, B1); PG8_BAR; PG8_SCHED;
            PG8_LDA(At, 0, 1); PG8_STAGE(PG8_SB(0, 0), b2, voffB); PG8_STAGE(PG8_SB(0, 1), b2 + hstep, voffB); PG8_STAGE(PG8_SA(0, 0), a2, voffA);
            PG8_WAIT_V(8); PG8_WAIT_L(0); PG8_BAR; PG8_MMA(1, 0, At, B0); PG8_MMA(1, 1, At, B1); PG8_BAR; PG8_SCHED;
            PG8_LDB(B0, 1, 0); PG8_LDB(B1, 1, 1); PG8_SCHED; PG8_LDA(At, 1, 0); PG8_STAGE(PG8_SA(0, 1), a2 + hstep, voffA);
            PG8_WAIT_V(8); PG8_WAIT_L(0); PG8_BAR; PG8_MMA(0, 0, At, B0); PG8_MMA(0, 1, At, B1); PG8_BAR; PG8_SCHED;
            PG8_LDA(At, 1, 1); PG8_STAGE(PG8_SB(1, 0), b3, voffB); PG8_STAGE(PG8_SB(1, 1), b3 + hstep, voffB); PG8_STAGE(PG8_SA(1, 0), a3, voffA);
            PG8_WAIT_V(8); PG8_WAIT_L(0); PG8_BAR; PG8_MMA(1, 0, At, B0); PG8_MMA(1, 1, At, B1); PG8_BAR; PG8_SCHED;
            } else {
            PG8_LDB(B0, 0, 0); PG8_SCHED; PG8_LDA(At, 0, 0); PG8_STAGE(PG8_SA(1, 1), a1 + hstep, voffA);
            PG8_WAIT_L(8); PG8_BAR; PG8_WAIT_L(0); PG8_MMA(0, 0, At, B0); PG8_BAR; PG8_SCHED;
            PG8_LDB(B1, 0, 1); PG8_STAGE(PG8_SB(0, 0), b2, voffB);
            PG8_BAR; PG8_WAIT_L(0); PG8_MMA(0, 1, At, B1); PG8_BAR;
            PG8_LDA(At, 0, 1); PG8_STAGE(PG8_SA(0, 0), a2, voffA);
            PG8_BAR; PG8_WAIT_L(0); PG8_MMA(1, 0, At, B0); PG8_BAR; PG8_SCHED;
            PG8_STAGE(PG8_SB(0, 1), b2 + hstep, voffB);
            PG8_WAIT_V(6); PG8_BAR; PG8_MMA(1, 1, At, B1); PG8_BAR;
            PG8_LDB(B0, 1, 0); PG8_SCHED; PG8_LDA(At, 1, 0); PG8_STAGE(PG8_SA(0, 1), a2 + hstep, voffA);
            PG8_WAIT_L(8); PG8_BAR; PG8_WAIT_L(0); PG8_MMA(0, 0, At, B0); PG8_BAR; PG8_SCHED;
            PG8_LDB(B1, 1, 1); PG8_STAGE(PG8_SB(1, 0), b3, voffB);
            PG8_BAR; PG8_WAIT_L(0); PG8_MMA(0, 1, At, B1); PG8_BAR;
            PG8_LDA(At, 1, 1); PG8_STAGE(PG8_SA(1, 0), a3, voffA);
            PG8_BAR; PG8_WAIT_L(0); PG8_MMA(1, 0, At, B0); PG8_BAR; PG8_SCHED;
            PG8_STAGE(PG8_SB(1, 1), b3 + hstep, voffB);
            PG8_WAIT_V(6); PG8_BAR; PG8_MMA(1, 1, At, B1); PG8_BAR;
            }
        }
        if constexpr (ALIGN_EPI) { if (wr == 0) PG8_BAR; }
        if constexpr (!Epi::AFTER_DRAIN) { E(acc, cur, wr, wc, fr, fq); S.done(cur); }
        if (!has_next) break;
#pragma unroll
        for (int a = 0; a < 2; ++a)
#pragma unroll
            for (int b = 0; b < 2; ++b)
#pragma unroll
                for (int m = 0; m < 4; ++m)
#pragma unroll
                    for (int n = 0; n < 2; ++n) acc[a][b][m][n] = (f32x4){0.f, 0.f, 0.f, 0.f};
        cur = nxt; cA = nA; cB = nB; ++ui;
        if constexpr (ALIGN_EPI) { if (wr == 1) PG8_BAR; }
    }
    PG8_WAIT_V(0);
    if constexpr (!ALIGN_EPI) { if (wr == 0) PG8_BAR; }
    PG8_BAR;
    if constexpr (Epi::AFTER_DRAIN) { E.fused(acc, cur, wr, wc, fr, fq, lds, wid, lane); S.done(cur); }
#undef PG8_SA
#undef PG8_SB
#undef PG8_STAGE
#undef PG8_LDA
#undef PG8_LDB
#undef PG8_MMA
#undef PG8_WAIT_V
#undef PG8_WAIT_L
#undef PG8_BAR
#undef PG8_SCHED
}
}
#define GAS __attribute__((address_space(1)))
#define LAS __attribute__((address_space(3)))
typedef unsigned short bf16;
typedef unsigned v4u __attribute__((ext_vector_type(4)));
typedef float f32x4 __attribute__((ext_vector_type(4)));
typedef short bf16x8 __attribute__((ext_vector_type(8)));
typedef GAS unsigned gu32;
typedef GAS unsigned long long gu64;
#define RLX_AGENT __ATOMIC_RELAXED, __HIP_MEMORY_SCOPE_AGENT
#define LDS_WAIT() asm volatile("s_waitcnt lgkmcnt(0)" ::: "memory")
#define VM_WAIT() asm volatile("s_waitcnt vmcnt(0)" ::: "memory")
__device__ __forceinline__ unsigned long long rt() { return __builtin_amdgcn_s_memrealtime(); }
__device__ __forceinline__ unsigned f2bf(float f) { unsigned u = __builtin_bit_cast(unsigned, f); return (u + 0x7fffu + ((u >> 16) & 1u)) >> 16; }
__device__ __forceinline__ unsigned pk2(float lo, float hi) { return f2bf(lo) | (f2bf(hi) << 16); }

#define XB_TMO      128
#define XB_XCNT(j)  (256  + 64 * (j))
#define XB_XSUB(j)  (1280 + 64 * (j))
#define XB_XGEN(j)  (2304 + 64 * (j))
#define XB_TOP      3328
#define XB_TOPGEN   3392
#define XCD_BAR_WORDS 3456
#define XB_SPIN_CAP (1u << 18)

__device__ __forceinline__ unsigned xb_ld(unsigned* p)              { return __hip_atomic_load(p, __ATOMIC_RELAXED, __HIP_MEMORY_SCOPE_AGENT); }
__device__ __forceinline__ unsigned xb_add(unsigned* p, unsigned v) { return __hip_atomic_fetch_add(p, v, __ATOMIC_RELAXED, __HIP_MEMORY_SCOPE_AGENT); }
__device__ __forceinline__ unsigned xb_xcc_id() { return (unsigned)__builtin_amdgcn_s_getreg((3 << 11) | 20) & 0xFu; }
#define XB_SPIN(cond, bar) do { unsigned _sp = 0; while (cond) { __builtin_amdgcn_s_sleep(1); \
    if ((++_sp & 255u) == 0u) { if (xb_ld(&(bar)[XB_TMO])) break; if (_sp > XB_SPIN_CAP) { atomicAdd(&(bar)[XB_TMO], 1u); break; } } } } while (0)

struct XcdBarrier {
    unsigned* bar; unsigned x;
    volatile LAS unsigned* st;
};

__device__ __forceinline__ XcdBarrier xcd_barrier_post(unsigned* bar, volatile LAS unsigned* st) {
    XcdBarrier b; b.bar = bar; b.x = xb_xcc_id(); b.st = st;
    if (threadIdx.x == 0) (void)xb_add(&bar[XB_XCNT(b.x)], 1u);
    return b;
}
__device__ __forceinline__ void xcd_barrier_complete(unsigned* bar, unsigned x, unsigned& nloc, unsigned& nx) {
    const unsigned G = gridDim.x * gridDim.y * gridDim.z;
    unsigned sum, cnt, mine, sp = 0u;
    for (;;) {
        sum = 0u; cnt = 0u; mine = 0u;
#pragma unroll
        for (unsigned j = 0; j < 16; ++j) { const unsigned c = xb_ld(&bar[XB_XCNT(j)]); sum += c; cnt += (c > 0u) ? 1u : 0u; mine = (j == x) ? c : mine; }
        if (sum == G) break;
        __builtin_amdgcn_s_sleep(1);
        if ((++sp & 255u) == 0u) { if (xb_ld(&bar[XB_TMO])) break; if (sp > XB_SPIN_CAP) { atomicAdd(&bar[XB_TMO], 1u); break; } }
    }
    nloc = mine > 0u ? mine : 1u; nx = cnt > 0u ? cnt : 1u;
}

__device__ __forceinline__ void xcd_barrier(const XcdBarrier& b) {
    asm volatile("s_waitcnt vmcnt(0)" ::: "memory");
    __syncthreads();
    if (threadIdx.x == 0) {
        unsigned* bar = b.bar;
        __builtin_amdgcn_s_waitcnt(0);
        unsigned nloc = b.st[0], nx = b.st[1];
        if (nloc == 0u) { xcd_barrier_complete(bar, b.x, nloc, nx); b.st[0] = nloc; b.st[1] = nx; }
        const unsigned old = xb_add(&bar[XB_XSUB(b.x)], 1u);
        const unsigned gen = old / nloc;
        if (old + 1u == (gen + 1u) * nloc) {
            __builtin_amdgcn_fence(__ATOMIC_RELEASE, "agent");
            asm volatile("s_waitcnt vmcnt(0)" ::: "memory");
            const unsigned og = xb_add(&bar[XB_TOP], 1u);
            const unsigned tg = og / nx;
            if (og + 1u == (tg + 1u) * nx) xb_add(&bar[XB_TOPGEN], 1u);
            else XB_SPIN(xb_ld(&bar[XB_TOPGEN]) == tg, bar);
            __builtin_amdgcn_fence(__ATOMIC_ACQUIRE, "agent");
            xb_add(&bar[XB_XGEN(b.x)], 1u);
            asm volatile("s_waitcnt vmcnt(0)" ::: "memory");
        } else {
            XB_SPIN(xb_ld(&bar[XB_XGEN(b.x)]) == gen, bar);
            __builtin_amdgcn_fence(__ATOMIC_ACQUIRE, "agent");
            asm volatile("s_waitcnt vmcnt(0)" ::: "memory");
        }
    }
    __syncthreads();
}
constexpr int NWAVES = 8;
constexpr int BATCH = 2, SEQ = 8192, NMETA = 16, LTOK = SEQ + NMETA  , DM = 1024, INDIM = 2560, RWKV_IN = 1792, RDIM = 512, DFF = 2816;
constexpr int MROWS = BATCH * LTOK  , MPAD = 16640  , MREAL = BATCH * SEQ;
constexpr int QOFF = RWKV_IN, KOFF = RWKV_IN + 512, VOFF = RWKV_IN + 512 + 128;
constexpr size_t MiB = 1u << 20;
constexpr size_t WS_CTL = 0, CTL_ZERO_BYTES = 64 * 1024;
constexpr size_t WS_WIN = 1 * MiB, WS_WOUT = 6 * MiB, WS_WUP = 8 * MiB, WS_WDN = 19 * MiB;
constexpr size_t WS_SSQP = 24 * MiB + 512 * 1024;
constexpr size_t WS_KN = 26 * MiB;
constexpr size_t WS_XN = 30 * MiB + 512 * 1024;
constexpr size_t WS_P = 63 * MiB;
constexpr size_t WS_YMIX = 144 * MiB + 512 * 1024;
constexpr size_t WS_H1B = 177 * MiB;
constexpr size_t WS_TAIL = 209 * MiB + 512 * 1024;
constexpr size_t WS_ACT = WS_XN;
constexpr size_t WS_END = 256 * MiB;
constexpr size_t PREPB = (size_t)MROWS * RDIM * 2;
static_assert(WS_WDN + (size_t)DM * DFF * 2 <= WS_SSQP && WS_SSQP + 17ull * MPAD * 4 <= WS_KN && WS_KN + (size_t)MROWS * 128 * 2 <= WS_XN, "ws map 1");
static_assert(WS_XN + (size_t)MPAD * DM * 2 <= WS_P && WS_XN + (size_t)MROWS * RDIM * 4 <= WS_P && WS_P + (size_t)MPAD * INDIM * 2 <= WS_YMIX && WS_YMIX + (size_t)MPAD * DM * 2 <= WS_H1B, "ws map 2");
static_assert(WS_H1B + (size_t)MPAD * DM * 2 <= WS_TAIL && WS_H1B + PREPB <= WS_TAIL && WS_TAIL + 2 * PREPB <= WS_END && WS_ACT + (size_t)MREAL * DFF * 2 <= WS_YMIX, "ws map 3");
static_assert(3 * PREPB <= (size_t)MREAL * DM * 4, "d_out holds RB, K2B, VB");
constexpr int CW_BAR = 4096;
constexpr int RING_OFF = 0, RING_BYTES = 131072, HALO_OFF = RING_BYTES  , LDSCTL_OFF = 147456  , MISC_OFF = LDSCTL_OFF + 320, LDS_BYTES = 148480;

__constant__ unsigned char c_bucket[128] = {0, 1, 2, 3, 4, 5, 6, 7, 8, 9, 10, 11, 12, 13, 14, 15, 16, 16, 16, 17, 17, 18, 18, 18, 19, 19, 19, 20, 20, 20, 20, 21, 21, 21, 21, 22, 22, 22, 22, 22, 23, 23, 23, 23, 23, 23, 24, 24, 24, 24, 24, 24, 25, 25, 25, 25, 25, 25, 25, 26, 26, 26, 26, 26, 26, 26, 26, 27, 27, 27, 27, 27, 27, 27, 27, 27, 27, 28, 28, 28, 28, 28, 28, 28, 28, 28, 28, 29, 29, 29, 29, 29, 29, 29, 29, 29, 29, 29, 29, 30, 30, 30, 30, 30, 30, 30, 30, 30, 30, 30, 30, 30, 30, 31, 31, 31, 31, 31, 31, 31, 31, 31, 31, 31, 31, 31, 31, 31};

struct Frame {
    LAS unsigned char* lds;
    volatile LAS unsigned* MISC;
    gu32* ctl;
    int tid, lane, wave, vcu, G;
    const float* in[25]; float* out; unsigned char* ws;
};
__device__ __forceinline__ float wave_sum(float v) {
#pragma unroll
    for (int o = 1; o < 64; o <<= 1) v += __shfl_xor(v, o);
    return v;
}
__device__ __forceinline__ float bf2f(bf16 u) { return __uint_as_float((unsigned)u << 16); }
__device__ __forceinline__ float bflo(unsigned u) { return __uint_as_float(u << 16); }
__device__ __forceinline__ float bfhi(unsigned u) { return __uint_as_float(u & 0xffff0000u); }
__device__ __forceinline__ float sigmoidf_(float x) { return 1.0f / (1.0f + __expf(-x)); }

enum { I_X = 0, I_META, I_RELB, I_N1W, I_WIN, I_MU, I_W0, I_WDEC, I_A0, I_AUP, I_GUP, I_KK, I_KA, I_RK, I_LNW, I_LNB, I_QNW, I_KNW, I_SINK, I_WOUT, I_N2W, I_WUP, I_CONVW, I_CONVB, I_WDN };

typedef float f32x16 __attribute__((ext_vector_type(16)));
struct Op2 { bf16x8 s[2]; };
__device__ __forceinline__ f32x16 mfma32(bf16x8 a, bf16x8 b, f32x16 c) { return __builtin_amdgcn_mfma_f32_32x32x16_bf16(a, b, c, 0, 0, 0); }
__device__ __forceinline__ f32x16 zero16() { f32x16 z; for (int i = 0; i < 16; ++i) z[i] = 0.f; return z; }
typedef float f32x2_t __attribute__((ext_vector_type(2)));
typedef __bf16 bf16x2_t __attribute__((ext_vector_type(2)));
__device__ __forceinline__ unsigned cvtpk(float lo, float hi) { f32x2_t v = {lo, hi}; bf16x2_t b = __builtin_convertvector(v, bf16x2_t); return __builtin_bit_cast(unsigned, b); }
__device__ __forceinline__ bf16x8 pack8(float a0, float a1, float a2, float a3, float a4, float a5, float a6, float a7) {
    v4u u; u.x = cvtpk(a0, a1); u.y = cvtpk(a2, a3); u.z = cvtpk(a4, a5); u.w = cvtpk(a6, a7); return __builtin_bit_cast(bf16x8, u); }
__device__ __forceinline__ Op2 tile2op(const f32x16& t) { Op2 o; o.s[0] = pack8(t[0], t[1], t[2], t[3], t[4], t[5], t[6], t[7]); o.s[1] = pack8(t[8], t[9], t[10], t[11], t[12], t[13], t[14], t[15]); return o; }
__device__ __forceinline__ int opaque(int x) { asm volatile("" : "+v"(x)); return x; }
__device__ __forceinline__ int trow(int q, int hf) { return 8 * (q >> 2) + 4 * hf + (q & 3); }
__device__ __forceinline__ bf16x8 const_op(int kind, int s, int n, int hf) {
    v4u u; unsigned w[4];
#pragma unroll
    for (int p = 0; p < 4; ++p) { const int j0 = 2 * p, j1 = 2 * p + 1; const int r0 = 16 * s + 8 * (j0 >> 2) + 4 * hf + (j0 & 3), r1 = 16 * s + 8 * (j1 >> 2) + 4 * hf + (j1 & 3);
        const bool b0 = kind == 0 ? true : (kind == 1 ? r0 <= n : (kind == 2 ? r0 < n : r0 == n)), b1 = kind == 0 ? true : (kind == 1 ? r1 <= n : (kind == 2 ? r1 < n : r1 == n));
        w[p] = (b0 ? 0x3F80u : 0u) | (b1 ? 0x3F800000u : 0u); }
    u.x = w[0]; u.y = w[1]; u.z = w[2]; u.w = w[3]; return __builtin_bit_cast(bf16x8, u); }
__device__ __forceinline__ bf16x8 tri_op(int diag, int strict, int s, int n, int hf) {
    unsigned w[4];
#pragma unroll
    for (int p = 0; p < 4; ++p) { const int j0 = 2 * p, j1 = 2 * p + 1; const int r0 = 16 * s + 8 * (j0 >> 2) + 4 * hf + (j0 & 3) + strict, r1 = 16 * s + 8 * (j1 >> 2) + 4 * hf + (j1 & 3) + strict;
        const bool b0 = diag ? (r0 <= n) : true, b1 = diag ? (r1 <= n) : true; w[p] = (b0 ? 0x3F80u : 0u) | (b1 ? 0x3F800000u : 0u); }
    v4u u; u.x = w[0]; u.y = w[1]; u.z = w[2]; u.w = w[3]; return __builtin_bit_cast(bf16x8, u); }
__device__ __forceinline__ f32x4 ld_xs4(const bf16* prow, bool hasprev, int col, const float* mu) {
    const uint2 c = *(const uint2*)(prow + col); uint2 p; p.x = 0u; p.y = 0u; if (hasprev) p = *(const uint2*)(prow - INDIM + col);
    const f32x4 m = *(const f32x4*)(mu + col);
    const f32x4 cv = (f32x4){bflo(c.x), bfhi(c.x), bflo(c.y), bfhi(c.y)}, pv = (f32x4){bflo(p.x), bfhi(p.x), bflo(p.y), bfhi(p.y)};
    return cv + (pv - cv) * m; }
constexpr int NCHUNK = 129, NJOBS = BATCH * NCHUNK * 8;
constexpr size_t WS_IMG = 256 * 1024;
constexpr size_t IMG_DEC = 0, IMG_AUP = 65536, IMG_GUP = 131072;
constexpr size_t JOB16 = (size_t)NJOBS * 16384, JOB8 = (size_t)NJOBS * 8192;
static_assert(JOB16 + JOB8 + 2048ull * 6144 <= (size_t)MREAL * DM * 4 && 2 * JOB8 + (size_t)MROWS * 32 + 2048ull * 6144 <= WS_END - WS_TAIL && JOB16 <= WS_TAIL - WS_H1B && 2 * JOB8 + (size_t)MROWS * 8 * 4 <= WS_END - WS_TAIL, "chunk buffers");
__device__ __forceinline__ float* buf_YL(Frame& F) { return (float*)F.out; }
__device__ __forceinline__ bf16* buf_QC(Frame& F) { return (bf16*)((unsigned char*)F.out + JOB16); }
__device__ __forceinline__ bf16* buf_NC(Frame& F) { return (bf16*)(F.ws + WS_H1B); }
__device__ __forceinline__ bf16* buf_MC(Frame& F) { return (bf16*)(F.ws + WS_TAIL); }
__device__ __forceinline__ bf16* buf_SC(Frame& F) { return (bf16*)(F.ws + WS_TAIL + JOB8); }
__device__ __forceinline__ float* buf_BON(Frame& F) { return (float*)(F.ws + WS_TAIL + 2 * JOB8); }

__device__ __forceinline__ void build_lora_img(const float* W, int nI, bf16x8* img, int e) {
    const int lane = e & 63, s = (e >> 6) & 1, B = (e >> 7) & 1, I = (e >> 8) % nI, h = (e >> 8) / nI, n = lane & 31, hf = lane >> 5;
    float v[8];
#pragma unroll
    for (int jj = 0; jj < 8; ++jj) { const int m = 32 * I + 16 * s + 8 * (jj >> 2) + 4 * hf + (jj & 3); v[jj] = W[(size_t)m * RDIM + 64 * h + 32 * B + n]; }
    img[e] = pack8(v[0], v[1], v[2], v[3], v[4], v[5], v[6], v[7]);
}

#define PARK_ST(slot, v) (*(LAS bf16x8*)(park + (slot) * 1024 + lane * 16) = (v))
#define PARK_LD(slot) (*(const LAS bf16x8*)(park + (slot) * 1024 + lane * 16))
#define GS_ST(slot, v) (*(bf16x8*)(gscr + (slot) * 1024 + lane * 16) = (v))
#define GS_LD(slot) (*(const bf16x8*)(gscr + (slot) * 1024 + lane * 16))
#define GS2_ST(slot, v) (*(bf16x8*)(gscr2 + (slot) * 1024 + lane * 16) = (v))
#define GS2_LD(slot) (*(const bf16x8*)(gscr2 + (slot) * 1024 + lane * 16))
#define GS3_ST(slot, v) (*(bf16x8*)(gscr3 + (slot) * 1024 + lane * 16) = (v))
#define GS3_LD(slot) (*(const bf16x8*)(gscr3 + (slot) * 1024 + lane * 16))
#define GS4_ST(slot, v) (*(bf16x8*)(gscr4 + (slot) * 1024 + lane * 16) = (v))
#define GS4_LD(slot) (*(const bf16x8*)(gscr4 + (slot) * 1024 + lane * 16))
#define FENCE() do { asm volatile("" ::: "memory"); __builtin_amdgcn_sched_barrier(0); } while (0)
__device__ __forceinline__ void rwkv_chunk_local(Frame& F, int job, LAS unsigned char* park, unsigned char* gscr, unsigned char* gscr2, unsigned char* gscr3, unsigned char* gscr4) {
    int lane_ = (int)__builtin_amdgcn_mbcnt_hi(~0u, __builtin_amdgcn_mbcnt_lo(~0u, 0u)); asm volatile("" : "+v"(lane_));
    const int lane = lane_, n = lane & 31, hf = lane >> 5;
    const int h = job & 7, bc = job >> 3, c = bc % NCHUNK, b = bc / NCHUNK;
    const int pos0 = 64 * c, nvalid = (LTOK - pos0) < 64 ? (LTOK - pos0) : 64;
    const bf16* P = (const bf16*)(F.ws + WS_P) + (size_t)(b * LTOK + pos0) * INDIM;
    const float* mu = F.in[I_MU];
    const bf16x8* imgD = (const bf16x8*)(F.ws + WS_IMG + IMG_DEC) + (size_t)h * 512; const bf16x8* imgA = (const bf16x8*)(F.ws + WS_IMG + IMG_AUP) + (size_t)h * 512;
    const int hc = 64 * h;
    constexpr int SL_AK[3] = {8, 0, 6}, SL_RB[3] = {10, 2, 14}, SL_RK[3] = {12, 4, 16};
    float lamC[2];
    {
        Op2 TW[2][2];
#pragma unroll
        for (int J = 0; J < 2; ++J) { const int t = 32 * J + n; const bool live = t < nvalid; const bf16* prow = P + (size_t)(live ? t : nvalid - 1) * INDIM; const bool hp = (pos0 + t) > 0;
#pragma unroll
            for (int I = 0; I < 2; ++I)
#pragma unroll
                for (int s = 0; s < 2; ++s) { const int c0 = 1536 + 32 * I + 16 * s + 4 * hf; f32x4 x0 = ld_xs4(prow, hp, c0, mu), x1 = ld_xs4(prow, hp, c0 + 8, mu);
                    if (!live) { x0 = (f32x4){0.f, 0.f, 0.f, 0.f}; x1 = x0; }
                    TW[I][J].s[s] = pack8(tanhf(x0[0]), tanhf(x0[1]), tanhf(x0[2]), tanhf(x0[3]), tanhf(x1[0]), tanhf(x1[1]), tanhf(x1[2]), tanhf(x1[3])); FENCE(); } }
#pragma unroll
        for (int B = 0; B < 2; ++B) { lamC[B] = 0.f; const float w0 = F.in[I_W0][hc + 32 * B + n];
#pragma unroll
            for (int A = 0; A < 2; ++A) { f32x16 acc = zero16();
#pragma unroll
                for (int I = 0; I < 2; ++I)
#pragma unroll
                    for (int s = 0; s < 2; ++s) acc = mfma32(TW[I][A].s[s], imgD[((I * 2 + B) * 2 + s) * 64 + lane], acc);
#pragma unroll
                for (int q = 0; q < 16; ++q) { const int t = 32 * A + trow(q, hf); const float e = t < nvalid ? 0.60653065971f * sigmoidf_(w0 + acc[q]) : 0.f; acc[q] = e; lamC[B] += e; }
                const Op2 eo = tile2op(acc); PARK_ST((A * 2 + B) * 2, eo.s[0]); PARK_ST((A * 2 + B) * 2 + 1, eo.s[1]); FENCE(); }
            lamC[B] += __shfl_xor(lamC[B], 32); }
    }
    FENCE();
    bf16* QC = buf_QC(F) + (size_t)job * 4096; float* BON = buf_BON(F);
#pragma unroll 1
    for (int b2 = 0; b2 < 2; ++b2) {
        const int t = 32 * b2 + n; const bool live = t < nvalid; const bf16* prow = P + (size_t)(live ? t : nvalid - 1) * INDIM; const bool hp = (pos0 + t) > 0;
        Op2 ADT[2];
#pragma unroll
        for (int I = 0; I < 2; ++I)
#pragma unroll
            for (int s = 0; s < 2; ++s) { const int c0 = 1600 + 32 * I + 16 * s + 4 * hf; f32x4 x0 = ld_xs4(prow, hp, c0, mu), x1 = ld_xs4(prow, hp, c0 + 8, mu);
                if (!live) { x0 = (f32x4){0.f, 0.f, 0.f, 0.f}; x1 = x0; }
                ADT[I].s[s] = pack8(x0[0], x0[1], x0[2], x0[3], x1[0], x1[1], x1[2], x1[3]); }
        float ss = 0.f;
#pragma unroll
        for (int g8 = 0; g8 < 8; ++g8) { const int j0 = 8 * g8 + 4 * hf; const f32x4 k4 = ld_xs4(prow, hp, 512 + hc + j0, mu); const f32x4 kkw = *(const f32x4*)(F.in[I_KK] + hc + j0);
#pragma unroll
            for (int cc = 0; cc < 4; ++cc) { const float x = (live ? k4[cc] : 0.f) * kkw[cc]; ss += x * x; } }
        ss += __shfl_xor(ss, 32);
        const float inv = 1.0f / fmaxf(sqrtf(ss), 1e-12f);
        float bon = 0.f;
#pragma unroll 1
        for (int a = 0; a < 2; ++a) {
            f32x16 lam = zero16(), lamp = zero16(), alr = zero16();
#pragma unroll 1
            for (int I = 0; I <= b2; ++I) { const int kd = (I == b2) ? 1 : 0;
#pragma unroll
                for (int s = 0; s < 2; ++s) { const bf16x8 eo = PARK_LD((I * 2 + a) * 2 + s); lam = mfma32(eo, tri_op(kd, 0, s, n, hf), lam); lamp = mfma32(eo, tri_op(kd, 1, s, n, hf), lamp); } }
#pragma unroll
            for (int I = 0; I < 2; ++I)
#pragma unroll
                for (int s = 0; s < 2; ++s) alr = mfma32(imgA[((I * 2 + a) * 2 + s) * 64 + lane], ADT[I].s[s], alr);
#pragma unroll
            for (int s = 0; s < 2; ++s) { float at[8], bt[8], kt[8], rt[8];
#pragma unroll
                for (int g2 = 0; g2 < 2; ++g2) { const int g4 = 2 * s + g2, j0 = 32 * a + 8 * g4 + 4 * hf;
                    const f32x4 k4 = ld_xs4(prow, hp, 512 + hc + j0, mu), r4 = ld_xs4(prow, hp, hc + j0, mu);
                    const f32x4 kkw = *(const f32x4*)(F.in[I_KK] + hc + j0), a04 = *(const f32x4*)(F.in[I_A0] + hc + j0), ka4 = *(const f32x4*)(F.in[I_KA] + hc + j0), rk4 = *(const f32x4*)(F.in[I_RK] + hc + j0);
#pragma unroll
                    for (int cc = 0; cc < 4; ++cc) { const int q = 4 * g4 + cc, o = 4 * g2 + cc; const float k = live ? k4[cc] : 0.f, r = live ? r4[cc] : 0.f;
                        const float al = sigmoidf_(a04[cc] + alr[q]); const float kk = k * kkw[cc] * inv; const float k2 = k * (1.0f + (al - 1.0f) * ka4[cc]);
                        const float eL = __expf(lam[q]), emL = __expf(-lam[q]), emLp = __expf(-lamp[q]);
                        at[o] = -kk * emLp; bt[o] = kk * al * eL; kt[o] = k2 * eL; rt[o] = r * emL; bon += r * k2 * rk4[cc]; }
                    uint2 w; w.x = cvtpk(rt[4 * g2], rt[4 * g2 + 1]); w.y = cvtpk(rt[4 * g2 + 2], rt[4 * g2 + 3]); *(uint2*)(QC + t * 64 + j0) = w; }
                GS3_ST(a * 2 + s, pack8(at[0], at[1], at[2], at[3], at[4], at[5], at[6], at[7])); GS4_ST(a * 2 + s, pack8(rt[0], rt[1], rt[2], rt[3], rt[4], rt[5], rt[6], rt[7]));
                GS_ST((0 * 2 + b2) * 4 + a * 2 + s, pack8(bt[0], bt[1], bt[2], bt[3], bt[4], bt[5], bt[6], bt[7])); GS_ST((1 * 2 + b2) * 4 + a * 2 + s, pack8(kt[0], kt[1], kt[2], kt[3], kt[4], kt[5], kt[6], kt[7])); }
        }
        bon += __shfl_xor(bon, 32);
        if (live && hf == 0) BON[(size_t)(b * LTOK + pos0 + t) * 8 + h] = bon;
        FENCE();
#pragma unroll 1
        for (int A = 0; A <= b2; ++A) { const int ti = A + b2;
#pragma unroll 1
            for (int which = 0; which < 4; ++which) { f32x16 x = zero16(); const unsigned char* rp = (which & 2) ? gscr4 : gscr3;
#pragma unroll
                for (int I = 0; I < 2; ++I)
#pragma unroll
                    for (int s = 0; s < 2; ++s) x = mfma32(GS_LD(((which & 1) * 2 + A) * 4 + I * 2 + s), *(const bf16x8*)(rp + (I * 2 + s) * 1024 + lane * 16), x);
                const int incl = which >> 1;
#pragma unroll
                for (int q = 0; q < 16; ++q) { const int sidx = 32 * A + trow(q, hf), tidx = 32 * b2 + n; x[q] = (sidx < tidx + incl) ? x[q] : 0.f; }
                const Op2 o = tile2op(x);
                if (which == 0) { GS2_ST(8 + 2 * ti, o.s[0]); GS2_ST(8 + 2 * ti + 1, o.s[1]); }
                else { const int sl = (which == 1 ? (ti == 0 ? 8 : (ti == 1 ? 0 : 6)) : (which == 2 ? (ti == 0 ? 10 : (ti == 1 ? 2 : 14)) : (ti == 0 ? 12 : (ti == 1 ? 4 : 16)))); PARK_ST(sl, o.s[0]); PARK_ST(sl + 1, o.s[1]); } }
        }
        { f32x16 x = zero16();
#pragma unroll
            for (int I = 0; I < 2; ++I)
#pragma unroll
                for (int s = 0; s < 2; ++s) x = mfma32(GS3_LD(I * 2 + s), GS_LD((0 * 2 + b2) * 4 + I * 2 + s), x);
#pragma unroll
            for (int q = 0; q < 16; ++q) x[q] = (n < trow(q, hf)) ? x[q] : 0.f;
            const Op2 o = tile2op(x); unsigned char* dp = b2 ? gscr4 : gscr3; *(bf16x8*)(dp + 4 * 1024 + lane * 16) = o.s[0]; *(bf16x8*)(dp + 5 * 1024 + lane * 16) = o.s[1]; }
        { const bf16x8 id0 = const_op(3, 0, n, hf), id1 = const_op(3, 1, n, hf);
#pragma unroll
        for (int B = 0; B < 2; ++B) { f32x16 x = zero16(); x = mfma32(GS3_LD(B * 2), id0, x); x = mfma32(GS3_LD(B * 2 + 1), id1, x); const Op2 o = tile2op(x); GS2_ST((b2 * 2 + B) * 2, o.s[0]); GS2_ST((b2 * 2 + B) * 2 + 1, o.s[1]); } }
        FENCE();
    }
    { const bf16x8 id0 = const_op(3, 0, n, hf), id1 = const_op(3, 1, n, hf);
#pragma unroll 1
    for (int m = 0; m < 2; ++m)
#pragma unroll 1
        for (int B = 0; B < 2; ++B) { const float sc = __expf(-(B ? lamC[1] : lamC[0]));
#pragma unroll 1
            for (int A = 0; A < 2; ++A) { f32x16 y = zero16(); const int sl = (m * 2 + A) * 4 + B * 2;
                y = mfma32(GS_LD(sl), id0, y); y = mfma32(GS_LD(sl + 1), id1, y);
#pragma unroll
                for (int q = 0; q < 16; ++q) y[q] *= sc;
                const Op2 yo = tile2op(y); GS_ST(sl, yo.s[0]); GS_ST(sl + 1, yo.s[1]); } } }
    FENCE();
    Op2 TT[3];
    {
        Op2 T11;
#pragma unroll
        for (int d = 0; d < 2; ++d) {
            Op2 X, Xt; X.s[0] = d ? GS4_LD(4) : GS3_LD(4); X.s[1] = d ? GS4_LD(5) : GS3_LD(5); Xt.s[0] = GS2_LD(8 + 4 * d); Xt.s[1] = GS2_LD(8 + 4 * d + 1);
            f32x16 T, Tt;
            { const v4u x0 = __builtin_bit_cast(v4u, X.s[0]), x1 = __builtin_bit_cast(v4u, X.s[1]), y0 = __builtin_bit_cast(v4u, Xt.s[0]), y1 = __builtin_bit_cast(v4u, Xt.s[1]);
                T[0] = bflo(x0.x); T[1] = bfhi(x0.x); T[2] = bflo(x0.y); T[3] = bfhi(x0.y); T[4] = bflo(x0.z); T[5] = bfhi(x0.z); T[6] = bflo(x0.w); T[7] = bfhi(x0.w);
                T[8] = bflo(x1.x); T[9] = bfhi(x1.x); T[10] = bflo(x1.y); T[11] = bfhi(x1.y); T[12] = bflo(x1.z); T[13] = bfhi(x1.z); T[14] = bflo(x1.w); T[15] = bfhi(x1.w);
                Tt[0] = bflo(y0.x); Tt[1] = bfhi(y0.x); Tt[2] = bflo(y0.y); Tt[3] = bfhi(y0.y); Tt[4] = bflo(y0.z); Tt[5] = bfhi(y0.z); Tt[6] = bflo(y0.w); Tt[7] = bfhi(y0.w);
                Tt[8] = bflo(y1.x); Tt[9] = bfhi(y1.x); Tt[10] = bflo(y1.y); Tt[11] = bfhi(y1.y); Tt[12] = bflo(y1.z); Tt[13] = bfhi(y1.z); Tt[14] = bflo(y1.w); Tt[15] = bfhi(y1.w);
#pragma unroll
                for (int q = 0; q < 16; ++q) if (trow(q, hf) == n) { T[q] += 1.0f; Tt[q] += 1.0f; } }
#pragma unroll
            for (int it = 0; it < 4; ++it) {
                f32x16 X2 = zero16(), X2t = zero16();
                X2 = mfma32(Xt.s[0], X.s[0], X2); X2 = mfma32(Xt.s[1], X.s[1], X2);
                X2t = mfma32(X.s[0], Xt.s[0], X2t); X2t = mfma32(X.s[1], Xt.s[1], X2t);
                const Op2 X2o = tile2op(X2), X2to = tile2op(X2t), Tto = tile2op(Tt);
                T = mfma32(Tto.s[0], X2o.s[0], T); T = mfma32(Tto.s[1], X2o.s[1], T);
                Tt = mfma32(X2o.s[0], Tto.s[0], Tt); Tt = mfma32(X2o.s[1], Tto.s[1], Tt);
                X = X2o; Xt = X2to;
            }
            if (d == 0) { T11 = tile2op(T); TT[0] = tile2op(Tt); } else { TT[2] = tile2op(Tt); }
        }
        f32x16 Z = zero16(); Z = mfma32(GS2_LD(10), T11.s[0], Z); Z = mfma32(GS2_LD(11), T11.s[1], Z);
        const Op2 Zo = tile2op(Z); f32x16 T21t = zero16(); T21t = mfma32(Zo.s[0], TT[2].s[0], T21t); T21t = mfma32(Zo.s[1], TT[2].s[1], T21t);
        TT[1] = tile2op(T21t);
    }
    FENCE();
    Op2 VCL[2][2], UL[2][2], PC[2][2];
    {
        const int n_o = opaque(n), hf_o = opaque(hf); const bf16x8 id0 = const_op(3, 0, n_o, hf_o), id1 = const_op(3, 1, n_o, hf_o);
#pragma unroll
        for (int J = 0; J < 2; ++J) { const int t = 32 * J + n; const bool live = t < nvalid; const bf16* prow = P + (size_t)(live ? t : nvalid - 1) * INDIM; const bool hp = (pos0 + t) > 0;
#pragma unroll
            for (int I = 0; I < 2; ++I) { Op2 vt;
#pragma unroll
                for (int s = 0; s < 2; ++s) { const int c0 = 1024 + hc + 32 * I + 16 * s + 4 * hf; f32x4 x0 = ld_xs4(prow, hp, c0, mu), x1 = ld_xs4(prow, hp, c0 + 8, mu);
                    if (!live) { x0 = (f32x4){0.f, 0.f, 0.f, 0.f}; x1 = x0; }
                    vt.s[s] = pack8(x0[0], x0[1], x0[2], x0[3], x1[0], x1[1], x1[2], x1[3]); FENCE(); }
                f32x16 x = zero16(); x = mfma32(vt.s[0], id0, x); x = mfma32(vt.s[1], id1, x); VCL[J][I] = tile2op(x); } }
    }
    FENCE();
    {
        Op2 X1[2][2];
#pragma unroll
        for (int A = 0; A < 2; ++A)
#pragma unroll
            for (int B = 0; B < 2; ++B) { f32x16 x = zero16();
#pragma unroll
                for (int I = 0; I <= A; ++I) { const int sl = SL_AK[I + A];
#pragma unroll
                    for (int s = 0; s < 2; ++s) x = mfma32(PARK_LD(sl + s), VCL[I][B].s[s], x); }
                X1[A][B] = tile2op(x); }
#pragma unroll
        for (int A = 0; A < 2; ++A)
#pragma unroll
            for (int B = 0; B < 2; ++B) { f32x16 u = zero16(), p = zero16();
#pragma unroll
                for (int I = 0; I <= A; ++I) { const int ti = I + A;
#pragma unroll
                    for (int s = 0; s < 2; ++s) { u = mfma32(TT[ti].s[s], X1[I][B].s[s], u); p = mfma32(TT[ti].s[s], GS2_LD((I * 2 + B) * 2 + s), p); } }
                UL[A][B] = tile2op(u); PC[A][B] = tile2op(p); }
    }
    FENCE();
    float* YL = buf_YL(F) + (size_t)job * 4096; bf16* NC = buf_NC(F) + (size_t)job * 4096; bf16* MC = buf_MC(F) + (size_t)job * 4096;
#pragma unroll
    for (int B = 0; B < 2; ++B) { const int t = 32 * B + n;
#pragma unroll
        for (int A = 0; A < 2; ++A) {
            f32x16 qt, yt = zero16();
#pragma unroll
            for (int g4 = 0; g4 < 4; ++g4) { const uint2 w = *(const uint2*)(QC + t * 64 + 32 * A + 8 * g4 + 4 * hf); qt[4 * g4] = bflo(w.x); qt[4 * g4 + 1] = bfhi(w.x); qt[4 * g4 + 2] = bflo(w.y); qt[4 * g4 + 3] = bfhi(w.y); }
#pragma unroll
            for (int I = 0; I <= B; ++I) { const int ti = I + B;
#pragma unroll
                for (int s = 0; s < 2; ++s) { const bf16x8 rb = PARK_LD(SL_RB[ti] + s), rk = PARK_LD(SL_RK[ti] + s);
                    qt = mfma32(PC[I][A].s[s], rb, qt); yt = mfma32(UL[I][A].s[s], rb, yt); yt = mfma32(VCL[I][A].s[s], rk, yt); } }
#pragma unroll
            for (int g4 = 0; g4 < 4; ++g4) { uint2 w; w.x = cvtpk(qt[4 * g4], qt[4 * g4 + 1]); w.y = cvtpk(qt[4 * g4 + 2], qt[4 * g4 + 3]); *(uint2*)(QC + t * 64 + 32 * A + 8 * g4 + 4 * hf) = w;
                *(f32x4*)(YL + t * 64 + 32 * A + 8 * g4 + 4 * hf) = (f32x4){yt[4 * g4], yt[4 * g4 + 1], yt[4 * g4 + 2], yt[4 * g4 + 3]}; } } }
    FENCE();
#pragma unroll
    for (int B = 0; B < 2; ++B) { const float dg = __expf(-lamC[B]);
#pragma unroll
        for (int A = 0; A < 2; ++A) { f32x16 mt = zero16(), nn = zero16();
#pragma unroll
            for (int I = 0; I < 2; ++I)
#pragma unroll
                for (int s = 0; s < 2; ++s) { mt = mfma32(PC[I][A].s[s], GS_LD((0 * 2 + I) * 4 + B * 2 + s), mt); nn = mfma32(GS_LD((0 * 2 + I) * 4 + A * 2 + s), UL[I][B].s[s], nn); nn = mfma32(GS_LD((1 * 2 + I) * 4 + A * 2 + s), VCL[I][B].s[s], nn); }
            if (A == B) {
#pragma unroll
                for (int q = 0; q < 16; ++q) if (trow(q, hf) == n) mt[q] += dg; }
#pragma unroll
            for (int g4 = 0; g4 < 4; ++g4) { uint2 w; w.x = cvtpk(mt[4 * g4], mt[4 * g4 + 1]); w.y = cvtpk(mt[4 * g4 + 2], mt[4 * g4 + 3]);
                *(uint2*)(MC + (32 * B + n) * 64 + 32 * A + 8 * g4 + 4 * hf) = w;
                { uint2 wn; wn.x = cvtpk(nn[4 * g4], nn[4 * g4 + 1]); wn.y = cvtpk(nn[4 * g4 + 2], nn[4 * g4 + 3]); *(uint2*)(NC + (32 * B + n) * 64 + 32 * A + 8 * g4 + 4 * hf) = wn; } }
            FENCE(); } }
}

struct ScanBuf { uint2 m[4][2][2]; uint2 nb[4]; };
__device__ __forceinline__ void scan_load(ScanBuf& B, const bf16* MC, const bf16* NC, size_t jo, int v, int vv, int g) {
#pragma unroll
    for (int r = 0; r < 4; ++r) { B.nb[r] = *(const uint2*)(NC + jo + v * 64 + 16 * r + 4 * g);
#pragma unroll
        for (int kk = 0; kk < 2; ++kk) { B.m[r][kk][0] = *(const uint2*)(MC + jo + (16 * r + vv) * 64 + 32 * kk + 4 * g); B.m[r][kk][1] = *(const uint2*)(MC + jo + (16 * r + vv) * 64 + 32 * kk + 16 + 4 * g); } }
}
__device__ __forceinline__ void scan_step(f32x4 (&S)[4], const ScanBuf& B, bf16* SC, size_t jo, int v, int g) {
    uint2 sb[4];
#pragma unroll
    for (int r = 0; r < 4; ++r) { sb[r].x = cvtpk(S[r][0], S[r][1]); sb[r].y = cvtpk(S[r][2], S[r][3]); *(uint2*)(SC + jo + v * 64 + 16 * r + 4 * g) = sb[r]; }
    bf16x8 Bop[2];
#pragma unroll
    for (int kk = 0; kk < 2; ++kk) { v4u u; u.x = sb[2 * kk].x; u.y = sb[2 * kk].y; u.z = sb[2 * kk + 1].x; u.w = sb[2 * kk + 1].y; Bop[kk] = __builtin_bit_cast(bf16x8, u); }
#pragma unroll
    for (int r = 0; r < 4; ++r) { f32x4 acc = (f32x4){bflo(B.nb[r].x), bfhi(B.nb[r].x), bflo(B.nb[r].y), bfhi(B.nb[r].y)};
#pragma unroll
        for (int kk = 0; kk < 2; ++kk) { v4u u; u.x = B.m[r][kk][0].x; u.y = B.m[r][kk][0].y; u.z = B.m[r][kk][1].x; u.w = B.m[r][kk][1].y;
            acc = __builtin_amdgcn_mfma_f32_16x16x32_bf16(__builtin_bit_cast(bf16x8, u), Bop[kk], acc, 0, 0, 0); }
        S[r] = acc; }
}
__device__ __forceinline__ void rwkv_scan(Frame& F, int sj) {
    int lane_ = (int)__builtin_amdgcn_mbcnt_hi(~0u, __builtin_amdgcn_mbcnt_lo(~0u, 0u)); asm volatile("" : "+v"(lane_));
    const int lane = lane_, vv = lane & 15, g = lane >> 4, bh = sj >> 2, vg = sj & 3, b = bh >> 3, h = bh & 7, v = 16 * vg + vv;
    const bf16* MC = buf_MC(F); const bf16* NC = buf_NC(F); bf16* SC = buf_SC(F);
    f32x4 S[4];
#pragma unroll
    for (int r = 0; r < 4; ++r) S[r] = (f32x4){0.f, 0.f, 0.f, 0.f};
    const size_t j0 = (size_t)((b * NCHUNK) * 8 + h) * 4096, jstep = (size_t)8 * 4096;
    ScanBuf B0, B1, B2, B3;
    scan_load(B0, MC, NC, j0, v, vv, g); scan_load(B1, MC, NC, j0 + jstep, v, vv, g); scan_load(B2, MC, NC, j0 + 2 * jstep, v, vv, g); scan_load(B3, MC, NC, j0 + 3 * jstep, v, vv, g);
#pragma unroll 1
    for (int c = 0; c < 128; c += 4) {
        const size_t jc = j0 + (size_t)c * jstep; const int c4 = c + 4 < 128 ? c + 4 : 124;
        const size_t jn = j0 + (size_t)c4 * jstep;
        scan_step(S, B0, SC, jc, v, g);             scan_load(B0, MC, NC, jn, v, vv, g);
        scan_step(S, B1, SC, jc + jstep, v, g);     scan_load(B1, MC, NC, jn + jstep, v, vv, g);
        scan_step(S, B2, SC, jc + 2 * jstep, v, g); scan_load(B2, MC, NC, jn + 2 * jstep, v, vv, g);
        scan_step(S, B3, SC, jc + 3 * jstep, v, g); scan_load(B3, MC, NC, jn + 3 * jstep, v, vv, g);
    }
    { const size_t jl = j0 + (size_t)128 * jstep;
#pragma unroll
        for (int r = 0; r < 4; ++r) { uint2 w; w.x = cvtpk(S[r][0], S[r][1]); w.y = cvtpk(S[r][2], S[r][3]); *(uint2*)(SC + jl + v * 64 + 16 * r + 4 * g) = w; } }
}

__device__ __forceinline__ void rwkv_output(Frame& F, int job, int nB) {
    int lane_ = (int)__builtin_amdgcn_mbcnt_hi(~0u, __builtin_amdgcn_mbcnt_lo(~0u, 0u)); asm volatile("" : "+v"(lane_));
    const int lane = lane_, n = lane & 31, hf = lane >> 5;
    const int h = job & 7, bc = job >> 3, c = bc % NCHUNK, b = bc / NCHUNK, hc = 64 * h;
    const int pos0 = 64 * c, nvalid = (LTOK - pos0) < 64 ? (LTOK - pos0) : 64;
    const bf16* P = (const bf16*)(F.ws + WS_P) + (size_t)(b * LTOK + pos0) * INDIM; const float* mu = F.in[I_MU];
    const bf16* QC = buf_QC(F) + (size_t)job * 4096; const bf16* SC = buf_SC(F) + (size_t)job * 4096; const float* YL = buf_YL(F) + (size_t)job * 4096; const float* BON = buf_BON(F);
    const bf16x8* imgG = (const bf16x8*)(F.ws + WS_IMG + IMG_GUP) + (size_t)h * 1024;
    bf16* YMIX = (bf16*)(F.ws + WS_YMIX);
#pragma unroll 1
    for (int B = 0; B < nB; ++B) {
        const int t = 32 * B + n; const bool live = t < nvalid; const bf16* prow = P + (size_t)(live ? t : nvalid - 1) * INDIM; const bool hp = (pos0 + t) > 0;
        Op2 SG[4];
#pragma unroll
        for (int I = 0; I < 4; ++I)
#pragma unroll
            for (int s = 0; s < 2; ++s) { const int c0 = 1664 + 32 * I + 16 * s + 4 * hf; const f32x4 x0 = ld_xs4(prow, hp, c0, mu), x1 = ld_xs4(prow, hp, c0 + 8, mu);
                SG[I].s[s] = pack8(sigmoidf_(x0[0]), sigmoidf_(x0[1]), sigmoidf_(x0[2]), sigmoidf_(x0[3]), sigmoidf_(x1[0]), sigmoidf_(x1[1]), sigmoidf_(x1[2]), sigmoidf_(x1[3])); }
        bf16x8 qb[4];
#pragma unroll
        for (int ks = 0; ks < 4; ++ks) qb[ks] = *(const bf16x8*)(QC + t * 64 + 16 * ks + 8 * hf);
        f32x16 y[2], gt[2]; float sum = 0.f;
#pragma unroll
        for (int A = 0; A < 2; ++A) {
#pragma unroll
            for (int g4 = 0; g4 < 4; ++g4) { const f32x4 w = *(const f32x4*)(YL + t * 64 + 32 * A + 8 * g4 + 4 * hf); y[A][4 * g4] = w[0]; y[A][4 * g4 + 1] = w[1]; y[A][4 * g4 + 2] = w[2]; y[A][4 * g4 + 3] = w[3]; }
#pragma unroll
            for (int ks = 0; ks < 4; ++ks) y[A] = mfma32(*(const bf16x8*)(SC + (32 * A + n) * 64 + 16 * ks + 8 * hf), qb[ks], y[A]);
            gt[A] = zero16();
#pragma unroll
            for (int I = 0; I < 4; ++I)
#pragma unroll
                for (int s = 0; s < 2; ++s) gt[A] = mfma32(imgG[((I * 2 + A) * 2 + s) * 64 + lane], SG[I].s[s], gt[A]);
#pragma unroll
            for (int q = 0; q < 16; ++q) sum += y[A][q]; }
        sum += __shfl_xor(sum, 32); const float mean = sum * (1.0f / 64.0f); float sq = 0.f;
#pragma unroll
        for (int A = 0; A < 2; ++A)
#pragma unroll
            for (int q = 0; q < 16; ++q) { const float d = y[A][q] - mean; sq += d * d; }
        sq += __shfl_xor(sq, 32); const float rstd = 1.0f / sqrtf(sq * (1.0f / 64.0f) + 64e-5f);
        const float bon = BON[(size_t)(b * LTOK + pos0 + (live ? t : nvalid - 1)) * 8 + h];
#pragma unroll
        for (int A = 0; A < 2; ++A)
#pragma unroll
            for (int g4 = 0; g4 < 4; ++g4) { const int i0 = 32 * A + 8 * g4 + 4 * hf; const f32x4 v4 = ld_xs4(prow, hp, 1024 + hc + i0, mu);
                const f32x4 lw = *(const f32x4*)(F.in[I_LNW] + hc + i0), lb = *(const f32x4*)(F.in[I_LNB] + hc + i0); float o[4];
#pragma unroll
                for (int cc = 0; cc < 4; ++cc) { const int q = 4 * g4 + cc; o[cc] = ((y[A][q] - mean) * rstd * lw[cc] + lb[cc] + bon * v4[cc]) * gt[A][q]; }
                if (live) { uint2 w; w.x = cvtpk(o[0], o[1]); w.y = cvtpk(o[2], o[3]); *(uint2*)(YMIX + (size_t)(b * LTOK + pos0 + t) * DM + hc + i0) = w; } }
    }
}

__device__ __forceinline__ void p0_transpose_item(const float* W, int K, int N, bf16* WT, const float* ksc, int mode, LAS float* scr, int item, int lane) {
    const int nblk = N / 32, kb = item / nblk, nb = item % nblk, k0 = 64 * kb, n0 = 32 * nb;
#pragma unroll 8
    for (int i = 0; i < 32; ++i) { const int kk = 2 * i + (lane >> 5); float w = W[(size_t)(k0 + kk) * N + n0 + (lane & 31)]; if (ksc) w *= ksc[k0 + kk]; scr[kk * 33 + (lane & 31)] = w; }
    LDS_WAIT(); asm volatile("" ::: "memory");
    int d0 = n0;
    if (mode == 1) d0 = n0 < DFF ? (n0 / 128) * 256 + (n0 % 128) : ((n0 - DFF) / 128) * 256 + 128 + ((n0 - DFF) % 128);
    const int c = lane & 7;
#pragma unroll
    for (int j = 0; j < 4; ++j) { const int n = (lane >> 3) + 8 * j; const LAS float* s = scr + (8 * c) * 33 + n;
        v4u o; o.x = pk2(s[0 * 33], s[1 * 33]); o.y = pk2(s[2 * 33], s[3 * 33]); o.z = pk2(s[4 * 33], s[5 * 33]); o.w = pk2(s[6 * 33], s[7 * 33]);
        *(GAS v4u*)(WT + (size_t)(d0 + n) * K + k0 + 8 * c) = o; }
    LDS_WAIT(); asm volatile("" ::: "memory");
}
__device__ __forceinline__ void p0_prologue(Frame& F) {
    LAS float* scr = (LAS float*)(F.lds + RING_OFF + F.wave * 16384);
    const int gw = F.vcu * NWAVES + F.wave, NGW = F.G * NWAVES;
    constexpr int I_1 = (DM / 64) * (INDIM / 32), I_2 = (DM / 64) * (DM / 32), I_3 = (DM / 64) * (2 * DFF / 32), I_4 = (DFF / 64) * (DM / 32);
    constexpr int NITEMS = I_1 + I_2 + I_3 + I_4;
    for (int it = gw; it < NITEMS; it += NGW) {
        int r = it;
        if (r < I_1) { p0_transpose_item(F.in[I_WIN], DM, INDIM, (bf16*)(F.ws + WS_WIN), F.in[I_N1W], 0, scr, r, F.lane); continue; } r -= I_1;
        if (r < I_2) { p0_transpose_item(F.in[I_WOUT], DM, DM, (bf16*)(F.ws + WS_WOUT), nullptr, 0, scr, r, F.lane); continue; } r -= I_2;
        if (r < I_3) { p0_transpose_item(F.in[I_WUP], DM, 2 * DFF, (bf16*)(F.ws + WS_WUP), F.in[I_N2W], 1, scr, r, F.lane); continue; } r -= I_3;
        p0_transpose_item(F.in[I_WDN], DFF, DM, (bf16*)(F.ws + WS_WDN), nullptr, 0, scr, r, F.lane);
    }
    { bf16x8* imgD = (bf16x8*)(F.ws + WS_IMG + IMG_DEC); bf16x8* imgA = (bf16x8*)(F.ws + WS_IMG + IMG_AUP); bf16x8* imgG = (bf16x8*)(F.ws + WS_IMG + IMG_GUP);
      for (int e = (F.vcu * NWAVES + F.wave) * 64 + F.lane; e < 16384; e += F.G * NWAVES * 64) {
          if (e < 4096) build_lora_img(F.in[I_WDEC], 2, imgD, e); else if (e < 8192) build_lora_img(F.in[I_AUP], 2, imgA, e - 4096); else build_lora_img(F.in[I_GUP], 4, imgG, e - 8192); } }
    bf16* XN = (bf16*)(F.ws + WS_XN);
    for (int R = gw; R < MPAD; R += NGW) {
        GAS unsigned long long* o8 = (GAS unsigned long long*)(XN + (size_t)R * DM) + F.lane;
        if (R >= MROWS) {
#pragma unroll
            for (int j = 0; j < 4; ++j) o8[64 * j] = 0ull;
            continue; }
        const int b = R / LTOK, pos = R % LTOK;
        const float* src = pos < NMETA ? F.in[I_META] + (size_t)pos * DM : F.in[I_X] + ((size_t)b * SEQ + pos - NMETA) * DM;
        const GAS f32x4* xr = (const GAS f32x4*)src + F.lane;
        f32x4 v[4]; float s = 0.f;
#pragma unroll
        for (int j = 0; j < 4; ++j) { v[j] = xr[64 * j]; s += (v[j].x * v[j].x + v[j].y * v[j].y) + (v[j].z * v[j].z + v[j].w * v[j].w); }
        const float rs = 1.0f / sqrtf(wave_sum(s) * (1.0f / DM) + 1e-6f);
#pragma unroll
        for (int j = 0; j < 4; ++j) o8[64 * j] = (unsigned long long)pk2(v[j].x * rs, v[j].y * rs) | ((unsigned long long)pk2(v[j].z * rs, v[j].w * rs) << 32);
    }
}

constexpr int LPADV = 8384;
constexpr size_t WS_VT = WS_WIN;
static_assert(2ull * 2 * 64 * LPADV * 2 <= WS_WOUT - WS_WIN, "VT fits the dead in-proj copy");
constexpr int BIAS_LD = 132;
__device__ __forceinline__ void attn_build_bias(Frame& F, LAS float* biasT) {
    for (int e = F.tid; e < 8 * 129; e += NWAVES * 64) { const int h = e / 129, d = e % 129; biasT[h * BIAS_LD + d] = F.in[I_RELB][(d < 128 ? (int)c_bucket[d] : 31) * 8 + h]; }
}
__device__ __forceinline__ void kv_prep(Frame& F) {
    const int lane = F.lane, gw = F.vcu * NWAVES + F.wave, NGW = F.G * NWAVES;
    const bf16* P = (const bf16*)(F.ws + WS_P); bf16* KN = (bf16*)(F.ws + WS_KN); bf16* VT = (bf16*)(F.ws + WS_VT);
    for (int R = gw; R < MROWS; R += NGW)
#pragma unroll
        for (int hk = 0; hk < 2; ++hk) { const float k = bf2f(P[(size_t)R * INDIM + KOFF + 64 * hk + lane]); const float ss = wave_sum(k * k);
            KN[(size_t)R * 128 + 64 * hk + lane] = (bf16)f2bf(k * (1.0f / sqrtf(ss * (1.0f / 64.0f) + 1e-6f)) * F.in[I_KNW][lane]); }
    constexpr int NPB = LPADV / 64;
    for (int it = gw; it < BATCH * 2 * NPB; it += NGW) { const int pb = it % NPB, bg = it / NPB, b = bg >> 1, g = bg & 1; const int slot = 64 * pb + lane, pos = slot - 128;
        v4u v[8];
        if (pos >= 0 && pos < LTOK) { const v4u* vp = (const v4u*)(P + (size_t)(b * LTOK + pos) * INDIM + VOFF + 64 * g);
#pragma unroll
            for (int c8 = 0; c8 < 8; ++c8) v[c8] = vp[c8]; }
        else {
#pragma unroll
            for (int c8 = 0; c8 < 8; ++c8) v[c8] = (v4u){0u, 0u, 0u, 0u}; }
        bf16* o = VT + (size_t)(bg * 64) * LPADV + slot;
#pragma unroll
        for (int c8 = 0; c8 < 8; ++c8) { o[(size_t)(8 * c8 + 0) * LPADV] = (bf16)(v[c8].x & 0xffffu); o[(size_t)(8 * c8 + 1) * LPADV] = (bf16)(v[c8].x >> 16); o[(size_t)(8 * c8 + 2) * LPADV] = (bf16)(v[c8].y & 0xffffu); o[(size_t)(8 * c8 + 3) * LPADV] = (bf16)(v[c8].y >> 16);
            o[(size_t)(8 * c8 + 4) * LPADV] = (bf16)(v[c8].z & 0xffffu); o[(size_t)(8 * c8 + 5) * LPADV] = (bf16)(v[c8].z >> 16); o[(size_t)(8 * c8 + 6) * LPADV] = (bf16)(v[c8].w & 0xffffu); o[(size_t)(8 * c8 + 7) * LPADV] = (bf16)(v[c8].w >> 16); } }
}
constexpr int NQB = (LTOK + 31) / 32, NATT = BATCH * NQB * 8;
__device__ __forceinline__ void attn_unit(Frame& F, int unit, const LAS float* biasT) {
    int lane_ = (int)__builtin_amdgcn_mbcnt_hi(~0u, __builtin_amdgcn_mbcnt_lo(~0u, 0u)); asm volatile("" : "+v"(lane_));
    const int lane = lane_, n = lane & 31, hf = lane >> 5;
    const int gi = unit & 3, g = (unit >> 2) & 1, bq = unit >> 3, qb = bq % NQB, b = bq / NQB, hq = 4 * g + gi;
    const int q0 = 32 * qb, qpos = q0 + n; const bool live = qpos < LTOK;
    const bf16* P = (const bf16*)(F.ws + WS_P); const bf16* KN = (const bf16*)(F.ws + WS_KN) + (size_t)b * LTOK * 128 + 64 * g; const bf16* VT = (const bf16*)(F.ws + WS_VT) + (size_t)((b * 2 + g) * 64) * LPADV + 128;
    bf16x8 qop[4];
    { const bf16* qrow = P + (size_t)(b * LTOK + (live ? qpos : LTOK - 1)) * INDIM + QOFF + 64 * hq; float qv[4][8]; float ss = 0.f;
#pragma unroll
        for (int ks = 0; ks < 4; ++ks) { const v4u u = *(const v4u*)(qrow + 16 * ks + 8 * hf); qv[ks][0] = bflo(u.x); qv[ks][1] = bfhi(u.x); qv[ks][2] = bflo(u.y); qv[ks][3] = bfhi(u.y); qv[ks][4] = bflo(u.z); qv[ks][5] = bfhi(u.z); qv[ks][6] = bflo(u.w); qv[ks][7] = bfhi(u.w);
#pragma unroll
            for (int j = 0; j < 8; ++j) ss += qv[ks][j] * qv[ks][j]; }
        ss += __shfl_xor(ss, 32); const float rs = 0.125f / sqrtf(ss * (1.0f / 64.0f) + 1e-6f);
#pragma unroll
        for (int ks = 0; ks < 4; ++ks) { const f32x4 w0 = *(const f32x4*)(F.in[I_QNW] + 16 * ks + 8 * hf), w1 = *(const f32x4*)(F.in[I_QNW] + 16 * ks + 8 * hf + 4);
            qop[ks] = pack8(qv[ks][0] * rs * w0[0], qv[ks][1] * rs * w0[1], qv[ks][2] * rs * w0[2], qv[ks][3] * rs * w0[3], qv[ks][4] * rs * w1[0], qv[ks][5] * rs * w1[1], qv[ks][6] * rs * w1[2], qv[ks][7] * rs * w1[3]); } }
    f32x16 S[6]; const float sink = F.in[I_SINK][hq]; float mx = sink;
    const LAS float* bt = biasT + hq * BIAS_LD;
#pragma unroll
    for (int kt = 0; kt < 6; ++kt) { const int kp0 = kt < 5 ? q0 - 128 + 32 * kt : 0; int kl = kp0 + n; kl = kl < 0 ? 0 : (kl > LTOK - 1 ? LTOK - 1 : kl);
        const bf16* krow = KN + (size_t)kl * 128; f32x16 acc = zero16();
#pragma unroll
        for (int ks = 0; ks < 4; ++ks) acc = mfma32(*(const bf16x8*)(krow + 16 * ks + 8 * hf), qop[ks], acc);
#pragma unroll
        for (int q = 0; q < 16; ++q) { const int kr = trow(q, hf), kpos = kp0 + kr, d = qpos - kpos;
            const bool valid = kt < 5 ? (kpos >= NMETA && d >= 0 && d < 128) : (kr < NMETA && d >= 0);
            const int di = d < 0 ? 0 : (d > 128 ? 128 : d);
            const float sv = valid ? acc[q] + bt[di] : -1e30f; acc[q] = sv; mx = fmaxf(mx, sv); }
        S[kt] = acc; }
    mx = fmaxf(mx, __shfl_xor(mx, 32));
    float sum = 0.f; Op2 Pop[6];
#pragma unroll
    for (int kt = 0; kt < 6; ++kt) { f32x16 p;
#pragma unroll
        for (int q = 0; q < 16; ++q) { p[q] = __expf(S[kt][q] - mx); sum += p[q]; }
        Pop[kt] = tile2op(p); }
    sum += __shfl_xor(sum, 32); sum += __expf(sink - mx);
    const float il = 1.0f / sum;
    bf16* orow = (bf16*)(F.ws + WS_YMIX) + (size_t)(b * LTOK + qpos) * DM + 512 + 64 * hq;
#pragma unroll
    for (int db = 0; db < 2; ++db) { f32x16 o = zero16(); const bf16* vrow = VT + (size_t)(32 * db + n) * LPADV;
#pragma unroll
        for (int kt = 0; kt < 6; ++kt) { const int kp0 = kt < 5 ? q0 - 128 + 32 * kt : 0;
#pragma unroll
            for (int s = 0; s < 2; ++s) { const uint2 v0 = *(const uint2*)(vrow + kp0 + 16 * s + 4 * hf), v1 = *(const uint2*)(vrow + kp0 + 16 * s + 8 + 4 * hf);
                v4u u; u.x = v0.x; u.y = v0.y; u.z = v1.x; u.w = v1.y; o = mfma32(__builtin_bit_cast(bf16x8, u), Pop[kt].s[s], o); } }
        if (live) {
#pragma unroll
            for (int g4 = 0; g4 < 4; ++g4) { uint2 w; w.x = cvtpk(o[4 * g4] * il, o[4 * g4 + 1] * il); w.y = cvtpk(o[4 * g4 + 2] * il, o[4 * g4 + 3] * il); *(uint2*)(orow + 32 * db + 8 * g4 + 4 * hf) = w; } } }
}

__device__ __forceinline__ void p5_meta_rows(Frame& F, int blk) {
    const int lane = F.lane, wave = F.wave;
    LAS float* red = (LAS float*)(F.lds + RING_OFF);
    const bf16* YMIX = (const bf16*)(F.ws + WS_YMIX); const bf16* WT = (const bf16*)(F.ws + WS_WOUT); bf16* H1B = (bf16*)(F.ws + WS_H1B); float* SSQP = (float*)(F.ws + WS_SSQP);
    float y0[16], y1[16];
    { const v4u a0 = *(const v4u*)(YMIX + (size_t)14 * DM + 16 * lane), a1 = *(const v4u*)(YMIX + (size_t)14 * DM + 16 * lane + 8), b0 = *(const v4u*)(YMIX + (size_t)15 * DM + 16 * lane), b1 = *(const v4u*)(YMIX + (size_t)15 * DM + 16 * lane + 8);
        const unsigned ua[8] = {a0.x, a0.y, a0.z, a0.w, a1.x, a1.y, a1.z, a1.w}, ub[8] = {b0.x, b0.y, b0.z, b0.w, b1.x, b1.y, b1.z, b1.w};
#pragma unroll
        for (int p = 0; p < 8; ++p) { y0[2 * p] = bflo(ua[p]); y0[2 * p + 1] = bfhi(ua[p]); y1[2 * p] = bflo(ub[p]); y1[2 * p + 1] = bfhi(ub[p]); } }
    float q0 = 0.f, q1 = 0.f;
#pragma unroll 1
    for (int cc = 0; cc < 8; ++cc) { const int col = 64 * blk + 8 * wave + cc;
        const v4u w0 = *(const v4u*)(WT + (size_t)col * DM + 16 * lane), w1 = *(const v4u*)(WT + (size_t)col * DM + 16 * lane + 8);
        const unsigned uw[8] = {w0.x, w0.y, w0.z, w0.w, w1.x, w1.y, w1.z, w1.w}; float s0 = 0.f, s1 = 0.f;
#pragma unroll
        for (int p = 0; p < 8; ++p) { const float wl = bflo(uw[p]), wh = bfhi(uw[p]); s0 += wl * y0[2 * p] + wh * y0[2 * p + 1]; s1 += wl * y1[2 * p] + wh * y1[2 * p + 1]; }
        s0 = wave_sum(s0); s1 = wave_sum(s1);
        const float h0 = F.in[I_META][(size_t)14 * DM + col] + s0, h1 = F.in[I_META][(size_t)15 * DM + col] + s1; q0 += h0 * h0; q1 += h1 * h1;
        if (lane == 0) { const bf16 b0 = (bf16)f2bf(h0), b1 = (bf16)f2bf(h1);
            H1B[(size_t)14 * DM + col] = b0; H1B[(size_t)15 * DM + col] = b1; H1B[(size_t)(LTOK + 14) * DM + col] = b0; H1B[(size_t)(LTOK + 15) * DM + col] = b1; } }
    if (lane == 0) { red[2 * wave] = q0; red[2 * wave + 1] = q1; }
    __syncthreads();
    if (F.tid < 2) { float t = 0.f; for (int w = 0; w < NWAVES; ++w) t += red[2 * w + F.tid]; SSQP[(size_t)blk * MPAD + 14 + F.tid] = t; SSQP[(size_t)blk * MPAD + LTOK + 14 + F.tid] = t; }
    __syncthreads();
}

#ifndef MK_N_LAUNCHES
#define MK_N_LAUNCHES 1
#endif
constexpr int N_LAUNCHES = MK_N_LAUNCHES;
constexpr int PER_PHASE = 8;
#ifndef PROBE_DUP
#define PROBE_DUP -1
#endif
#ifndef PROBE_T
#define PROBE_T -1
#endif
#define REP(k) for (int rep_ = 0; rep_ < ((PROBE_DUP == (k)) ? 2 : 1); ++rep_)
struct Args { const float* in[25]; float* out; unsigned char* ws; int ph_lo, ph_hi; };
__global__ void __launch_bounds__(NWAVES * 64, 2) hymba_fwd(Args args) {
    extern __shared__ __attribute__((aligned(16))) unsigned char lds[];
    Frame F;
    F.lds = (LAS unsigned char*)lds;
    F.MISC = (volatile LAS unsigned*)(F.lds + MISC_OFF);
    F.tid = threadIdx.x; F.lane = F.tid & 63; F.wave = __builtin_amdgcn_readfirstlane(F.tid >> 6);
    F.G = gridDim.x; { const int bx = blockIdx.x; F.vcu = (F.G % 8 == 0) ? (bx % 8) * (F.G / 8) + bx / 8 : bx; }
    F.ws = args.ws; F.out = args.out; F.ctl = (gu32*)(args.ws + WS_CTL);
#pragma unroll
    for (int i = 0; i < 25; ++i) F.in[i] = args.in[i];
    for (int u = F.tid; u < (LDS_BYTES - LDSCTL_OFF) / 4; u += NWAVES * 64) ((LAS unsigned*)(F.lds + LDSCTL_OFF))[u] = 0u;
    __syncthreads();
    XcdBarrier bar; bar.bar = (unsigned*)(F.ctl + CW_BAR); bar.x = 0; bar.st = nullptr;
    if (N_LAUNCHES == 1) bar = xcd_barrier_post((unsigned*)(F.ctl + CW_BAR), F.MISC + 8);
    const int lo = args.ph_lo, hi = args.ph_hi;
#define IN(k) (lo <= (k) && (k) < hi)
    unsigned long long tp0_ = 0ull, tp1_ = 0ull;
#define TSTART(k) do { if (PROBE_T == (k)) tp0_ = __builtin_amdgcn_s_memrealtime(); } while (0)
#define TEND(k) do { if (PROBE_T == (k)) tp1_ = __builtin_amdgcn_s_memrealtime(); } while (0)
#define SEAM(k) do { if (IN(k) && IN((k) + 1)) xcd_barrier(bar); } while (0)
    bf16* XN = (bf16*)(F.ws + WS_XN); bf16* PB = (bf16*)(F.ws + WS_P); bf16* YMIX = (bf16*)(F.ws + WS_YMIX); bf16* H1B = (bf16*)(F.ws + WS_H1B); bf16* ACT = (bf16*)(F.ws + WS_ACT);
    float* SSQP = (float*)(F.ws + WS_SSQP);

    TSTART(0);
    if (IN(0)) { REP(0) p0_prologue(F); SEAM(0); }
    TEND(0);
    TSTART(1);
    if (IN(1)) {
        pg8::Gemm g{XN, (const bf16*)(F.ws + WS_WIN), MPAD, INDIM, DM}; pg8::StaticOrderT<0> S; S.init(MPAD, INDIM, F.G, (int)blockIdx.x);
        pg8::EpiBf16 E{PB, INDIM};
        pg8::gemm_phase<pg8::EpiBf16, pg8::StaticOrderT<0>, true, true>(F.lds + RING_OFF, g, S, E);
#if PROBE_DUP == 1
        __syncthreads();
        pg8::gemm_phase<pg8::EpiBf16, pg8::StaticOrderT<0>, true, true>(F.lds + RING_OFF, g, S, E);
#endif
        SEAM(1);
    }
    TEND(1);
    TSTART(2);
    if (IN(2)) {
        LAS unsigned char* park = F.lds + F.wave * 18432;
        const int gw = F.vcu * NWAVES + F.wave, NGW = F.G * NWAVES;
        REP(2)
#pragma unroll 1
        for (int w = gw; w < 2048; w += NGW) rwkv_chunk_local(F, (((w >> 10) * NCHUNK + ((w >> 3) & 127)) * 8) + (w & 7), park, F.ws + WS_XN + (size_t)gw * 16384, F.ws + WS_YMIX + (size_t)gw * 16384, (unsigned char*)F.out + JOB16 + JOB8 + (size_t)gw * 6144, F.ws + WS_TAIL + 2 * JOB8 + (size_t)MROWS * 32 + (size_t)gw * 6144);
        REP(8) kv_prep(F);
        SEAM(2);
    }
    TEND(2);
    TSTART(3);
    if (IN(3)) {
        const int blk = (int)blockIdx.x;
        LAS float* biasT = (LAS float*)(F.lds + HALO_OFF);
        attn_build_bias(F, biasT);
        __syncthreads();
        REP(3) { if (blk < 64 && F.wave == 0) rwkv_scan(F, blk);
        else { const int w0 = blk < 64 ? blk * 7 + F.wave - 1 : 448 + (blk - 64) * 8 + F.wave, nw = 448 + (F.G - 64) * 8;
            if (blk >= 64 && blk < 80 && F.wave == 0) { const int tj = blk - 64, gwt = F.vcu * NWAVES;
                rwkv_chunk_local(F, (((tj >> 3) * NCHUNK + 128) * 8) + (tj & 7), F.lds, F.ws + WS_XN + (size_t)gwt * 16384, F.ws + WS_SSQP + (size_t)tj * 16384, (unsigned char*)F.out + JOB16 + JOB8 + (size_t)gwt * 6144, F.ws + WS_TAIL + 2 * JOB8 + (size_t)MROWS * 32 + (size_t)gwt * 6144); }
#pragma unroll 1
            for (int u = w0; u < NATT; u += nw) attn_unit(F, u, biasT); } }
        SEAM(3);
    }
    TEND(3);
    TSTART(4);
    if (IN(4)) {
        const int gw = F.vcu * NWAVES + F.wave, NGW = F.G * NWAVES;
        REP(4)
#pragma unroll 1
        for (int w = gw; w < 2048; w += NGW) { const int bb = w >> 10, cc = (w >> 3) & 127, hh = w & 7; rwkv_output(F, ((bb * NCHUNK + cc) * 8) + hh, 2); if (cc == 127) rwkv_output(F, ((bb * NCHUNK + 128) * 8) + hh, 1); }
        SEAM(4);
    }
    TEND(4);
    TSTART(5);
    if (IN(5)) {
        if (blockIdx.x < 16) p5_meta_rows(F, (int)blockIdx.x);
        pg8::Gemm g{YMIX, (const bf16*)(F.ws + WS_WOUT), MREAL, DM, DM}; pg8::StaticOrderT<1> S; S.init(MREAL, DM, F.G, (int)blockIdx.x);
        pg8::EpiH1 E{F.in[I_X], F.out, H1B, SSQP, MPAD};
        pg8::gemm_phase<pg8::EpiH1, pg8::StaticOrderT<1>, true, true>(F.lds + RING_OFF, g, S, E);
#if PROBE_DUP == 5
        __syncthreads();
        pg8::gemm_phase<pg8::EpiH1, pg8::StaticOrderT<1>, true, true>(F.lds + RING_OFF, g, S, E);
#endif
        SEAM(5);
    }
    TEND(5);
    TSTART(6);
    if (IN(6)) {
        pg8::Gemm g{H1B, (const bf16*)(F.ws + WS_WUP), 66 * 256, 2 * DFF, DM}; pg8::StaticOrderT<2> S; S.init(66 * 256, 2 * DFF, F.G, (int)blockIdx.x);
        float* RS2 = SSQP + 16 * (size_t)MPAD;
        { pg8::Unit u; for (int i = 0; S.next(i, u); ++i) { const int r0 = S.a_row0(u), lim = (u.pm / 33) * LTOK + LTOK - 1; if (F.tid < 256) { const int U = (r0 + F.tid) <= lim ? r0 + F.tid : lim; float sacc = 0.f;
#pragma unroll
                    for (int p = 0; p < 16; ++p) sacc += SSQP[(size_t)p * MPAD + U];
                    RS2[U] = 1.0f / sqrtf(sacc * (1.0f / 1024.0f) + 1e-6f); } } }
        VM_WAIT(); __syncthreads();
        pg8::EpiAct E{ACT, RS2, F.in[I_CONVW], F.in[I_CONVB], (LAS float*)(F.lds + HALO_OFF)};
        pg8::gemm_phase<pg8::EpiAct, pg8::StaticOrderT<2>, true, true>(F.lds + RING_OFF, g, S, E);
#if PROBE_DUP == 6
        __syncthreads();
        pg8::gemm_phase<pg8::EpiAct, pg8::StaticOrderT<2>, true, true>(F.lds + RING_OFF, g, S, E);
#endif
        SEAM(6);
    }
    TEND(6);
    TSTART(7);
    if (IN(7)) {
        pg8::Gemm g{ACT, (const bf16*)(F.ws + WS_WDN), MREAL, DM, DFF}; pg8::StaticOrderT<0> S; S.init(MREAL, DM, F.G, (int)blockIdx.x);
        pg8::EpiOut E{F.out};
        pg8::gemm_phase<pg8::EpiOut, pg8::StaticOrderT<0>, true, true>(F.lds + RING_OFF, g, S, E);
#if PROBE_DUP == 7
        __syncthreads();
        { pg8::EpiOut E2{(float*)(F.ws + WS_YMIX)}; pg8::gemm_phase<pg8::EpiOut, pg8::StaticOrderT<0>, true, true>(F.lds + RING_OFF, g, S, E2); }
#endif
    }
    TEND(7);
    if (PROBE_T >= 0 && blockIdx.x == 0 && F.tid == 0) { const unsigned long long span = (tp1_ - tp0_) * 9ull, tz = __builtin_amdgcn_s_memrealtime(); while (__builtin_amdgcn_s_memrealtime() - tz < span) __builtin_amdgcn_s_sleep(8); }
#undef IN
#undef SEAM
}

extern "C" void kernel_launch(void* const* d_in, const int* in_sizes, int n_in, void* d_out, int out_size, void* d_ws, size_t ws_size, hipStream_t stream) {
    static int grid = 0;
    if (grid == 0) {
        if (n_in != 25 || out_size != MREAL * DM || ws_size < WS_END) { fprintf(stderr, "kernel_launch: unexpected shapes n_in %d out %d ws %zu\n", n_in, out_size, ws_size); grid = -1; return; }
        int dev = 0, cus = 0;
        if (hipGetDevice(&dev) != hipSuccess || hipDeviceGetAttribute(&cus, hipDeviceAttributeMultiprocessorCount, dev) != hipSuccess) { grid = -1; return; }
        if (hipFuncSetAttribute((const void*)hymba_fwd, hipFuncAttributeMaxDynamicSharedMemorySize, LDS_BYTES) != hipSuccess) { fprintf(stderr, "kernel_launch: hipFuncSetAttribute failed\n"); grid = -1; return; }
        (void)hipGetLastError();
        grid = cus;
    }
    if (grid < 0) return;
    (void)hipMemsetAsync((char*)d_ws + WS_CTL, 0, CTL_ZERO_BYTES, stream);
    Args a{};
    for (int i = 0; i < 25; ++i) a.in[i] = (const float*)d_in[i];
    a.out = (float*)d_out; a.ws = (unsigned char*)d_ws;
    for (int li = 0; li < N_LAUNCHES; ++li) {
        a.ph_lo = (N_LAUNCHES == 1) ? 0 : li; a.ph_hi = (N_LAUNCHES == 1) ? PER_PHASE : li + 1;
        hipLaunchKernelGGL(hymba_fwd, dim3(grid), dim3(NWAVES * 64), LDS_BYTES, stream, a);
    }
}
```
